# Optimizing an MI355X kernel written in HIP

```python
import math
import jax, jax.numpy as jnp
from jax import lax
import numpy as np

D_MODEL = 4096
BATCH = 2
SEQ = 8192
DEPTH = 1

MEM_LEN = 256
A_HEADS = 32
A_KV_HEADS = 4
A_HEAD_DIM = 64
WINDOW = 128
BLOCK = 128
N_BUCKETS = 32
MAX_DISTANCE = 128
B_HEADS = 16
B_DK = 128
B_DV = 128
CONV_W = 4
CHUNK = 64
M_HEADS = 4
M_HEAD_DIM = 128
D_FF = -(-8 * D_MODEL // (3 * 256)) * 256

A_Q = A_HEADS * A_HEAD_DIM
A_KV = A_KV_HEADS * A_HEAD_DIM
B_QK = B_HEADS * B_DK
B_V = B_HEADS * B_DV
B_CONV = 2 * B_QK + B_V
M_Q = M_HEADS * M_HEAD_DIM
IN_SIZES = (A_Q, A_KV, A_KV, B_CONV, B_V, B_HEADS, B_HEADS, M_Q, D_MODEL, D_MODEL, D_MODEL)
N_IN = sum(IN_SIZES)
EPS = 1e-6
NEG = -1e30

kernel_name = 'hybrid_swa_sink_gdn_memory_block'


def rms_norm(x, g):
    xf = x.astype(jnp.float32)
    y = xf * lax.rsqrt(jnp.mean(xf * xf, axis=-1, keepdims=True) + EPS)
    return (y * g.astype(jnp.float32)).astype(x.dtype)


def l2_norm(x):
    return x * lax.rsqrt(jnp.sum(x * x, axis=-1, keepdims=True) + EPS)


def split_cols(t, sizes):
    out = []
    off = 0
    for n in sizes:
        out.append(t[..., off:off + n])
        off += n
    return out


def t5_bucket(n):
    max_exact = N_BUCKETS // 2
    nf = jnp.maximum(n, 1).astype(jnp.float32)
    large = max_exact + (jnp.log(nf / max_exact) / math.log(MAX_DISTANCE / max_exact)
                         * (N_BUCKETS - max_exact)).astype(jnp.int32)
    large = jnp.minimum(large, N_BUCKETS - 1)
    return jnp.where(n < max_exact, n, large)


def swa_sink_attention(q, k, v, sink, rel_bias):
    bsz, s_len = q.shape[0], q.shape[1]
    nb = s_len // BLOCK
    grp = A_HEADS // A_KV_HEADS
    qb = q.reshape(bsz, nb, BLOCK, A_KV_HEADS, grp, A_HEAD_DIM)
    kb = k.reshape(bsz, nb, BLOCK, A_KV_HEADS, A_HEAD_DIM)
    vb = v.reshape(bsz, nb, BLOCK, A_KV_HEADS, A_HEAD_DIM)

    def with_prev(t):
        prev = jnp.pad(t[:, :-1], ((0, 0), (1, 0), (0, 0), (0, 0), (0, 0)))
        return jnp.concatenate([prev, t], axis=2)

    kw, vw = with_prev(kb), with_prev(vb)
    s = jnp.einsum('bnqhgd,bnkhd->bnhgqk', qb, kw).astype(jnp.float32) * (A_HEAD_DIM ** -0.5)
    qi = jnp.arange(BLOCK)[:, None]
    kj = jnp.arange(2 * BLOCK)[None, :]
    dist = qi + BLOCK - kj
    band = (dist >= 0) & (dist < WINDOW)
    exists = (jnp.arange(nb)[:, None, None] > 0) | (kj >= BLOCK)[None]
    mask = band[None] & exists
    bias = rel_bias[t5_bucket(jnp.maximum(dist, 0))].astype(jnp.float32)
    bias = bias.transpose(2, 0, 1).reshape(A_KV_HEADS, grp, BLOCK, 2 * BLOCK)
    s = jnp.where(mask[None, :, None, None], s + bias, NEG)
    sk = sink.astype(jnp.float32).reshape(A_KV_HEADS, grp)[:, :, None, None]
    m = jnp.maximum(jnp.max(s, axis=-1, keepdims=True), sk)
    p = jnp.exp(s - m)
    p = p / (jnp.sum(p, axis=-1, keepdims=True) + jnp.exp(sk - m))
    o = jnp.einsum('bnhgqk,bnkhd->bnqhgd', p.astype(v.dtype), vw)
    return o.reshape(bsz, s_len, A_Q)


def causal_conv(x, w):
    s_len = x.shape[1]
    xp = jnp.pad(x, ((0, 0), (CONV_W - 1, 0), (0, 0)))
    y = xp[:, 0:s_len] * w[0]
    for i in range(1, CONV_W):
        y = y + xp[:, i:i + s_len] * w[i]
    return y


def gated_delta_rule(q, k, v, g, beta):
    bsz, s_len, nh, dk = q.shape
    dv = v.shape[-1]
    n = s_len // CHUNK

    def chunk(t):
        return t.reshape(bsz, n, CHUNK, nh, -1).transpose(0, 3, 1, 2, 4)

    q, k, v = chunk(q), chunk(k), chunk(v)
    g = g.reshape(bsz, n, CHUNK, nh).transpose(0, 3, 1, 2)
    beta = beta.reshape(bsz, n, CHUNK, nh).transpose(0, 3, 1, 2)
    gc = jnp.cumsum(g, axis=-1)
    tri = jnp.tril(jnp.ones((CHUNK, CHUNK), dtype=bool))
    strict = jnp.tril(jnp.ones((CHUNK, CHUNK), dtype=bool), -1)
    decay = jnp.exp(jnp.where(tri, gc[..., :, None] - gc[..., None, :], -jnp.inf))
    kb = k * beta[..., None]
    a_mat = jnp.where(strict, jnp.einsum('bhncd,bhnsd->bhncs', kb, k) * decay, 0.0)
    rhs = jnp.concatenate([v * beta[..., None], kb * jnp.exp(gc)[..., None]], axis=-1)
    sol = lax.linalg.triangular_solve(a_mat + jnp.eye(CHUNK, dtype=a_mat.dtype), rhs,
                                      left_side=True, lower=True)
    u, w = sol[..., :dv], sol[..., dv:]
    att = jnp.where(tri, jnp.einsum('bhncd,bhnsd->bhncs', q, k) * decay, 0.0)

    def step(state, inp):
        q_c, k_c, u_c, w_c, att_c, gc_c = inp
        v_new = u_c - jnp.einsum('bhck,bhkv->bhcv', w_c, state)
        o_c = (jnp.einsum('bhck,bhkv->bhcv', q_c * jnp.exp(gc_c)[..., None], state)
               + jnp.einsum('bhcs,bhsv->bhcv', att_c, v_new))
        g_last = gc_c[..., -1:]
        state = (state * jnp.exp(g_last)[..., None]
                 + jnp.einsum('bhck,bhcv->bhkv', k_c * jnp.exp(g_last - gc_c)[..., None], v_new))
        return state, o_c

    xs = tuple(jnp.moveaxis(t, 2, 0) for t in (q, k, u, w, att, gc))
    state0 = jnp.zeros((bsz, nh, dk, dv), jnp.float32)
    _, o = lax.scan(step, state0, xs)
    return o.transpose(1, 0, 3, 2, 4).reshape(bsz, s_len, nh, dv)


def setup_inputs(seed: int = 0) -> dict:
    key = jax.random.key(seed)
    ks = jax.random.split(key, 24)
    f32 = jnp.float32

    def nrm(k, shape, fan_in):
        return jax.random.normal(k, shape, f32) * (fan_in ** -0.5)

    def gain(k, shape):
        return 1.0 + 0.02 * jax.random.normal(k, shape, f32)

    dt = jnp.exp(jax.random.uniform(ks[5], (DEPTH, B_HEADS), f32, math.log(1e-3), math.log(0.1)))
    return {
        'x': jax.random.normal(ks[0], (BATCH, SEQ, D_MODEL), f32),
        'mem': jax.random.normal(ks[1], (BATCH, MEM_LEN, D_MODEL), f32),
        'rel_bias': 0.1 * jax.random.normal(ks[2], (N_BUCKETS, A_HEADS), f32),
        'g_mix': gain(ks[3], (DEPTH, D_MODEL)),
        'w_in': nrm(ks[4], (DEPTH, D_MODEL, N_IN), D_MODEL),
        'conv_w': nrm(ks[6], (DEPTH, CONV_W, B_CONV), CONV_W),
        'a_log': jnp.log(jax.random.uniform(ks[7], (DEPTH, B_HEADS), f32, 1.0, 16.0)),
        'dt_bias': dt + jnp.log(-jnp.expm1(-dt)),
        'g_dn_out': gain(ks[8], (DEPTH, B_DV)),
        'sinks': 0.5 * jax.random.normal(ks[9], (DEPTH, A_HEADS), f32),
        'g_mem': gain(ks[10], (DEPTH, D_MODEL)),
        'w_mem_kv': nrm(ks[11], (DEPTH, D_MODEL, 2 * M_Q), D_MODEL),
        'w_br_a': nrm(ks[12], (DEPTH, A_Q, D_MODEL), A_Q),
        'w_br_b': nrm(ks[13], (DEPTH, B_V, D_MODEL), B_V),
        'w_br_m': nrm(ks[14], (DEPTH, M_Q, D_MODEL), M_Q),
        'w_o': nrm(ks[15], (DEPTH, D_MODEL, D_MODEL), D_MODEL),
        'g_ffn': gain(ks[16], (DEPTH, D_MODEL)),
        'w_ffn_in': nrm(ks[17], (DEPTH, D_MODEL, 2 * D_FF), D_MODEL),
        'w_ffn_out': nrm(ks[18], (DEPTH, D_FF, D_MODEL), D_FF),
        'g_final': gain(ks[19], (D_MODEL,)),
    }


def reference(x, mem, rel_bias, g_mix, w_in, conv_w, a_log, dt_bias, g_dn_out, sinks, g_mem,
              w_mem_kv, w_br_a, w_br_b, w_br_m, w_o, g_ffn, w_ffn_in, w_ffn_out, g_final):
    f32 = jnp.float32
    bsz, s_len, _ = x.shape
    for l in range(DEPTH):
        h = rms_norm(x, g_mix[l])
        proj = h @ w_in[l]
        a_q, a_k, a_v, b_qkv, b_z, b_b, b_a, m_q, gt_a, gt_b, gt_m = split_cols(proj, IN_SIZES)

        o_a = swa_sink_attention(a_q.reshape(bsz, s_len, A_HEADS, A_HEAD_DIM),
                                 a_k.reshape(bsz, s_len, A_KV_HEADS, A_HEAD_DIM),
                                 a_v.reshape(bsz, s_len, A_KV_HEADS, A_HEAD_DIM),
                                 sinks[l], rel_bias)

        qkv = jax.nn.silu(causal_conv(b_qkv, conv_w[l])).astype(f32)
        bq, bk, bv = split_cols(qkv, (B_QK, B_QK, B_V))
        bq = l2_norm(bq.reshape(bsz, s_len, B_HEADS, B_DK)) * (B_DK ** -0.5)
        bk = l2_norm(bk.reshape(bsz, s_len, B_HEADS, B_DK))
        bv = bv.reshape(bsz, s_len, B_HEADS, B_DV)
        beta = jax.nn.sigmoid(b_b.astype(f32))
        g = -jnp.exp(a_log[l].astype(f32)) * jax.nn.softplus(b_a.astype(f32) + dt_bias[l].astype(f32))
        o_b = gated_delta_rule(bq, bk, bv, g, beta)
        o_b = rms_norm(o_b, g_dn_out[l]) * jax.nn.silu(b_z.reshape(bsz, s_len, B_HEADS, B_DV).astype(f32))
        o_b = o_b.reshape(bsz, s_len, B_V).astype(x.dtype)

        mk, mv = split_cols(rms_norm(mem, g_mem[l]) @ w_mem_kv[l], (M_Q, M_Q))
        mk = mk.reshape(bsz, MEM_LEN, M_HEADS, M_HEAD_DIM)
        mv = mv.reshape(bsz, MEM_LEN, M_HEADS, M_HEAD_DIM)
        sm = jnp.einsum('bshd,bmhd->bhsm', m_q.reshape(bsz, s_len, M_HEADS, M_HEAD_DIM), mk)
        pm = jax.nn.softmax(sm.astype(f32) * (M_HEAD_DIM ** -0.5), axis=-1).astype(x.dtype)
        o_m = jnp.einsum('bhsm,bmhd->bshd', pm, mv).reshape(bsz, s_len, M_Q)

        y = (jax.nn.sigmoid(gt_a) * (o_a @ w_br_a[l])
             + jax.nn.sigmoid(gt_b) * (o_b @ w_br_b[l])
             + jax.nn.sigmoid(gt_m) * (o_m @ w_br_m[l]))
        x = x + y @ w_o[l]

        gate, up = split_cols(rms_norm(x, g_ffn[l]) @ w_ffn_in[l], (D_FF, D_FF))
        x = x + (jax.nn.silu(gate) * up) @ w_ffn_out[l]
    return rms_norm(x, g_final)
```

```cpp
#include <hip/hip_runtime.h>
#include <cstdio>

#ifndef GEMM_MODE
#define GEMM_MODE 1
#endif
#ifndef MK_ONE_LAUNCH
#define MK_ONE_LAUNCH 1
#endif

#define LAS __attribute__((address_space(3)))
#define GAS __attribute__((address_space(1)))
typedef unsigned short bf16_t;
typedef short bf16x8 __attribute__((ext_vector_type(8)));
typedef float f32x4 __attribute__((ext_vector_type(4)));
typedef float f32x2 __attribute__((ext_vector_type(2)));
typedef unsigned u32x4 __attribute__((ext_vector_type(4)));
typedef unsigned u32x2 __attribute__((ext_vector_type(2)));

constexpr int DM = 4096, BATCH = 2, SEQ = 8192, M = BATCH * SEQ, MEMLEN = 256, MEMROWS = BATCH * MEMLEN;
constexpr int N_IN = 23584, NP_IN = 23808;
constexpr int DFF = 11008, KCAT = 4608;
constexpr int A_HEADS = 32, A_KVH = 4, A_HD = 64, WINDOW = 128;
constexpr int B_HEADS = 16, B_DK = 128;
constexpr int M_HEADS = 4, M_HD = 128;
constexpr float EPS = 1e-6f;

constexpr size_t MiB = 1u << 20;
constexpr size_t WS_CTL = 0, CTL_ZERO_BYTES = 1 * MiB;
constexpr size_t WS_WIN = 2 * MiB;
constexpr size_t WS_WKV = 188 * MiB;
constexpr size_t WS_WBR = 196 * MiB;
constexpr size_t WS_WO = 232 * MiB;
constexpr size_t WS_WF1 = 264 * MiB;
constexpr size_t WS_WF2 = 436 * MiB;
constexpr size_t WS_H = 522 * MiB;
constexpr size_t WS_ACAT = 650 * MiB;
constexpr size_t WS_KVA = 794 * MiB;
constexpr size_t WS_BQKV = 810 * MiB;
constexpr size_t WS_GATES = 1002 * MiB;
constexpr size_t WS_BA = 1386 * MiB;
constexpr size_t WS_MEMN = 1388 * MiB;
constexpr size_t WS_MKV = 1392 * MiB;
constexpr size_t WS_PART1 = 1393 * MiB;
constexpr size_t WS_PART2 = 1397 * MiB;
constexpr size_t WS_END = 1401 * MiB;
constexpr size_t WS_H2 = WS_BQKV;
constexpr size_t WS_HID = WS_GATES;
constexpr size_t WS_GW = WS_WIN, WS_GKDT = 66 * MiB, WS_GATT = 130 * MiB, WS_GL = 162 * MiB, WS_GQG = WS_H, WS_GUT = 586 * MiB, WS_GST = WS_BQKV, WS_GVT = 938 * MiB;
constexpr int CW_TMO = 0, CW_CODE = 1, CW_QUEUE = 64, CW_DONE = 1024, CW_BGHEAD = 2048, CW_BAR = 4096;

constexpr int RING_BYTES = 147456;
constexpr int DEC_OFF = RING_BYTES;
constexpr int RS_OFF = 159744;
constexpr int MISC_OFF = 161792;
constexpr int LDS_BYTES = 163840;

__device__ __forceinline__ unsigned f2bf(float f) { unsigned u = __builtin_bit_cast(unsigned, f); return (u + 0x7fffu + ((u >> 16) & 1u)) >> 16; }
__device__ __forceinline__ float bf2f(unsigned short b) { return __builtin_bit_cast(float, (unsigned)b << 16); }
__device__ __forceinline__ float bflo(unsigned w) { return __builtin_bit_cast(float, w << 16); }
__device__ __forceinline__ float bfhi(unsigned w) { return __builtin_bit_cast(float, w & 0xffff0000u); }
typedef __bf16 bf16x2_t __attribute__((ext_vector_type(2)));
__device__ __forceinline__ unsigned cvt_pk_bf16(float lo, float hi) { const f32x2 v = {lo, hi}; const bf16x2_t b = __builtin_convertvector(v, bf16x2_t); return __builtin_bit_cast(unsigned, b); }
__device__ __forceinline__ unsigned pk2(float lo, float hi) { return cvt_pk_bf16(lo, hi); }
__device__ __forceinline__ float sigmoidf_(float x) { return __builtin_amdgcn_rcpf(1.0f + __expf(-x)); }
__device__ __forceinline__ float siluf_(float x) { return x * __builtin_amdgcn_rcpf(1.0f + __expf(-x)); }
__host__ __device__ __forceinline__ size_t tiled_off(int row, int col, int ktiles) { return ((size_t)(row >> 7) * ktiles + (size_t)(col >> 6)) * 8192 + (size_t)((row & 127) * 64 + (col & 63)); }
__device__ __forceinline__ float wave_sum(float v) {
#pragma unroll
    for (int o = 1; o < 64; o <<= 1) v += __shfl_xor(v, o);
    return v;
}

namespace pg8 {
constexpr int BM = 256, BK = 64, HALF = 128, HTB = HALF * BK * 2, STAGE_BYTES = 8 * HTB, NXCD = 8, WGM = 8;
__host__ __device__ __forceinline__ int lds_byte(int r, int c) { const int st = (r >> 4) * 2 + (c >> 5), rr = r & 15, cc = c & 31, ob = rr * 64 + cc * 2; return st * 1024 + (ob ^ (((ob >> 9) & 1) << 5)); }
__host__ __device__ __forceinline__ void stage_rc(int b, int& R, int& C) { const int st = b / 1024, sb = b % 1024, swz = sb ^ (((sb >> 9) & 1) << 5); R = (st >> 1) * 16 + swz / 64; C = (st & 1) * 32 + (swz % 64) / 2; }
__host__ __device__ __forceinline__ int perm32(int rho) { const int n = rho >> 4, i = rho & 15; return 8 * (i >> 2) + 4 * n + (i & 3); }

struct Unit { int pm, pn, sel; };
struct Gemm { const bf16_t* A; const bf16_t* Bt; const bf16_t* A2; const bf16_t* B2; int K; };

struct StaticOrder {
    int nM, nN, nwg, G, c, nextra, exN;
    __device__ void init(int M_, int N_, int G_, int c_, int nextra_ = 0, int exN_ = 1) { nM = M_ / BM; nN = N_ / BM; nwg = nM * nN; G = G_; c = c_; nextra = nextra_; exN = exN_; }
    __device__ bool next(int i, Unit& u) const {
        const long L = (long)i * G + c; if (L >= nwg + nextra) return false;
        if (L >= nwg) { const int e = (int)(L - nwg); u.pm = e / exN; u.pn = e % exN; u.sel = 1; return true; }
        int wgid = (int)L; { const int q = nwg / NXCD, r = nwg % NXCD, xcd = wgid % NXCD, off = wgid / NXCD; wgid = (xcd < r ? xcd * (q + 1) : r * (q + 1) + (xcd - r) * q) + off; }
        const int nig = WGM * nN, gid = wgid / nig, fm = gid * WGM, gsz = (nM - fm) < WGM ? (nM - fm) : WGM;
        u.pm = fm + ((wgid % nig) % gsz); u.pn = (wgid % nig) / gsz; u.sel = 0; return true;
    }
    __device__ __forceinline__ void a_ready(const Unit&) {}
    __device__ __forceinline__ void done(const Unit&) {}
};

template <class Epi, class Sched, bool ALIGN_EPI, int SP2>
__device__ __forceinline__ void gemm_phase(LAS unsigned char* lds, const Gemm g, Sched& S, Epi& E) {
    const int tid = threadIdx.x, wid = __builtin_amdgcn_readfirstlane(tid >> 6), lane = tid & 63, wr = wid >> 2, wc = wid & 3, fr = lane & 15, fq = lane >> 4;
    const int K = g.K, nt = K / BK;
    unsigned voffA[2], voffB[2];
#pragma unroll
    for (int i = 0; i < 2; ++i) { int R, C; stage_rc(tid * 16 + i * 8192, R, C); const int Rb = Epi::PERM ? ((R & ~31) + perm32(R & 31)) : R;
        voffA[i] = (unsigned)(R * 64 + C) * 2u; voffB[i] = (unsigned)(Rb * 64 + C) * 2u; }
    const size_t kstep = (size_t)HTB;
    const size_t hstepA = (size_t)nt * HTB, hstepB = hstepA;
    const unsigned ldsw = (unsigned)wid * 1024u;
    const int aoff = lds_byte(wr * 64 + fr, fq * 8), boff = lds_byte(wc * 32 + fr, fq * 8);
#define PG8_SA(b, h) (((b) * 2 + (h)) * HTB)
#define PG8_SB(b, h) ((4 + (b) * 2 + (h)) * HTB)
#define PG8_STAGE(bufoff, gbase, voff) do { _Pragma("unroll") for (int _i = 0; _i < 2; ++_i) \
        __builtin_amdgcn_global_load_lds((const unsigned*)((const char*)(gbase) + (voff)[_i]), (LAS unsigned*)(lds + (bufoff) + ldsw + _i * 8192), 16, 0, 0); } while (0)
#define PG8_LDA(dst, b, h) do { _Pragma("unroll") for (int m = 0; m < 4; ++m) _Pragma("unroll") for (int k = 0; k < 2; ++k) dst[m][k] = *(const LAS bf16x8*)(lds + PG8_SA(b, h) + aoff + m * 2048 + k * 1024); } while (0)
#define PG8_LDB(dst, b, h) do { _Pragma("unroll") for (int n = 0; n < 2; ++n) _Pragma("unroll") for (int k = 0; k < 2; ++k) dst[n][k] = *(const LAS bf16x8*)(lds + PG8_SB(b, h) + boff + n * 2048 + k * 1024); } while (0)
#define PG8_MMA(ai, bj, At, Bt) do { __builtin_amdgcn_s_setprio(1); _Pragma("unroll") for (int m = 0; m < 4; ++m) _Pragma("unroll") for (int n = 0; n < 2; ++n) _Pragma("unroll") for (int k = 0; k < 2; ++k) \
        acc[ai][bj][m][n] = __builtin_amdgcn_mfma_f32_16x16x32_bf16(Bt[n][k], At[m][k], acc[ai][bj][m][n], 0, 0, 0); __builtin_amdgcn_s_setprio(0); } while (0)
#define PG8_WAIT_V(n) asm volatile("s_waitcnt vmcnt(" #n ")" ::: "memory")
#define PG8_WAIT_L(n) asm volatile("s_waitcnt lgkmcnt(" #n ")" ::: "memory")
#define PG8_BAR __builtin_amdgcn_s_barrier()
#define PG8_SCHED __builtin_amdgcn_sched_barrier(0)
#define PG8_ATILE(u) ((const char*)((u).sel ? g.A2 : g.A) + (size_t)(u).pm * 2 * hstepA)
#define PG8_BTILE(u) ((const char*)((u).sel ? g.B2 : g.Bt) + (size_t)(u).pn * 2 * hstepB)
    Unit cur, nxt; int ui = 0;
    if (!S.next(0, cur)) return;
    f32x4 acc[2][2][4][2];
#pragma unroll
    for (int a = 0; a < 2; ++a)
#pragma unroll
        for (int b = 0; b < 2; ++b)
#pragma unroll
            for (int m = 0; m < 4; ++m)
#pragma unroll
                for (int n = 0; n < 2; ++n) acc[a][b][m][n] = (f32x4){0.f, 0.f, 0.f, 0.f};
    bf16x8 At[4][2], B0[2][2], B1[2][2];
    const char* cA = PG8_ATILE(cur); const char* cB = PG8_BTILE(cur);
    S.a_ready(cur);
    if constexpr (SP2 != 0) {
        PG8_STAGE(PG8_SB(0, 0), cB, voffB); PG8_STAGE(PG8_SB(0, 1), cB + hstepB, voffB); PG8_STAGE(PG8_SA(0, 0), cA, voffA); PG8_STAGE(PG8_SA(0, 1), cA + hstepA, voffA);
        if (wr == 1) PG8_BAR;
        PG8_WAIT_V(2); PG8_BAR;
        PG8_STAGE(PG8_SB(1, 0), cB + kstep, voffB); PG8_STAGE(PG8_SA(1, 0), cA + kstep, voffA); PG8_STAGE(PG8_SB(1, 1), cB + hstepB + kstep, voffB);
        PG8_WAIT_V(6); PG8_BAR;
    } else {
        PG8_STAGE(PG8_SB(0, 0), cB, voffB); PG8_STAGE(PG8_SA(0, 0), cA, voffA); PG8_STAGE(PG8_SB(0, 1), cB + hstepB, voffB); PG8_STAGE(PG8_SA(0, 1), cA + hstepA, voffA);
        if (wr == 1) PG8_BAR;
        PG8_WAIT_V(4); PG8_BAR;
        PG8_STAGE(PG8_SB(1, 0), cB + kstep, voffB); PG8_STAGE(PG8_SA(1, 0), cA + kstep, voffA); PG8_STAGE(PG8_SB(1, 1), cB + hstepB + kstep, voffB);
        PG8_WAIT_V(6); PG8_BAR;
    }
    for (;;) {
        const bool has_next = S.next(ui + 1, nxt);
        const char* nA = has_next ? PG8_ATILE(nxt) : cA; const char* nB = has_next ? PG8_BTILE(nxt) : cB;
        for (int t = 0; t < nt; t += 2) {
            const bool last = (t == nt - 2);
            const char* a1 = cA + (size_t)(t + 1) * kstep;
            const char* a2 = last ? nA : cA + (size_t)(t + 2) * kstep; const char* b2 = last ? nB : cB + (size_t)(t + 2) * kstep;
            const char* a3 = a2 + kstep; const char* b3 = b2 + kstep;
            if (last && has_next) S.a_ready(nxt);
            if constexpr (Epi::HOOK) { if (t == Epi::H1 || t == Epi::H2) E.hook(acc, cur, t, wr, wc, fr, fq); }
            if constexpr (SP2 == 2) {
            PG8_LDB(B0, 0, 0); PG8_LDB(B1, 0, 1); PG8_SCHED; PG8_LDA(At, 0, 0);
            PG8_WAIT_V(6); PG8_WAIT_L(0); PG8_BAR; PG8_MMA(0, 0, At, B0); PG8_STAGE(PG8_SA(1, 1), a1 + hstepA, voffA); PG8_MMA(0, 1, At, B1); PG8_BAR; PG8_SCHED;
            PG8_LDA(At, 0, 1);
            PG8_WAIT_V(2); PG8_WAIT_L(0); PG8_BAR; PG8_MMA(1, 0, At, B0); PG8_STAGE(PG8_SB(0, 0), b2, voffB); PG8_STAGE(PG8_SB(0, 1), b2 + hstepB, voffB); PG8_STAGE(PG8_SA(0, 0), a2, voffA); PG8_MMA(1, 1, At, B1); PG8_BAR; PG8_SCHED;
            PG8_LDB(B0, 1, 0); PG8_LDB(B1, 1, 1); PG8_SCHED; PG8_LDA(At, 1, 0);
            PG8_WAIT_V(6); PG8_WAIT_L(0); PG8_BAR; PG8_MMA(0, 0, At, B0); PG8_STAGE(PG8_SA(0, 1), a2 + hstepA, voffA); PG8_MMA(0, 1, At, B1); PG8_BAR; PG8_SCHED;
            PG8_LDA(At, 1, 1);
            PG8_WAIT_V(2); PG8_WAIT_L(0); PG8_BAR; PG8_MMA(1, 0, At, B0); PG8_STAGE(PG8_SB(1, 0), b3, voffB); PG8_STAGE(PG8_SB(1, 1), b3 + hstepB, voffB); PG8_STAGE(PG8_SA(1, 0), a3, voffA); PG8_MMA(1, 1, At, B1); PG8_BAR; PG8_SCHED;
            } else if constexpr (SP2 == 1) {
            PG8_LDB(B0, 0, 0); PG8_LDB(B1, 0, 1); PG8_SCHED; PG8_LDA(At, 0, 0); PG8_STAGE(PG8_SA(1, 1), a1 + hstepA, voffA);
            PG8_WAIT_V(8); PG8_WAIT_L(0); PG8_BAR; PG8_MMA(0, 0, At, B0); PG8_MMA(0, 1, At, B1); PG8_BAR; PG8_SCHED;
            PG8_LDA(At, 0, 1); PG8_STAGE(PG8_SB(0, 0), b2, voffB); PG8_STAGE(PG8_SB(0, 1), b2 + hstepB, voffB); PG8_STAGE(PG8_SA(0, 0), a2, voffA);
            PG8_WAIT_V(8); PG8_WAIT_L(0); PG8_BAR; PG8_MMA(1, 0, At, B0); PG8_MMA(1, 1, At, B1); PG8_BAR; PG8_SCHED;
            PG8_LDB(B0, 1, 0); PG8_LDB(B1, 1, 1); PG8_SCHED; PG8_LDA(At, 1, 0); PG8_STAGE(PG8_SA(0, 1), a2 + hstepA, voffA);
            PG8_WAIT_V(8); PG8_WAIT_L(0); PG8_BAR; PG8_MMA(0, 0, At, B0); PG8_MMA(0, 1, At, B1); PG8_BAR; PG8_SCHED;
            PG8_LDA(At, 1, 1); PG8_STAGE(PG8_SB(1, 0), b3, voffB); PG8_STAGE(PG8_SB(1, 1), b3 + hstepB, voffB); PG8_STAGE(PG8_SA(1, 0), a3, voffA);
            PG8_WAIT_V(8); PG8_WAIT_L(0); PG8_BAR; PG8_MMA(1, 0, At, B0); PG8_MMA(1, 1, At, B1); PG8_BAR; PG8_SCHED;
            } else {
            PG8_LDB(B0, 0, 0); PG8_SCHED; PG8_LDA(At, 0, 0); PG8_STAGE(PG8_SA(1, 1), a1 + hstepA, voffA);
            PG8_WAIT_L(8); PG8_BAR; PG8_WAIT_L(0); PG8_MMA(0, 0, At, B0); PG8_BAR; PG8_SCHED;
            PG8_LDB(B1, 0, 1); PG8_STAGE(PG8_SB(0, 0), b2, voffB);
            PG8_BAR; PG8_WAIT_L(0); PG8_MMA(0, 1, At, B1); PG8_BAR;
            PG8_LDA(At, 0, 1); PG8_STAGE(PG8_SA(0, 0), a2, voffA);
            PG8_BAR; PG8_WAIT_L(0); PG8_MMA(1, 0, At, B0); PG8_BAR; PG8_SCHED;
            PG8_STAGE(PG8_SB(0, 1), b2 + hstepB, voffB);
            PG8_WAIT_V(6); PG8_BAR; PG8_MMA(1, 1, At, B1); PG8_BAR;
            PG8_LDB(B0, 1, 0); PG8_SCHED; PG8_LDA(At, 1, 0); PG8_STAGE(PG8_SA(0, 1), a2 + hstepA, voffA);
            PG8_WAIT_L(8); PG8_BAR; PG8_WAIT_L(0); PG8_MMA(0, 0, At, B0); PG8_BAR; PG8_SCHED;
            PG8_LDB(B1, 1, 1); PG8_STAGE(PG8_SB(1, 0), b3, voffB);
            PG8_BAR; PG8_WAIT_L(0); PG8_MMA(0, 1, At, B1); PG8_BAR;
            PG8_LDA(At, 1, 1); PG8_STAGE(PG8_SA(1, 0), a3, voffA);
            PG8_BAR; PG8_WAIT_L(0); PG8_MMA(1, 0, At, B0); PG8_BAR; PG8_SCHED;
            PG8_STAGE(PG8_SB(1, 1), b3 + hstepB, voffB);
            PG8_WAIT_V(6); PG8_BAR; PG8_MMA(1, 1, At, B1); PG8_BAR;
            }
        }
        if constexpr (ALIGN_EPI) { if (wr == 0) PG8_BAR; }
        E(acc, cur, wr, wc, fr, fq); S.done(cur);
        if (!has_next) break;
#pragma unroll
        for (int a = 0; a < 2; ++a)
#pragma unroll
            for (int b = 0; b < 2; ++b)
#pragma unroll
                for (int m = 0; m < 4; ++m)
#pragma unroll
                    for (int n = 0; n < 2; ++n) acc[a][b][m][n] = (f32x4){0.f, 0.f, 0.f, 0.f};
        cur = nxt; cA = nA; cB = nB; ++ui;
        if constexpr (ALIGN_EPI) { if (wr == 1) PG8_BAR; }
    }
    PG8_WAIT_V(0);
    if constexpr (!ALIGN_EPI) { if (wr == 0) PG8_BAR; }
    PG8_BAR;
#undef PG8_SA
#undef PG8_SB
#undef PG8_STAGE
#undef PG8_LDA
#undef PG8_LDB
#undef PG8_MMA
#undef PG8_WAIT_V
#undef PG8_WAIT_L
#undef PG8_BAR
#undef PG8_SCHED
#undef PG8_ATILE
#undef PG8_BTILE
}

struct EpiInProj {
    static constexpr bool PERM = true, HOOK = false; static constexpr int H1 = -1, H2 = -1;
    bf16_t* acat; bf16_t* kva; bf16_t* bqkv; bf16_t* gates; float* ba; bf16_t* mkv;
    __device__ __forceinline__ void hook(f32x4 (&)[2][2][4][2], const Unit&, int, int, int, int, int) {}
    __device__ __forceinline__ void operator()(const f32x4 (&acc)[2][2][4][2], const Unit& u, int wr, int wc, int fr, int fq) const {
        const int row0 = u.pm * BM + wr * 64 + fr;
        bf16_t* base; int ldc, colt; const int pn = u.pn;
        if (u.sel) { base = mkv; ldc = 1024; colt = pn * 256; }
        else if (pn < 8) { base = acat; ldc = KCAT; colt = pn * 256; }
        else if (pn < 10) { base = kva; ldc = 512; colt = (pn - 8) * 256; }
        else if (pn < 34) { base = bqkv; ldc = 6144; colt = (pn - 10) * 256; }
        else if (pn < 42) { base = acat; ldc = KCAT; colt = 2048 + (pn - 34) * 256; }
        else if (pn < 44) { base = acat; ldc = KCAT; colt = 4096 + (pn - 42) * 256; }
        else if (pn < 92) { base = gates; ldc = 12288; colt = (pn - 44) * 256; }
        else {
            if (wc == 0) {
#pragma unroll
                for (int ai = 0; ai < 2; ++ai)
#pragma unroll
                    for (int m = 0; m < 4; ++m) { float* rowp = ba + (size_t)(row0 + ai * HALF + m * 16) * 32 + 8 * fq;
                        *(f32x4*)(rowp) = acc[ai][0][m][0]; *(f32x4*)(rowp + 4) = acc[ai][0][m][1]; }
            }
            return;
        }
        const int col0 = colt + wc * 32 + 8 * fq; const bool tiled = (base == acat), isgate = (base == gates);
#pragma unroll
        for (int ai = 0; ai < 2; ++ai)
#pragma unroll
            for (int m = 0; m < 4; ++m) { const int r = row0 + ai * HALF + m * 16;
#pragma unroll
                for (int bj = 0; bj < 2; ++bj) { f32x4 v0 = acc[ai][bj][m][0], v1 = acc[ai][bj][m][1];
                    if (isgate) {
#pragma unroll
                        for (int j = 0; j < 4; ++j) { v0[j] = __builtin_amdgcn_rcpf(1.0f + __expf(-v0[j])); v1[j] = __builtin_amdgcn_rcpf(1.0f + __expf(-v1[j])); } }
                    u32x4 w; w.x = cvt_pk_bf16(v0[0], v0[1]); w.y = cvt_pk_bf16(v0[2], v0[3]); w.z = cvt_pk_bf16(v1[0], v1[1]); w.w = cvt_pk_bf16(v1[2], v1[3]);
                    bf16_t* p = tiled ? base + tiled_off(r, col0 + bj * HALF, KCAT / 64) : base + (size_t)r * ldc + col0 + bj * HALF;
                    *(u32x4*)p = w; } }
    }
};

struct EpiMerge {
    static constexpr bool PERM = true, HOOK = true; static constexpr int H1 = 32, H2 = 64;
    const bf16_t* gates; bf16_t* y;
    __device__ __forceinline__ void hook(f32x4 (&acc)[2][2][4][2], const Unit& u, int t, int wr, int wc, int fr, int fq) const {
        const char* gbase = (const char*)gates + ((size_t)(u.pm * BM + wr * 64) * 12288 + (size_t)(u.pn * BM + wc * 32) + (size_t)((t == H1) ? 0 : 4096)) * 2;
        const unsigned loff = (unsigned)(fr * 12288 + 8 * fq) * 2u;
#pragma unroll
        for (int ai = 0; ai < 2; ++ai) {
            u32x4 gp[4][2], gn[4][2];
#pragma unroll
            for (int m = 0; m < 4; ++m)
#pragma unroll
                for (int bj = 0; bj < 2; ++bj) { const char* p = gbase + ((size_t)(ai * HALF + m * 16) * 12288 + bj * HALF) * 2;
                    gp[m][bj] = *(const u32x4*)(p + loff); gn[m][bj] = *(const u32x4*)(p + 8192 + loff); }
            asm volatile("" ::: "memory");
#pragma unroll
            for (int m = 0; m < 4; ++m)
#pragma unroll
                for (int bj = 0; bj < 2; ++bj) {
#pragma unroll
                    for (int q = 0; q < 4; ++q) { const unsigned wp = gp[m][bj][q], wn = gn[m][bj][q];
                        const float r0 = bflo(wp) * __builtin_amdgcn_rcpf(bflo(wn)), r1 = bfhi(wp) * __builtin_amdgcn_rcpf(bfhi(wn));
                        acc[ai][bj][m][q >> 1][(q & 1) * 2] *= r0; acc[ai][bj][m][q >> 1][(q & 1) * 2 + 1] *= r1; } }
            asm volatile("" ::: "memory");
        }
    }
    __device__ __forceinline__ void operator()(const f32x4 (&acc)[2][2][4][2], const Unit& u, int wr, int wc, int fr, int fq) const {
        const int row0 = u.pm * BM + wr * 64 + fr, col0 = u.pn * BM + wc * 32 + 8 * fq;
#pragma unroll
        for (int ai = 0; ai < 2; ++ai) {
            u32x4 gm[4][2];
#pragma unroll
            for (int m = 0; m < 4; ++m)
#pragma unroll
                for (int bj = 0; bj < 2; ++bj) gm[m][bj] = *(const u32x4*)(gates + (size_t)(row0 + ai * HALF + m * 16) * 12288 + 8192 + col0 + bj * HALF);
            asm volatile("" ::: "memory");
#pragma unroll
            for (int m = 0; m < 4; ++m) { const size_t r = (size_t)(row0 + ai * HALF + m * 16);
#pragma unroll
                for (int bj = 0; bj < 2; ++bj) { float o[8];
#pragma unroll
                    for (int q = 0; q < 4; ++q) { o[2 * q] = acc[ai][bj][m][q >> 1][(q & 1) * 2] * bflo(gm[m][bj][q]); o[2 * q + 1] = acc[ai][bj][m][q >> 1][(q & 1) * 2 + 1] * bfhi(gm[m][bj][q]); }
                    u32x4 w; w.x = cvt_pk_bf16(o[0], o[1]); w.y = cvt_pk_bf16(o[2], o[3]); w.z = cvt_pk_bf16(o[4], o[5]); w.w = cvt_pk_bf16(o[6], o[7]);
                    *(u32x4*)(y + tiled_off((int)r, col0 + bj * HALF, DM / 64)) = w; } }
            asm volatile("" ::: "memory");
        }
    }
};

struct EpiWo {
    static constexpr bool PERM = true, HOOK = false; static constexpr int H1 = -1, H2 = -1;
    const float* xin; bf16_t* x1b; bf16_t* h2; const float* gain; float* part;
    __device__ __forceinline__ void hook(f32x4 (&)[2][2][4][2], const Unit&, int, int, int, int, int) {}
    __device__ __forceinline__ void operator()(const f32x4 (&acc)[2][2][4][2], const Unit& u, int wr, int wc, int fr, int fq) const {
        const int row0 = u.pm * BM + wr * 64 + fr, col0 = u.pn * BM + wc * 32 + 8 * fq;
        f32x4 gv[2][2];
#pragma unroll
        for (int bj = 0; bj < 2; ++bj)
#pragma unroll
            for (int n = 0; n < 2; ++n) gv[bj][n] = *(const f32x4*)(gain + col0 + bj * HALF + n * 4);
#pragma unroll
        for (int ai = 0; ai < 2; ++ai) {
#pragma unroll
            for (int mp = 0; mp < 2; ++mp) {
            f32x4 xv[2][2][2];
#pragma unroll
            for (int m2 = 0; m2 < 2; ++m2)
#pragma unroll
                for (int bj = 0; bj < 2; ++bj)
#pragma unroll
                    for (int n = 0; n < 2; ++n) xv[m2][bj][n] = *(const f32x4*)(xin + (size_t)(row0 + ai * HALF + (2 * mp + m2) * 16) * DM + col0 + bj * HALF + n * 4);
            asm volatile("" ::: "memory");
#pragma unroll
            for (int m2 = 0; m2 < 2; ++m2) { const int m = 2 * mp + m2; const int r = row0 + ai * HALF + m * 16; const size_t off = (size_t)r * DM + col0; float s = 0.f;
#pragma unroll
                for (int bj = 0; bj < 2; ++bj) { u32x4 wx, wh;
#pragma unroll
                    for (int n = 0; n < 2; ++n) { const f32x4 x1 = xv[m2][bj][n] + acc[ai][bj][m][n];
                        s += (x1[0] * x1[0] + x1[1] * x1[1]) + (x1[2] * x1[2] + x1[3] * x1[3]);
                        const f32x4 hv = x1 * gv[bj][n];
                        wx[2 * n] = cvt_pk_bf16(x1[0], x1[1]); wx[2 * n + 1] = cvt_pk_bf16(x1[2], x1[3]);
                        wh[2 * n] = cvt_pk_bf16(hv[0], hv[1]); wh[2 * n + 1] = cvt_pk_bf16(hv[2], hv[3]); }
                    *(u32x4*)(x1b + off + bj * HALF) = wx;
                    *(u32x4*)(h2 + tiled_off(r, col0 + bj * HALF, DM / 64)) = wh; }
                s += __shfl_xor(s, 16); s += __shfl_xor(s, 32);
                if (fq == 0) part[(size_t)(u.pn * 4 + wc) * M + r] = s; }
            asm volatile("" ::: "memory");
            }
        }
    }
};

struct EpiFfnIn {
    static constexpr bool PERM = true, HOOK = false; static constexpr int H1 = -1, H2 = -1;
    bf16_t* hid; const LAS float* rs;
    __device__ __forceinline__ void hook(f32x4 (&)[2][2][4][2], const Unit&, int, int, int, int, int) {}
    __device__ __forceinline__ void operator()(const f32x4 (&acc)[2][2][4][2], const Unit& u, int wr, int wc, int fr, int fq) const {
        const int rl0 = wr * 64 + fr, col0 = u.pn * HALF + wc * 32 + 8 * fq;
#pragma unroll
        for (int ai = 0; ai < 2; ++ai)
#pragma unroll
            for (int m = 0; m < 4; ++m) { const int rl = rl0 + ai * HALF + m * 16; const float sc = rs[rl]; float o[8];
#pragma unroll
                for (int n = 0; n < 2; ++n)
#pragma unroll
                    for (int j = 0; j < 4; ++j) { const float gt = acc[ai][0][m][n][j] * sc, up = acc[ai][1][m][n][j] * sc; o[4 * n + j] = siluf_(gt) * up; }
                u32x4 w; w.x = cvt_pk_bf16(o[0], o[1]); w.y = cvt_pk_bf16(o[2], o[3]); w.z = cvt_pk_bf16(o[4], o[5]); w.w = cvt_pk_bf16(o[6], o[7]);
                *(u32x4*)(hid + tiled_off(u.pm * BM + rl, col0, DFF / 64)) = w;
                asm volatile("" ::: "memory"); }
    }
};
struct RsOrder : StaticOrder {
    const float* part; LAS float* rs; int cur_pm;
    __device__ __forceinline__ void a_ready(const Unit& u) {
        if (u.pm == cur_pm) return;
        cur_pm = u.pm;
        const int tid = threadIdx.x, row = tid >> 1, hf = tid & 1; float s = 0.f;
        const float* p = part + (size_t)(hf * 32) * M + (size_t)u.pm * BM + row;
#pragma unroll 8
        for (int j = 0; j < 32; ++j) s += p[(size_t)j * M];
        s += __shfl_xor(s, 1);
        if (hf == 0) rs[row] = 1.0f / sqrtf(s * (1.0f / DM) + EPS);
        asm volatile("s_waitcnt lgkmcnt(0)" ::: "memory");
    }
};

struct EpiFfnOut {
    static constexpr bool PERM = true, HOOK = false; static constexpr int H1 = -1, H2 = -1;
    bf16_t* x1b; float* part;
    __device__ __forceinline__ void hook(f32x4 (&)[2][2][4][2], const Unit&, int, int, int, int, int) {}
    __device__ __forceinline__ void operator()(const f32x4 (&acc)[2][2][4][2], const Unit& u, int wr, int wc, int fr, int fq) const {
        const int row0 = u.pm * BM + wr * 64 + fr, col0 = u.pn * BM + wc * 32 + 8 * fq;
#pragma unroll
        for (int ai = 0; ai < 2; ++ai) {
            u32x4 xv[4][2];
#pragma unroll
            for (int m = 0; m < 4; ++m)
#pragma unroll
                for (int bj = 0; bj < 2; ++bj) xv[m][bj] = *(const u32x4*)(x1b + (size_t)(row0 + ai * HALF + m * 16) * DM + col0 + bj * HALF);
            asm volatile("" ::: "memory");
#pragma unroll
            for (int m = 0; m < 4; ++m) { const int r = row0 + ai * HALF + m * 16; const size_t off = (size_t)r * DM + col0; float s = 0.f;
#pragma unroll
                for (int bj = 0; bj < 2; ++bj) { u32x4 wx;
#pragma unroll
                    for (int n = 0; n < 2; ++n) { const unsigned w0 = xv[m][bj][2 * n], w1 = xv[m][bj][2 * n + 1];
                        const f32x4 x1 = {bflo(w0), bfhi(w0), bflo(w1), bfhi(w1)}; const f32x4 x2 = x1 + acc[ai][bj][m][n];
                        s += (x2[0] * x2[0] + x2[1] * x2[1]) + (x2[2] * x2[2] + x2[3] * x2[3]);
                        wx[2 * n] = cvt_pk_bf16(x2[0], x2[1]); wx[2 * n + 1] = cvt_pk_bf16(x2[2], x2[3]); }
                    *(u32x4*)(x1b + off + bj * HALF) = wx; }
                s += __shfl_xor(s, 16); s += __shfl_xor(s, 32);
                if (fq == 0) part[(size_t)(u.pn * 4 + wc) * M + r] = s; }
            asm volatile("" ::: "memory");
        }
    }
};
}

#define XB_TMO      128
#define XB_XCNT(j)  (256  + 64 * (j))
#define XB_XSUB(j)  (1280 + 64 * (j))
#define XB_XGEN(j)  (2304 + 64 * (j))
#define XB_TOP      3328
#define XB_TOPGEN   3392
#define XCD_BAR_WORDS 3456
#define XB_SPIN_CAP (1u << 18)
__device__ __forceinline__ unsigned xb_ld(unsigned* p)              { return __hip_atomic_load(p, __ATOMIC_RELAXED, __HIP_MEMORY_SCOPE_AGENT); }
__device__ __forceinline__ unsigned xb_add(unsigned* p, unsigned v) { return __hip_atomic_fetch_add(p, v, __ATOMIC_RELAXED, __HIP_MEMORY_SCOPE_AGENT); }
__device__ __forceinline__ unsigned xb_xcc_id() { return (unsigned)__builtin_amdgcn_s_getreg((3 << 11) | 20) & 0xFu; }
#define XB_SPIN(cond, bar) do { unsigned _sp = 0; while (cond) { __builtin_amdgcn_s_sleep(1); \
    if ((++_sp & 255u) == 0u) { if (xb_ld(&(bar)[XB_TMO])) break; if (_sp > XB_SPIN_CAP) { atomicAdd(&(bar)[XB_TMO], 1u); break; } } } } while (0)
struct XcdBarrier { unsigned* bar; unsigned x; volatile LAS unsigned* st; };
__device__ __forceinline__ XcdBarrier xcd_barrier_post(unsigned* bar, volatile LAS unsigned* st) {
    XcdBarrier b; b.bar = bar; b.x = xb_xcc_id(); b.st = st;
    if (threadIdx.x == 0) (void)xb_add(&bar[XB_XCNT(b.x)], 1u);
    return b;
}
__device__ __forceinline__ void xcd_barrier_complete(unsigned* bar, unsigned x, unsigned& nloc, unsigned& nx) {
    const unsigned G = gridDim.x * gridDim.y * gridDim.z;
    unsigned sum, cnt, mine, sp = 0u;
    for (;;) {
        sum = 0u; cnt = 0u; mine = 0u;
#pragma unroll
        for (unsigned j = 0; j < 16; ++j) { const unsigned c = xb_ld(&bar[XB_XCNT(j)]); sum += c; cnt += (c > 0u) ? 1u : 0u; mine = (j == x) ? c : mine; }
        if (sum == G) break;
        __builtin_amdgcn_s_sleep(1);
        if ((++sp & 255u) == 0u) { if (xb_ld(&bar[XB_TMO])) break; if (sp > XB_SPIN_CAP) { atomicAdd(&bar[XB_TMO], 1u); break; } }
    }
    nloc = mine > 0u ? mine : 1u; nx = cnt > 0u ? cnt : 1u;
}
__device__ __forceinline__ void xcd_barrier(const XcdBarrier& b) {
    asm volatile("s_waitcnt vmcnt(0)" ::: "memory");
    __syncthreads();
    if (threadIdx.x == 0) {
        unsigned* bar = b.bar;
        __builtin_amdgcn_s_waitcnt(0);
        unsigned nloc = b.st[0], nx = b.st[1];
        if (nloc == 0u) { xcd_barrier_complete(bar, b.x, nloc, nx); b.st[0] = nloc; b.st[1] = nx; }
        const unsigned old = xb_add(&bar[XB_XSUB(b.x)], 1u);
        const unsigned gen = old / nloc;
        if (old + 1u == (gen + 1u) * nloc) {
            __builtin_amdgcn_fence(__ATOMIC_RELEASE, "agent");
            asm volatile("s_waitcnt vmcnt(0)" ::: "memory");
            const unsigned og = xb_add(&bar[XB_TOP], 1u);
            const unsigned tg = og / nx;
            if (og + 1u == (tg + 1u) * nx) xb_add(&bar[XB_TOPGEN], 1u);
            else XB_SPIN(xb_ld(&bar[XB_TOPGEN]) == tg, bar);
            __builtin_amdgcn_fence(__ATOMIC_ACQUIRE, "agent");
            xb_add(&bar[XB_XGEN(b.x)], 1u);
            asm volatile("s_waitcnt vmcnt(0)" ::: "memory");
        } else {
            XB_SPIN(xb_ld(&bar[XB_XGEN(b.x)]) == gen, bar);
            __builtin_amdgcn_fence(__ATOMIC_ACQUIRE, "agent");
            asm volatile("s_waitcnt vmcnt(0)" ::: "memory");
        }
    }
    __syncthreads();
}

struct Args {
    const float *x, *mem, *rel_bias, *g_mix, *w_in, *conv_w, *a_log, *dt_bias, *g_dn_out, *sinks, *g_mem, *w_mem_kv, *w_br_a, *w_br_b, *w_br_m, *w_o, *g_ffn, *w_ffn_in, *w_ffn_out, *g_final;
    float* out; unsigned char* ws; int ph_lo, ph_hi;
};
constexpr int NPHASE = 10;

__device__ __forceinline__ void p0_transpose_item(const float* W, int ldw, int src_col0, int k0, bf16_t* WT, size_t dst_row0, int ldt  , int dst_k0, LAS float* scr, int lane) {
    if (src_col0 >= 0) {
#pragma unroll 8
        for (int i = 0; i < 32; ++i) { const int kk = 2 * i + (lane >> 5); scr[kk * 33 + (lane & 31)] = W[(size_t)(k0 + kk) * ldw + src_col0 + (lane & 31)]; }
    } else {
#pragma unroll 8
        for (int i = 0; i < 32; ++i) { const int kk = 2 * i + (lane >> 5); scr[kk * 33 + (lane & 31)] = 0.f; }
    }
    asm volatile("s_waitcnt lgkmcnt(0)" ::: "memory");
    const int c = lane & 7;
#pragma unroll
    for (int j = 0; j < 4; ++j) { const int n = (lane >> 3) + 8 * j; const LAS float* s = scr + (8 * c) * 33 + n;
        u32x4 o; o.x = pk2(s[0 * 33], s[1 * 33]); o.y = pk2(s[2 * 33], s[3 * 33]); o.z = pk2(s[4 * 33], s[5 * 33]); o.w = pk2(s[6 * 33], s[7 * 33]);
        *(u32x4*)(WT + tiled_off((int)dst_row0 + n, dst_k0 + k0 + 8 * c, ldt / 64)) = o; }
    asm volatile("s_waitcnt lgkmcnt(0)" ::: "memory");
}
__device__ __forceinline__ void rms_row_to_bf16(const float* xrow, const float* gain, bf16_t* obase, int row, int lane) {
    const f32x4* xr = (const f32x4*)xrow + lane; const f32x4* gr = (const f32x4*)gain + lane;
    f32x4 v[16]; float s = 0.f;
#pragma unroll
    for (int j = 0; j < 16; ++j) { v[j] = xr[64 * j]; s += (v[j][0] * v[j][0] + v[j][1] * v[j][1]) + (v[j][2] * v[j][2] + v[j][3] * v[j][3]); }
    const float rstd = 1.0f / sqrtf(wave_sum(s) * (1.0f / DM) + EPS);
#pragma unroll
    for (int j = 0; j < 16; ++j) { const f32x4 gv = gr[64 * j]; u32x2 w; w.x = pk2(v[j][0] * rstd * gv[0], v[j][1] * rstd * gv[1]); w.y = pk2(v[j][2] * rstd * gv[2], v[j][3] * rstd * gv[3]);
        *(u32x2*)(obase + tiled_off(row, 4 * lane + 256 * j, DM / 64)) = w; }
}

__device__ __forceinline__ int t5_bucket_dev(int n) {
    if (n < 16) return n;
    const float nf = (float)n;
    int large = 16 + (int)(logf(nf / 16.0f) / 2.0794415416798357f * 16.0f);
    return large < 31 ? large : 31;
}
constexpr int GDN_UNITS = BATCH * B_HEADS * (SEQ / 64);
constexpr int L_QS = 0, L_KS = 17408, L_RT = 34816, L_KDT = 71680, L_AM = 90112, L_TB = 107520, L_G = 116736, L_CW = 117504;
__device__ __forceinline__ f32x4 mfma16(bf16x8 a, bf16x8 b, f32x4 c) { return __builtin_amdgcn_mfma_f32_16x16x32_bf16(a, b, c, 0, 0, 0); }
__device__ __forceinline__ int perm_pos(int t) { const int t32 = t & 31; return (t & 32) + 8 * ((t32 >> 2) & 3) + 4 * (t32 >> 4) + (t32 & 3); }

constexpr int L_DINV = 123648;
struct GdnRaw { u32x4 w[3][4][2]; };
__device__ __forceinline__ void gdn_load_raw(GdnRaw& R, int unit, const bf16_t* bqkv, int tid) {
    const int bh = unit >> 7, n = unit & 127, b = bh >> 4, h = bh & 15, t = tid >> 3, c0 = (tid & 7) * 16;
    const long tok0 = (long)b * SEQ + (long)n * 64;
#pragma unroll
    for (int xi = 0; xi < 3; ++xi)
#pragma unroll
        for (int j = 0; j < 4; ++j) { const int row = t + j - 3;
            if (n * 64 + row >= 0) { const bf16_t* src = bqkv + (size_t)(tok0 + row) * 6144 + xi * 2048 + h * 128 + c0;
                R.w[xi][j][0] = *(const u32x4*)src; R.w[xi][j][1] = *(const u32x4*)(src + 8); }
            else { R.w[xi][j][0] = (u32x4){0u, 0u, 0u, 0u}; R.w[xi][j][1] = (u32x4){0u, 0u, 0u, 0u}; } }
}
__device__ __forceinline__ f32x4 mfma4f(float a, float b, f32x4 c) { return __builtin_amdgcn_mfma_f32_16x16x4f32(a, b, c, 0, 0, 0); }

__device__ __forceinline__ void gdn_local_unit(int unit, const Args& a, LAS unsigned char* lds0, const bf16_t* bqkv, const float* ba,
        bf16_t* GW, bf16_t* GKDT, bf16_t* GATT, float* GL, bf16_t* GQG, bf16_t* GUT, int tid0, int wave) {
    LAS unsigned char* lds = lds0; asm volatile("" : "+v"(lds));
    int tid = tid0; asm volatile("" : "+v"(tid));
    const int lane = tid & 63;
    const int bh = unit >> 7, n = unit & 127, b = bh >> 4, h = bh & 15, fr = lane & 15, fq = lane >> 4;
    const long tok0 = (long)b * SEQ + (long)n * 64;
    LAS float* CW = (LAS float*)(lds + L_CW);
    LAS float* Gs = (LAS float*)(lds + L_G); LAS float* GCs = Gs + 64; LAS float* BTs = Gs + 128;
    const int t = tid >> 3, cg = tid & 7, c0 = cg * 16;
#ifndef GP_A
#define GP_A 1
#define GP_B 1
#define GP_C 1
#define GP_D 1
#endif
    for (int rrA = 0; rrA < GP_A; ++rrA) {
    float beta;
    { const float bb = ba[(tok0 + t) * 32 + h], bav = ba[(tok0 + t) * 32 + 16 + h];
      beta = sigmoidf_(bb); const float z = bav + a.dt_bias[h]; const float sp = z > 20.f ? z : log1pf(__expf(z));
      const float g = -__expf(a.a_log[h]) * sp;
      if (cg == 0) { Gs[t] = g; BTs[t] = beta; } }
    __syncthreads();
    if (wave == 0) { float v = Gs[lane];
#pragma unroll
        for (int o = 1; o < 64; o <<= 1) { const float u = __shfl_up(v, o); if (lane >= o) v += u; }
        GCs[lane] = v; }
    float y[3][16];
#pragma unroll
    for (int xi = 0; xi < 3; ++xi) {
#pragma unroll
        for (int i = 0; i < 16; ++i) y[xi][i] = 0.f;
#pragma unroll
        for (int j = 0; j < 4; ++j) {
            const int row = t + j - 3;
            if (j == 2) asm volatile("" ::: "memory");
            const bool rok = (n * 64 + row >= 0);
            const bf16_t* src = bqkv + (size_t)(tok0 + (rok ? row : 0)) * 6144 + xi * 2048 + h * 128 + c0;
            u32x4 w0 = *(const u32x4*)src, w1 = *(const u32x4*)(src + 8);
            const unsigned msk = rok ? 0xffffffffu : 0u; w0 = w0 & msk; w1 = w1 & msk;
            const LAS float* cw = CW + xi * 512 + j * 128 + c0;
            const f32x4 k0 = *(const LAS f32x4*)cw, k1 = *(const LAS f32x4*)(cw + 4), k2 = *(const LAS f32x4*)(cw + 8), k3 = *(const LAS f32x4*)(cw + 12);
            y[xi][0] += k0[0] * bflo(w0[0]); y[xi][1] += k0[1] * bfhi(w0[0]); y[xi][2] += k0[2] * bflo(w0[1]); y[xi][3] += k0[3] * bfhi(w0[1]);
            y[xi][4] += k1[0] * bflo(w0[2]); y[xi][5] += k1[1] * bfhi(w0[2]); y[xi][6] += k1[2] * bflo(w0[3]); y[xi][7] += k1[3] * bfhi(w0[3]);
            y[xi][8] += k2[0] * bflo(w1[0]); y[xi][9] += k2[1] * bfhi(w1[0]); y[xi][10] += k2[2] * bflo(w1[1]); y[xi][11] += k2[3] * bfhi(w1[1]);
            y[xi][12] += k3[0] * bflo(w1[2]); y[xi][13] += k3[1] * bfhi(w1[2]); y[xi][14] += k3[2] * bflo(w1[3]); y[xi][15] += k3[3] * bfhi(w1[3]);
        }
#pragma unroll
        for (int i = 0; i < 16; ++i) y[xi][i] = siluf_(y[xi][i]);
        asm volatile("" ::: "memory");
    }
    float sq = 0.f, sk = 0.f;
#pragma unroll
    for (int i = 0; i < 16; ++i) { sq += y[0][i] * y[0][i]; sk += y[1][i] * y[1][i]; }
    sq += __shfl_xor(sq, 1); sq += __shfl_xor(sq, 2); sq += __shfl_xor(sq, 4);
    sk += __shfl_xor(sk, 1); sk += __shfl_xor(sk, 2); sk += __shfl_xor(sk, 4);
    const float rq = __builtin_amdgcn_rsqf(sq + EPS) * 0.08838834764831845f, rk = __builtin_amdgcn_rsqf(sk + EPS);
    __syncthreads();
    const float gct = GCs[t], glast = GCs[63];
    const float e1 = __expf(gct), e2 = __expf(glast - gct);
    if (tid == 0) GL[unit] = __expf(glast);
    {
        u32x4 kq[2], qq[2], qg[2];
#pragma unroll
        for (int i = 0; i < 8; ++i) { const float k0 = y[1][2 * i] * rk, k1 = y[1][2 * i + 1] * rk, q0 = y[0][2 * i] * rq, q1 = y[0][2 * i + 1] * rq;
            kq[i >> 2][i & 3] = cvt_pk_bf16(k0, k1); qq[i >> 2][i & 3] = cvt_pk_bf16(q0, q1); qg[i >> 2][i & 3] = cvt_pk_bf16(q0 * e1, q1 * e1); }
        *(LAS u32x4*)(lds + L_KS + t * 272 + c0 * 2) = kq[0]; *(LAS u32x4*)(lds + L_KS + t * 272 + c0 * 2 + 16) = kq[1];
        *(LAS u32x4*)(lds + L_QS + t * 272 + c0 * 2) = qq[0]; *(LAS u32x4*)(lds + L_QS + t * 272 + c0 * 2 + 16) = qq[1];
        bf16_t* qgp = GQG + (size_t)unit * 8192 + t * 128 + (c0 & ~31) + 4 * (cg & 1);
        *(u32x2*)(qgp) = (u32x2){qg[0].x, qg[0].y}; *(u32x2*)(qgp + 8) = (u32x2){qg[0].z, qg[0].w}; *(u32x2*)(qgp + 16) = (u32x2){qg[1].x, qg[1].y}; *(u32x2*)(qgp + 24) = (u32x2){qg[1].z, qg[1].w};
    }
    {
        const int tp = (t + 8 * cg) & 63, pt = (perm_pos(t) + 8 * cg) & 63;
#pragma unroll
        for (int i = 0; i < 16; i += 2) { const float kn0 = y[1][i] * rk, kn1 = y[1][i + 1] * rk;
            const unsigned pv = cvt_pk_bf16(beta * y[2][i], beta * y[2][i + 1]), pk = cvt_pk_bf16(beta * kn0 * e1, beta * kn1 * e1), pd = cvt_pk_bf16(kn0 * e2, kn1 * e2);
            *(LAS unsigned short*)(lds + L_RT + (c0 + i) * 144 + tp * 2) = (unsigned short)(pv & 0xffffu); *(LAS unsigned short*)(lds + L_RT + (c0 + i + 1) * 144 + tp * 2) = (unsigned short)(pv >> 16);
            *(LAS unsigned short*)(lds + L_RT + (128 + c0 + i) * 144 + tp * 2) = (unsigned short)(pk & 0xffffu); *(LAS unsigned short*)(lds + L_RT + (128 + c0 + i + 1) * 144 + tp * 2) = (unsigned short)(pk >> 16);
            *(LAS unsigned short*)(lds + L_KDT + (c0 + i) * 144 + pt * 2) = (unsigned short)(pd & 0xffffu); *(LAS unsigned short*)(lds + L_KDT + (c0 + i + 1) * 144 + pt * 2) = (unsigned short)(pd >> 16); }
    }
    __syncthreads();
    }
    for (int rrB = 0; rrB < GP_B; ++rrB) {
#pragma unroll
    for (int q = 0; q < 2; ++q) {
        const int idx = 2 * wave + q, ct = idx >> 2, st = idx & 3;
        f32x4 acc = (f32x4){0.f, 0.f, 0.f, 0.f}, acc2 = (f32x4){0.f, 0.f, 0.f, 0.f};
        if (st <= ct) {
#pragma unroll
            for (int kk = 0; kk < 4; ++kk) {
                const bf16x8 kc = *(const LAS bf16x8*)(lds + L_KS + (ct * 16 + fr) * 272 + (32 * kk + 8 * fq) * 2);
                const bf16x8 ks = *(const LAS bf16x8*)(lds + L_KS + (st * 16 + fr) * 272 + (32 * kk + 8 * fq) * 2);
                const bf16x8 qc = *(const LAS bf16x8*)(lds + L_QS + (ct * 16 + fr) * 272 + (32 * kk + 8 * fq) * 2);
                acc = mfma16(kc, ks, acc);
                acc2 = mfma16(ks, qc, acc2);
            }
        }
        {   const int sc = st * 16 + fr; const float gcs = GCs[sc];
#pragma unroll
            for (int r = 0; r < 4; ++r) { const int c = ct * 16 + 4 * fq + r; const float dl = fminf(GCs[c] - gcs, 0.f);
                const float v = (sc < c) ? BTs[c] * acc[r] * __expf(dl) : 0.f;
                *(LAS float*)(lds + L_AM + c * 272 + sc * 4) = v; } }
        {   const int c = ct * 16 + fr; const float gcc = GCs[c]; float o[4];
#pragma unroll
            for (int r = 0; r < 4; ++r) { const int sr = st * 16 + 4 * fq + r; const float dl = fminf(gcc - GCs[sr], 0.f); o[r] = (sr <= c) ? acc2[r] * __expf(dl) : 0.f; }
            u32x2 w; w.x = cvt_pk_bf16(o[0], o[1]); w.y = cvt_pk_bf16(o[2], o[3]);
            *(u32x2*)(GATT + (size_t)unit * 4096 + c * 64 + 32 * (st >> 1) + 8 * fq + 4 * (st & 1)) = w; }
    }
    __syncthreads();
    }
    for (int rrC = 0; rrC < GP_C; ++rrC) {
    if (wave < 4) {
        const int bi = wave; float x[16];
#pragma unroll
        for (int i = 0; i < 16; ++i) x[i] = 0.f;
#pragma unroll
        for (int i = 0; i < 16; ++i) {
            float s0 = (fr == i) ? 1.f : 0.f, s1 = 0.f, s2 = 0.f, s3 = 0.f;
#pragma unroll
            for (int m4 = 0; m4 < (i + 3) / 4; ++m4) { const f32x4 a4 = *(const LAS f32x4*)(lds + L_AM + (16 * bi + i) * 272 + (16 * bi) * 4 + m4 * 16);
                s0 -= a4[0] * x[4 * m4]; s1 -= a4[1] * x[4 * m4 + 1]; s2 -= a4[2] * x[4 * m4 + 2]; s3 -= a4[3] * x[4 * m4 + 3]; }
            x[i] = (s0 + s1) + (s2 + s3);
        }
        if (fq == 0) {
#pragma unroll
            for (int i = 0; i < 16; ++i) { *(LAS float*)(lds + L_DINV + bi * 1280 + i * 80 + fr * 4) = x[i];
                *(LAS unsigned short*)(lds + L_TB + (16 * bi + i) * 144 + (16 * bi + fr) * 2) = (unsigned short)(cvt_pk_bf16(x[i], 0.f) & 0xffffu); }
        } else {
            const int bj = bi + fq;
            if (bj < 4) {
#pragma unroll
                for (int i = 0; i < 16; ++i) *(LAS unsigned short*)(lds + L_TB + (16 * bi + i) * 144 + (16 * bj + fr) * 2) = (unsigned short)0; }
        }
    } else {
        for (int idx = tid - 256; idx < 1024; idx += 256) { const int row = idx >> 3, ch = idx & 7;
            *(u32x4*)(GKDT + (size_t)unit * 8192 + row * 64 + ch * 8) = *(const LAS u32x4*)(lds + L_KDT + row * 144 + (((8 * ch + 8 * (row >> 4)) & 63) * 2)); }
    }
    __syncthreads();
    if (wave < 3) {
        const int j = wave;
        f32x4 Tc[4];
#pragma unroll
        for (int k = 0; k < 4; ++k) Tc[k] = (f32x4){0.f, 0.f, 0.f, 0.f};
#pragma unroll
        for (int k = 0; k < 3; ++k) if (k == j) {
#pragma unroll
            for (int kk = 0; kk < 4; ++kk) Tc[k][kk] = *(const LAS float*)(lds + L_DINV + k * 1280 + (4 * fq + kk) * 80 + fr * 4); }
#pragma unroll
        for (int i = 1; i < 4; ++i) if (i > j) {
            f32x4 Mx = (f32x4){0.f, 0.f, 0.f, 0.f};
#pragma unroll
            for (int k = 0; k < 3; ++k) if (k >= j && k < i) {
                const f32x4 a4 = *(const LAS f32x4*)(lds + L_AM + (16 * i + fr) * 272 + (16 * k + 4 * fq) * 4);
#pragma unroll
                for (int kk = 0; kk < 4; ++kk) Mx = mfma4f(a4[kk], Tc[k][kk], Mx); }
            f32x4 Tx = (f32x4){0.f, 0.f, 0.f, 0.f};
            const f32x4 d4 = *(const LAS f32x4*)(lds + L_DINV + i * 1280 + fr * 80 + (4 * fq) * 4);
#pragma unroll
            for (int kk = 0; kk < 4; ++kk) Tx = mfma4f(d4[kk], Mx[kk], Tx);
            Tc[i] = -Tx;
#pragma unroll
            for (int kk = 0; kk < 4; ++kk) *(LAS unsigned short*)(lds + L_TB + (16 * i + 4 * fq + kk) * 144 + (16 * j + fr) * 2) = (unsigned short)(cvt_pk_bf16(Tc[i][kk], 0.f) & 0xffffu);
        }
    }
    __syncthreads();
    }
    for (int rrD = 0; rrD < GP_D; ++rrD) {
#pragma unroll
    for (int q = 0; q < 4; ++q) {
        const int idx = 4 * wave + q;
        {   const int ct = idx >> 3, nt = idx & 7; f32x4 acc = (f32x4){0.f, 0.f, 0.f, 0.f};
#pragma unroll
            for (int kk = 0; kk < 2; ++kk) {
                const bf16x8 ta = *(const LAS bf16x8*)(lds + L_TB + (ct * 16 + fr) * 144 + (32 * kk + 8 * fq) * 2);
                const bf16x8 rb = *(const LAS bf16x8*)(lds + L_RT + (nt * 16 + fr) * 144 + (((32 * kk + 8 * fq + 8 * nt) & 63) * 2));
                acc = mfma16(ta, rb, acc); }
            u32x2 w; w.x = cvt_pk_bf16(acc[0], acc[1]); w.y = cvt_pk_bf16(acc[2], acc[3]);
            *(u32x2*)(GUT + (size_t)unit * 8192 + (nt * 16 + fr) * 64 + ct * 16 + 4 * fq) = w; }
        {   const int it = idx >> 2, ct = idx & 3; f32x4 acc = (f32x4){0.f, 0.f, 0.f, 0.f};
#pragma unroll
            for (int kk = 0; kk < 2; ++kk) {
                const bf16x8 ra = *(const LAS bf16x8*)(lds + L_RT + (128 + it * 16 + fr) * 144 + (((32 * kk + 8 * fq + 8 * it) & 63) * 2));
                const bf16x8 tb = *(const LAS bf16x8*)(lds + L_TB + (ct * 16 + fr) * 144 + (32 * kk + 8 * fq) * 2);
                acc = mfma16(ra, tb, acc); }
            u32x2 w; w.x = cvt_pk_bf16(acc[0], acc[1]); w.y = cvt_pk_bf16(acc[2], acc[3]);
            *(u32x2*)(GW + (size_t)unit * 8192 + (ct * 16 + fr) * 128 + 32 * (it >> 1) + 8 * fq + 4 * (it & 1)) = w; }
    }
    __syncthreads();
    }
}

constexpr int GS_SPW = 2, GS_SLOT = 36864, GS_D = 4;
__device__ __forceinline__ void gdn_scan(int bh, int sg, LAS unsigned char* lds, const bf16_t* GW, const bf16_t* GKDT, const bf16_t* GUT, const float* GL, bf16_t* GST, bf16_t* GVT, int tid, int lane, int wave) {
    const int fr = lane & 15, fq = lane >> 4;
    LAS float* DEC = (LAS float*)(lds + DEC_OFF);
    if (tid < 128) DEC[tid] = GL[bh * 128 + tid];
    const bool comp = wave < GS_SPW;
    const int slice = sg * GS_SPW + wave;
    const size_t ubase = (size_t)bh * 128;
    unsigned goff[6], dsto[6]; int kind[6];
#pragma unroll
    for (int k = 0; k < 6; ++k) { const int p = (wave - GS_SPW) * 6 + k;
        if (p < 16) { const int r = 4 * p + (lane >> 4), qd = lane & 15; goff[k] = (unsigned)(r * 256 + ((qd ^ (r & 15)) * 16)); dsto[k] = (unsigned)p * 1024u; kind[k] = 0; }
        else if (p < 32) { const int pp = p - 16, r = 8 * pp + (lane >> 3), qd = lane & 7; goff[k] = (unsigned)(r * 128 + ((qd ^ ((r >> 1) & 7)) * 16)); dsto[k] = 16384u + (unsigned)pp * 1024u; kind[k] = 1; }
        else { const int u = p - 32, cw = u >> 1, k2 = u & 1; goff[k] = (unsigned)((sg * GS_SPW + cw) * 2048 + k2 * 1024 + lane * 16); dsto[k] = 32768u + (unsigned)(cw * 2048 + k2 * 1024); kind[k] = 2; } }
#define GS_ISSUE(step, slot) do { if (!comp) { const size_t _u = ubase + (size_t)(step); \
        _Pragma("unroll") for (int _k = 0; _k < 6; ++_k) { const char* _g = (const char*)((kind[_k] == 0 ? GW : (kind[_k] == 1 ? GKDT : GUT)) + _u * 8192); \
            __builtin_amdgcn_global_load_lds((const unsigned*)(_g + goff[_k]), (LAS unsigned*)(lds + (slot) * GS_SLOT + dsto[_k]), 16, 0, 0); } } \
        asm volatile("" ::: "memory"); } while (0)
    f32x4 S[8];
#pragma unroll
    for (int i = 0; i < 8; ++i) S[i] = (f32x4){0.f, 0.f, 0.f, 0.f};
    asm volatile("s_waitcnt vmcnt(0) lgkmcnt(0)" ::: "memory");
    __builtin_amdgcn_s_barrier();
    GS_ISSUE(0, 0); GS_ISSUE(1, 1); GS_ISSUE(2, 2);
    for (int n = 0; n < 128; ++n) {
        if (!comp) asm volatile("s_waitcnt vmcnt(12)" ::: "memory");
        __builtin_amdgcn_s_barrier();
        asm volatile("" ::: "memory");
        { const int nn = n + 3 < 128 ? n + 3 : 127; const int sl = (n + 3) & 3; GS_ISSUE(nn, sl); }
        if (comp) {
            LAS const unsigned char* sb = lds + (n & 3) * GS_SLOT;
            const size_t unit = ubase + n;
            bf16x8 aw[4][4], ak[2][8];
#pragma unroll
            for (int kk = 0; kk < 4; ++kk)
#pragma unroll
                for (int ct = 0; ct < 4; ++ct) aw[kk][ct] = *(const LAS bf16x8*)(sb + (16 * ct + fr) * 256 + (((4 * kk + fq) ^ fr) * 16));
#pragma unroll
            for (int kk = 0; kk < 2; ++kk)
#pragma unroll
                for (int i = 0; i < 8; ++i) ak[kk][i] = *(const LAS bf16x8*)(sb + 16384 + (16 * i + fr) * 128 + (((4 * kk + fq) ^ ((fr >> 1) & 7)) * 16));
            u32x2 uu[4];
#pragma unroll
            for (int ct = 0; ct < 4; ++ct) uu[ct] = *(const LAS u32x2*)(sb + 32768 + wave * 2048 + fr * 128 + (16 * ct + 4 * fq) * 2);
            const float dec = DEC[n];
            asm volatile("" ::: "memory");
            bf16x8 bs[4];
#pragma unroll
            for (int kk = 0; kk < 4; ++kk) { u32x4 bw; bw.x = cvt_pk_bf16(S[2 * kk][0], S[2 * kk][1]); bw.y = cvt_pk_bf16(S[2 * kk][2], S[2 * kk][3]);
                bw.z = cvt_pk_bf16(S[2 * kk + 1][0], S[2 * kk + 1][1]); bw.w = cvt_pk_bf16(S[2 * kk + 1][2], S[2 * kk + 1][3]);
                *(u32x4*)(GST + unit * 16384 + (16 * slice + fr) * 128 + 32 * kk + 8 * fq) = bw;
                bs[kk] = __builtin_bit_cast(bf16x8, bw); }
            f32x4 av[4];
#pragma unroll
            for (int ct = 0; ct < 4; ++ct) av[ct] = (f32x4){0.f, 0.f, 0.f, 0.f};
#pragma unroll
            for (int kk = 0; kk < 4; ++kk)
#pragma unroll
                for (int ct = 0; ct < 4; ++ct) av[ct] = mfma16(aw[kk][ct], bs[kk], av[ct]);
            bf16x8 bv[2];
#pragma unroll
            for (int kk = 0; kk < 2; ++kk) { u32x4 bw;
                { const int ct = 2 * kk; bw.x = cvt_pk_bf16(bflo(uu[ct].x) - av[ct][0], bfhi(uu[ct].x) - av[ct][1]); bw.y = cvt_pk_bf16(bflo(uu[ct].y) - av[ct][2], bfhi(uu[ct].y) - av[ct][3]); }
                { const int ct = 2 * kk + 1; bw.z = cvt_pk_bf16(bflo(uu[ct].x) - av[ct][0], bfhi(uu[ct].x) - av[ct][1]); bw.w = cvt_pk_bf16(bflo(uu[ct].y) - av[ct][2], bfhi(uu[ct].y) - av[ct][3]); }
                *(u32x4*)(GVT + unit * 8192 + (16 * slice + fr) * 64 + 32 * kk + 8 * fq) = bw;
                bv[kk] = __builtin_bit_cast(bf16x8, bw); }
#pragma unroll
            for (int i = 0; i < 8; ++i) S[i] = S[i] * dec;
#pragma unroll
            for (int kk = 0; kk < 2; ++kk)
#pragma unroll
                for (int i = 0; i < 8; ++i) S[i] = mfma16(ak[kk][i], bv[kk], S[i]);
        }
    }
#undef GS_ISSUE
    asm volatile("s_waitcnt vmcnt(0)" ::: "memory");
    __builtin_amdgcn_s_barrier();
}

constexpr int GO_SLOT = 49152;
__device__ __forceinline__ void gdn_out_units(int u0, int nu, const Args& a, LAS unsigned char* lds, bf16_t* acat, bf16_t* odst, const bf16_t* GQG, const bf16_t* GATT, const bf16_t* GST, const bf16_t* GVT, int tid, int lane, int wave) {
    const int fr = lane & 15, fq = lane >> 4, ct = wave & 3, dvh = wave >> 2;
    LAS float* SSQ = (LAS float*)(lds + DEC_OFF);
    unsigned goff[6]; unsigned dsto[6]; bool isv[6];
#pragma unroll
    for (int k = 0; k < 6; ++k) { const int p = wave * 6 + k;
        if (p < 32) { const int r = 4 * p + (lane >> 4), qd = lane & 15; goff[k] = (unsigned)(r * 256 + ((qd ^ (r & 15)) * 16)); dsto[k] = (unsigned)p * 1024u; isv[k] = false; }
        else { const int pp = p - 32, r = 8 * pp + (lane >> 3), qd = lane & 7; goff[k] = (unsigned)(r * 128 + ((qd ^ ((r >> 1) & 7)) * 16)); dsto[k] = 32768u + (unsigned)pp * 1024u; isv[k] = true; } }
#define GO_ISSUE(unit, slot) do { const char* _s = (const char*)(GST + (size_t)(unit) * 16384); const char* _v = (const char*)(GVT + (size_t)(unit) * 8192); \
        _Pragma("unroll") for (int _k = 0; _k < 6; ++_k) __builtin_amdgcn_global_load_lds((const unsigned*)((isv[_k] ? _v : _s) + goff[_k]), (LAS unsigned*)(lds + (slot) * GO_SLOT + dsto[_k]), 16, 0, 0); \
        asm volatile("" ::: "memory"); } while (0)
    f32x4 gv[4];
#pragma unroll
    for (int i4 = 0; i4 < 4; ++i4) gv[i4] = *(const f32x4*)(a.g_dn_out + 16 * (4 * dvh + i4) + 4 * fq);
    asm volatile("s_waitcnt vmcnt(0) lgkmcnt(0)" ::: "memory");
    __builtin_amdgcn_s_barrier();
    GO_ISSUE(u0, 0); GO_ISSUE(u0 + (nu > 1 ? 1 : 0), 1);
    for (int i = 0; i < nu; ++i) {
        const int unit = u0 + i;
        if (i == 0) asm volatile("s_waitcnt vmcnt(6)" ::: "memory"); else if (i == 1) asm volatile("s_waitcnt vmcnt(20)" ::: "memory"); else asm volatile("s_waitcnt vmcnt(24)" ::: "memory");
        __builtin_amdgcn_s_barrier();
        asm volatile("" ::: "memory");
        const int bh = unit >> 7, n = unit & 127, b = bh >> 4, h = bh & 15;
        const bf16_t* qg = GQG + (size_t)unit * 8192 + (16 * ct + fr) * 128 + 8 * fq;
        const bf16_t* at = GATT + (size_t)unit * 4096 + (16 * ct + fr) * 64 + 8 * fq;
        bf16x8 bq[4], bt[2];
#pragma unroll
        for (int kk = 0; kk < 4; ++kk) bq[kk] = *(const bf16x8*)(qg + 32 * kk);
#pragma unroll
        for (int kk = 0; kk < 2; ++kk) bt[kk] = *(const bf16x8*)(at + 32 * kk);
        const size_t zoff = tiled_off(b * SEQ + n * 64 + 16 * ct + fr, 2048 + h * 128 + 64 * dvh + 4 * fq, KCAT / 64);
        u32x2 zz[4];
#pragma unroll
        for (int i4 = 0; i4 < 4; ++i4) zz[i4] = *(const u32x2*)(acat + zoff + 16 * i4);
        asm volatile("" ::: "memory");
        { const int un = (i + 2 < nu) ? unit + 2 : unit; GO_ISSUE(un, (i + 2) % 3); }
        LAS const unsigned char* sb = lds + (i % 3) * GO_SLOT;
        bf16x8 fs[4][4], fv[4][2];
#pragma unroll
        for (int i4 = 0; i4 < 4; ++i4) { const int row = 16 * (4 * dvh + i4) + fr;
#pragma unroll
            for (int kk = 0; kk < 4; ++kk) fs[i4][kk] = *(const LAS bf16x8*)(sb + row * 256 + (((4 * kk + fq) ^ fr) * 16));
#pragma unroll
            for (int kk = 0; kk < 2; ++kk) fv[i4][kk] = *(const LAS bf16x8*)(sb + 32768 + row * 128 + (((4 * kk + fq) ^ ((fr >> 1) & 7)) * 16)); }
        f32x4 o[4]; float ss = 0.f;
#pragma unroll
        for (int i4 = 0; i4 < 4; ++i4) { f32x4 acc = (f32x4){0.f, 0.f, 0.f, 0.f};
#pragma unroll
            for (int kk = 0; kk < 4; ++kk) acc = mfma16(fs[i4][kk], bq[kk], acc);
#pragma unroll
            for (int kk = 0; kk < 2; ++kk) acc = mfma16(fv[i4][kk], bt[kk], acc);
            o[i4] = acc; ss += (acc[0] * acc[0] + acc[1] * acc[1]) + (acc[2] * acc[2] + acc[3] * acc[3]); }
        ss += __shfl_xor(ss, 16); ss += __shfl_xor(ss, 32);
        LAS float* sq = SSQ + (i & 1) * 128;
        if (fq == 0) sq[dvh * 64 + ct * 16 + fr] = ss;
        asm volatile("s_waitcnt lgkmcnt(0)" ::: "memory");
        __builtin_amdgcn_s_barrier();
        asm volatile("" ::: "memory");
        const float tot = sq[ct * 16 + fr] + sq[64 + ct * 16 + fr];
        const float rstd = __builtin_amdgcn_rsqf(tot * (1.0f / 128.0f) + EPS);
#pragma unroll
        for (int i4 = 0; i4 < 4; ++i4) { const u32x2 z = zz[i4]; const f32x4 g = gv[i4];
            u32x2 w; w.x = pk2(o[i4][0] * rstd * g[0] * siluf_(bflo(z.x)), o[i4][1] * rstd * g[1] * siluf_(bfhi(z.x)));
            w.y = pk2(o[i4][2] * rstd * g[2] * siluf_(bflo(z.y)), o[i4][3] * rstd * g[3] * siluf_(bfhi(z.y)));
            *(u32x2*)(odst + zoff + 16 * i4) = w; }
        asm volatile("" ::: "memory");
    }
#undef GO_ISSUE
    asm volatile("s_waitcnt vmcnt(0)" ::: "memory");
    __builtin_amdgcn_s_barrier();
}

typedef float f32x16 __attribute__((ext_vector_type(16)));
__device__ __forceinline__ f32x16 mfma32(bf16x8 a, bf16x8 b, f32x16 c) { return __builtin_amdgcn_mfma_f32_32x32x16_bf16(a, b, c, 0, 0, 0); }
__device__ __forceinline__ int perm16(int k) { const int k16 = k & 15; return (k & ~15) + 8 * ((k16 >> 2) & 1) + 4 * (k16 >> 3) + (k16 & 3); }
__device__ __forceinline__ bf16x8 pack8(const f32x16& p, int base) {
    u32x4 w; w.x = cvt_pk_bf16(p[base + 0], p[base + 1]); w.y = cvt_pk_bf16(p[base + 2], p[base + 3]); w.z = cvt_pk_bf16(p[base + 4], p[base + 5]); w.w = cvt_pk_bf16(p[base + 6], p[base + 7]);
    return __builtin_bit_cast(bf16x8, w); }

constexpr int SW_VT = 36864, SW_BT = 70656;
__device__ __forceinline__ void swa_unit(int unit, const Args& a, LAS unsigned char* lds, bf16_t* acat, bf16_t* odst, const bf16_t* kva, int tid, int lane, int wave) {
    const int kvh = unit & 3, nb = (unit >> 2) & 63, b = unit >> 8, hq = kvh * 8 + wave;
    const long tok0 = (long)b * SEQ + (long)nb * 128, tokw = tok0 - 128;
#pragma unroll
    for (int i = 0; i < 4; ++i) { const int idx = tid + 512 * i, row = idx >> 3, ch = idx & 7; u32x4 v = (u32x4){0u, 0u, 0u, 0u};
        if (nb > 0 || row >= 128) v = *(const u32x4*)(kva + (size_t)(tokw + row) * 512 + kvh * 64 + ch * 8);
        *(LAS u32x4*)(lds + row * 144 + ch * 16) = v; }
#pragma unroll
    for (int i = 0; i < 4; ++i) { const int idx = tid + 512 * i, key = idx & 255, ch = idx >> 8; u32x4 v = (u32x4){0u, 0u, 0u, 0u};
        if (nb > 0 || key >= 128) v = *(const u32x4*)(kva + (size_t)(tokw + key) * 512 + 256 + kvh * 64 + ch * 8);
        const int pos = perm16(key);
#pragma unroll
        for (int e = 0; e < 4; ++e) { *(LAS unsigned short*)(lds + SW_VT + (8 * ch + 2 * e) * 528 + pos * 2) = (unsigned short)(v[e] & 0xffffu);
            *(LAS unsigned short*)(lds + SW_VT + (8 * ch + 2 * e + 1) * 528 + pos * 2) = (unsigned short)(v[e] >> 16); } }
    LAS float* BT = (LAS float*)(lds + SW_BT) + wave * 128;
    BT[lane] = a.rel_bias[t5_bucket_dev(lane) * A_HEADS + hq]; BT[lane + 64] = a.rel_bias[t5_bucket_dev(lane + 64) * A_HEADS + hq];
    __syncthreads();
    const int r = lane & 31, hh = lane >> 5;
    const float sink = a.sinks[hq];
#pragma unroll 1
    for (int i = 0; i < 4; ++i) {
        bf16_t* qrow = acat + tiled_off((int)tok0 + 32 * i + r, hq * 64, KCAT / 64);
        bf16x8 qf[4];
#pragma unroll
        for (int s = 0; s < 4; ++s) qf[s] = *(const bf16x8*)(qrow + 16 * s + 8 * hh);
        f32x16 sc[5];
#pragma unroll
        for (int d = 0; d < 5; ++d) { f32x16 acc;
#pragma unroll
            for (int e = 0; e < 16; ++e) acc[e] = 0.f;
#pragma unroll
            for (int s = 0; s < 4; ++s) acc = mfma32(*(const LAS bf16x8*)(lds + (32 * (i + d) + r) * 144 + (16 * s + 8 * hh) * 2), qf[s], acc);
            sc[d] = acc;  asm volatile("" ::: "memory"); }
        float mx = sink;
#pragma unroll
        for (int d = 0; d < 5; ++d) { const bool tile_ok = (nb > 0) || (i + d >= 4);
#pragma unroll
            for (int e = 0; e < 16; ++e) { const int krow = (e & 3) + 8 * (e >> 2) + 4 * hh, dist = 128 - 32 * d + r - krow;
                const bool valid = tile_ok && (d == 0 ? (krow > r) : (d == 4 ? (krow <= r) : true));
                const float v = valid ? sc[d][e] * 0.125f + BT[dist & 127] : -1e30f;
                sc[d][e] = v; mx = fmaxf(mx, v); }  asm volatile("" ::: "memory"); }
        mx = fmaxf(mx, __shfl_xor(mx, 32));
        float ls = 0.f;
#pragma unroll
        for (int d = 0; d < 5; ++d)
#pragma unroll
            for (int e = 0; e < 16; ++e) { const float p = __expf(sc[d][e] - mx); sc[d][e] = p; ls += p; }
        ls += __shfl_xor(ls, 32); ls += __expf(sink - mx);
        f32x16 o[2];
#pragma unroll
        for (int dt = 0; dt < 2; ++dt)
#pragma unroll
            for (int e = 0; e < 16; ++e) o[dt][e] = 0.f;
#pragma unroll
        for (int d = 0; d < 5; ++d)
#pragma unroll
            for (int s2 = 0; s2 < 2; ++s2) { const bf16x8 pf = pack8(sc[d], 8 * s2);
#pragma unroll
                for (int dt = 0; dt < 2; ++dt) o[dt] = mfma32(*(const LAS bf16x8*)(lds + SW_VT + (32 * dt + r) * 528 + (32 * (i + d) + 16 * s2) * 2 + hh * 16), pf, o[dt]);
                asm volatile("" ::: "memory"); }
        const float inv = 1.0f / ls;
#pragma unroll
        for (int dt = 0; dt < 2; ++dt)
#pragma unroll
            for (int g4 = 0; g4 < 4; ++g4) { u32x2 w; w.x = cvt_pk_bf16(o[dt][4 * g4] * inv, o[dt][4 * g4 + 1] * inv); w.y = cvt_pk_bf16(o[dt][4 * g4 + 2] * inv, o[dt][4 * g4 + 3] * inv);
                *(u32x2*)(odst + (qrow - acat) + 32 * dt + 8 * g4 + 4 * hh) = w; }
    }
    __syncthreads();
}

constexpr int MA_VT = 69632;
__device__ __forceinline__ void mem_unit(int unit, LAS unsigned char* lds, bf16_t* acat, bf16_t* odst, const bf16_t* mkv, int tid, int lane, int wave) {
    const int h = unit & 3, qb = (unit >> 2) & 31, b = unit >> 7;
    const bf16_t* kbase = mkv + (size_t)b * MEMLEN * 1024 + h * 128;
#pragma unroll
    for (int i = 0; i < 8; ++i) { const int idx = tid + 512 * i, row = idx >> 4, ch = idx & 15;
        *(LAS u32x4*)(lds + row * 272 + ch * 16) = *(const u32x4*)(kbase + (size_t)row * 1024 + ch * 8); }
#pragma unroll
    for (int i = 0; i < 8; ++i) { const int idx = tid + 512 * i, key = idx & 255, ch = idx >> 8;
        const u32x4 v = *(const u32x4*)(kbase + (size_t)key * 1024 + 512 + ch * 8);
        const int pos = perm16(key);
#pragma unroll
        for (int e = 0; e < 4; ++e) { *(LAS unsigned short*)(lds + MA_VT + (8 * ch + 2 * e) * 528 + pos * 2) = (unsigned short)(v[e] & 0xffffu);
            *(LAS unsigned short*)(lds + MA_VT + (8 * ch + 2 * e + 1) * 528 + pos * 2) = (unsigned short)(v[e] >> 16); } }
    __syncthreads();
    const int r = lane & 31, hh = lane >> 5;
    bf16_t* qrow = acat + tiled_off(b * SEQ + qb * 256 + 32 * wave + r, 4096 + h * 128, KCAT / 64);
    bf16x8 qf[8];
#pragma unroll
    for (int s = 0; s < 8; ++s) qf[s] = *(const bf16x8*)(qrow + (s >> 2) * 8192 + 16 * (s & 3) + 8 * hh);
    f32x16 o[4];
#pragma unroll
    for (int dt = 0; dt < 4; ++dt)
#pragma unroll
        for (int e = 0; e < 16; ++e) o[dt][e] = 0.f;
    float mx = -1e30f, ls = 0.f;
#pragma unroll 1
    for (int grp = 0; grp < 4; ++grp) {
        f32x16 sc[2]; float gm = -1e30f;
#pragma unroll
        for (int d = 0; d < 2; ++d) { f32x16 acc;
#pragma unroll
            for (int e = 0; e < 16; ++e) acc[e] = 0.f;
#pragma unroll
            for (int s = 0; s < 8; ++s) acc = mfma32(*(const LAS bf16x8*)(lds + (32 * (2 * grp + d) + r) * 272 + (16 * s + 8 * hh) * 2), qf[s], acc);
#pragma unroll
            for (int e = 0; e < 16; ++e) { acc[e] *= 0.08838834764831845f; gm = fmaxf(gm, acc[e]); }
            sc[d] = acc; }
        gm = fmaxf(gm, __shfl_xor(gm, 32));
        const float mn = fmaxf(mx, gm), alpha = __expf(mx - mn);
        float ps = 0.f;
#pragma unroll
        for (int d = 0; d < 2; ++d)
#pragma unroll
            for (int e = 0; e < 16; ++e) { const float p = __expf(sc[d][e] - mn); sc[d][e] = p; ps += p; }
        ps += __shfl_xor(ps, 32);
        ls = ls * alpha + ps; mx = mn;
#pragma unroll
        for (int dt = 0; dt < 4; ++dt)
#pragma unroll
            for (int e = 0; e < 16; ++e) o[dt][e] *= alpha;
#pragma unroll
        for (int d = 0; d < 2; ++d)
#pragma unroll
            for (int s2 = 0; s2 < 2; ++s2) { const bf16x8 pf = pack8(sc[d], 8 * s2);
#pragma unroll
                for (int dt = 0; dt < 4; ++dt) o[dt] = mfma32(*(const LAS bf16x8*)(lds + MA_VT + (32 * dt + r) * 528 + (32 * (2 * grp + d) + 16 * s2) * 2 + hh * 16), pf, o[dt]); }
    }
    const float inv = 1.0f / ls;
#pragma unroll
    for (int dt = 0; dt < 4; ++dt)
#pragma unroll
        for (int g4 = 0; g4 < 4; ++g4) { u32x2 w; w.x = cvt_pk_bf16(o[dt][4 * g4] * inv, o[dt][4 * g4 + 1] * inv); w.y = cvt_pk_bf16(o[dt][4 * g4 + 2] * inv, o[dt][4 * g4 + 3] * inv);
            *(u32x2*)(odst + (qrow - acat) + (dt >> 1) * 8192 + 32 * (dt & 1) + 8 * g4 + 4 * hh) = w; }
    __syncthreads();
}


constexpr int BG_BRA = 128 * 32, BG_BRM = 128 * 8, BG_O = 128 * 64, BG_F1 = (2 * DFF / 32) * 64, BG_F2 = 128 * (DFF / 64);
constexpr int BG_ITEMS = 2 * BG_BRA + BG_BRM + BG_O + BG_F1 + BG_F2;
constexpr int BG_CH = 32;
constexpr int BG_E0 = (2 * BG_BRA + BG_BRM) / BG_CH, BG_E1 = BG_E0 + BG_O / BG_CH, BG_E2 = BG_E1 + BG_F1 / BG_CH, BG_E3 = BG_ITEMS / BG_CH;
static_assert(BG_ITEMS % BG_CH == 0 && (2 * BG_BRA + BG_BRM) % BG_CH == 0 && BG_O % BG_CH == 0 && BG_F1 % BG_CH == 0, "whole chunks per segment");
__device__ __forceinline__ void bg_item(int r, const Args& args, bf16_t* Wbr_t, bf16_t* Wo_t, bf16_t* Wf1_t, bf16_t* Wf2_t, LAS float* scr, int lane) {
    if (r < BG_BRA) { const int kb = r / 128, gd = r % 128; p0_transpose_item(args.w_br_a, DM, gd * 32, kb * 64, Wbr_t, (size_t)gd * 32, KCAT, 0, scr, lane); return; } r -= BG_BRA;
    if (r < BG_BRA) { const int kb = r / 128, gd = r % 128; p0_transpose_item(args.w_br_b, DM, gd * 32, kb * 64, Wbr_t, (size_t)gd * 32, KCAT, 2048, scr, lane); return; } r -= BG_BRA;
    if (r < BG_BRM) { const int kb = r / 128, gd = r % 128; p0_transpose_item(args.w_br_m, DM, gd * 32, kb * 64, Wbr_t, (size_t)gd * 32, KCAT, 4096, scr, lane); return; } r -= BG_BRM;
    if (r < BG_O) { const int kb = r / 128, gd = r % 128; p0_transpose_item(args.w_o, DM, gd * 32, kb * 64, Wo_t, (size_t)gd * 32, DM, 0, scr, lane); return; } r -= BG_O;
    if (r < BG_F1) { const int kb = r / (2 * DFF / 32), gd = r % (2 * DFF / 32), tj = gd / 8, wi = gd % 8;
        const int src = wi < 4 ? tj * 128 + wi * 32 : DFF + tj * 128 + (wi - 4) * 32;
        p0_transpose_item(args.w_ffn_in, 2 * DFF, src, kb * 64, Wf1_t, (size_t)gd * 32, DM, 0, scr, lane); return; } r -= BG_F1;
    { const int kb = r / 128, gd = r % 128; p0_transpose_item(args.w_ffn_out, DM, gd * 32, kb * 64, Wf2_t, (size_t)gd * 32, DFF, 0, scr, lane); }
}

constexpr int CV_DEPTH = 7, CV_NBUF = 9;
static_assert(CV_NBUF * 16384 <= RING_BYTES && CV_NBUF >= CV_DEPTH + 2, "converter ring");
struct CvBlock { const float* src; unsigned ldw; size_t dst; };
__device__ __forceinline__ void cv_issue(const CvBlock& d, LAS unsigned char* buf, int wid, int lane) {
    const unsigned voff = (unsigned)(8 * wid + (lane >> 4)) * (d.ldw * 4u) + (unsigned)(((lane & 15) ^ (2 * wid)) * 16);
#pragma unroll
    for (int j = 0; j < 2; ++j)
        __builtin_amdgcn_global_load_lds((const unsigned*)((const char*)d.src + (size_t)j * 16 * d.ldw + voff), (LAS unsigned*)(buf + (2 * wid + j) * 1024), 16, 0, 0);
}
__device__ __forceinline__ void cv_consume(LAS const unsigned char* buf, unsigned char* dst, int wid, int lane) {
    const int n = 8 * wid + (lane >> 3), kq = lane & 7;
    const LAS float* p = (const LAS float*)(buf + kq * 2048 + (((n >> 2) ^ (2 * kq)) * 16) + (n & 3) * 4);
    float v[8];
#pragma unroll
    for (int i = 0; i < 8; ++i) v[i] = p[i * 64];
    u32x4 o; o.x = cvt_pk_bf16(v[0], v[1]); o.y = cvt_pk_bf16(v[2], v[3]); o.z = cvt_pk_bf16(v[4], v[5]); o.w = cvt_pk_bf16(v[6], v[7]);
    *(u32x4*)(dst + wid * 1024 + lane * 16) = o;
}
template <class Gen>
__device__ __forceinline__ int cv_stream(const Gen& gen, int nb, unsigned char* ws, LAS unsigned char* lds, int wid, int lane, const unsigned* done_flag, unsigned done_need) {
    if (nb <= 0) return 0;
    asm volatile("s_waitcnt vmcnt(0) lgkmcnt(0)" ::: "memory"); __builtin_amdgcn_s_barrier();
    const int pre = nb < CV_DEPTH ? nb : CV_DEPTH;
    for (int p = 0; p < pre; ++p) { const CvBlock d = gen(p); cv_issue(d, lds + (p % CV_NBUF) * 16384, wid, lane); }
    int j = 0, issued = pre;
    while (issued < nb) {
        if ((j & 127) == 127 && done_flag != nullptr) {
            LAS unsigned* slot = (LAS unsigned*)(lds + DEC_OFF + 2048);
            if (wid == 0 && lane == 0) *slot = __hip_atomic_load(done_flag, __ATOMIC_RELAXED, __HIP_MEMORY_SCOPE_AGENT);
            asm volatile("s_waitcnt lgkmcnt(0)" ::: "memory"); __builtin_amdgcn_s_barrier();
            const unsigned v = *(volatile LAS unsigned*)slot;
            if (v >= done_need) break;
        }
        if (j < 6) asm volatile("s_waitcnt vmcnt(12)" ::: "memory"); else asm volatile("s_waitcnt vmcnt(18)" ::: "memory");
        __builtin_amdgcn_s_barrier();
        { const CvBlock d = gen(j); cv_consume(lds + (j % CV_NBUF) * 16384, ws + d.dst, wid, lane); }
        { const CvBlock d = gen(issued); cv_issue(d, lds + (issued % CV_NBUF) * 16384, wid, lane); }
        ++j; ++issued;
    }
    asm volatile("s_waitcnt vmcnt(0)" ::: "memory"); __builtin_amdgcn_s_barrier();
    for (; j < issued; ++j) { const CvBlock d = gen(j); cv_consume(lds + (j % CV_NBUF) * 16384, ws + d.dst, wid, lane); }
    asm volatile("s_waitcnt vmcnt(0) lgkmcnt(0)" ::: "memory"); __builtin_amdgcn_s_barrier();
    return issued;
}
struct CvGenP0 { const float* w_in; const float* w_kv; int w, G;
    __device__ __forceinline__ CvBlock operator()(int p) const { const int b = w + p * G; CvBlock d;
        if (b < 64 * (NP_IN / 64)) { const int kb = b / (NP_IN / 64), ng = b % (NP_IN / 64), n0 = ng * 64; const int col = n0 < 10752 ? n0 : (n0 < 23552 ? n0 + 32 : 10752);
            d.src = w_in + (size_t)kb * 64 * N_IN + col; d.ldw = N_IN; d.dst = WS_WIN + 2 * tiled_off(n0, kb * 64, DM / 64); }
        else { const int r = b - 64 * (NP_IN / 64), kb = r >> 4, ng = r & 15; d.src = w_kv + (size_t)kb * 64 * 1024 + ng * 64; d.ldw = 1024; d.dst = WS_WKV + 2 * tiled_off(ng * 64, kb * 64, DM / 64); }
        return d; } };

__global__ void __launch_bounds__(512, 2) hybrid_fwd(Args args) {
    extern __shared__ __attribute__((aligned(16))) unsigned char lds_raw[];
    LAS unsigned char* lds = (LAS unsigned char*)lds_raw;
    volatile LAS unsigned* MISC = (volatile LAS unsigned*)(lds + MISC_OFF);
    const int tid = threadIdx.x, lane = tid & 63, wave = __builtin_amdgcn_readfirstlane(tid >> 6);
    const int G = gridDim.x, bx = blockIdx.x;
    const int vcu = (G % 8 == 0) ? (bx % 8) * (G / 8) + bx / 8 : bx;
    unsigned char* ws = args.ws;
    unsigned* ctl = (unsigned*)(ws + WS_CTL);
    bf16_t* Win_t = (bf16_t*)(ws + WS_WIN); bf16_t* Wkv_t = (bf16_t*)(ws + WS_WKV); bf16_t* Wbr_t = (bf16_t*)(ws + WS_WBR); bf16_t* Wo_t = (bf16_t*)(ws + WS_WO);
    bf16_t* Wf1_t = (bf16_t*)(ws + WS_WF1); bf16_t* Wf2_t = (bf16_t*)(ws + WS_WF2);
    bf16_t* HB = (bf16_t*)(ws + WS_H); bf16_t* ACAT = (bf16_t*)(ws + WS_ACAT); bf16_t* KVA = (bf16_t*)(ws + WS_KVA); bf16_t* BQKV = (bf16_t*)(ws + WS_BQKV);
    bf16_t* GATES = (bf16_t*)(ws + WS_GATES); float* BA = (float*)(ws + WS_BA); bf16_t* MEMN = (bf16_t*)(ws + WS_MEMN); bf16_t* MKV = (bf16_t*)(ws + WS_MKV);
    float* PART1 = (float*)(ws + WS_PART1); float* PART2 = (float*)(ws + WS_PART2); bf16_t* H2 = (bf16_t*)(ws + WS_H2); bf16_t* HID = (bf16_t*)(ws + WS_HID);
    bf16_t* YB = HB;
    bf16_t* X1B = (bf16_t*)(ws + WS_ACAT);
    bf16_t* GWp = (bf16_t*)(ws + WS_GW); bf16_t* GKDTp = (bf16_t*)(ws + WS_GKDT); bf16_t* GATTp = (bf16_t*)(ws + WS_GATT); float* GLp = (float*)(ws + WS_GL);
    bf16_t* GQGp = (bf16_t*)(ws + WS_GQG); bf16_t* GUTp = (bf16_t*)(ws + WS_GUT); bf16_t* GSTp = (bf16_t*)(ws + WS_GST); bf16_t* GVTp = (bf16_t*)(ws + WS_GVT);

    for (int u = tid; u < (LDS_BYTES - RS_OFF) / 4; u += 512) ((LAS unsigned*)(lds + RS_OFF))[u] = 0u;
    __syncthreads();
    XcdBarrier bar; bar.bar = ctl + CW_BAR; bar.x = 0; bar.st = nullptr;
    if (MK_ONE_LAUNCH) bar = xcd_barrier_post(ctl + CW_BAR, MISC + 8);
    const int lo = args.ph_lo, hi = args.ph_hi;
#ifndef DISABLE_MASK
#define DISABLE_MASK 0
#endif
#define IN(k) (lo <= (k) && (k) < hi && !((DISABLE_MASK >> (k)) & 1))
#ifndef REPEAT_MASK
#define REPEAT_MASK 0
#endif
#define REP(k) for (int _rep = 0; _rep < 1 + ((REPEAT_MASK >> (k)) & 1); ++_rep)
#define ODST_OF(k) ((_rep < ((REPEAT_MASK >> (k)) & 1)) ? (bf16_t*)args.out : ACAT)
#define SEAM(k) do { if (IN(k) && IN((k) + 1)) xcd_barrier(bar); } while (0)
#define AT_LD(p) __hip_atomic_load((p), __ATOMIC_RELAXED, __HIP_MEMORY_SCOPE_AGENT)
#define BG_WORK(need, steal_k) do { \
    LAS int* _qs = (LAS int*)(lds + DEC_OFF + 1024); \
    __syncthreads(); \
    if ((steal_k) >= 0 && tid == 0) (void)__hip_atomic_fetch_add(ctl + CW_DONE + 64 * ((steal_k) < 0 ? 0 : (steal_k)), 1u, __ATOMIC_RELAXED, __HIP_MEMORY_SCOPE_AGENT); \
    for (;;) { \
        if (tid == 0) { const unsigned _hd = AT_LD(ctl + CW_BGHEAD); bool _go = _hd < (unsigned)(need); \
            if (!_go && (steal_k) >= 0 && _hd < (unsigned)BG_E3) _go = AT_LD(ctl + CW_DONE + 64 * ((steal_k) < 0 ? 0 : (steal_k))) < (unsigned)G; \
            _qs[0] = _go ? (int)__hip_atomic_fetch_add(ctl + CW_BGHEAD, 1u, __ATOMIC_RELAXED, __HIP_MEMORY_SCOPE_AGENT) : -1; } \
        __syncthreads(); const int _c = _qs[0]; __syncthreads(); \
        if (_c < 0 || _c >= BG_E3) break; \
        for (int _q = 0; _q < BG_CH / 8; ++_q) bg_item(_c * BG_CH + _q * 8 + wave, args, Wbr_t, Wo_t, Wf1_t, Wf2_t, (LAS float*)(lds + wave * 16384), lane); \
    } } while (0)

    if (IN(0)) REP(0) {
        const int gw = vcu * 8 + wave, NGW = G * 8;
        { constexpr int NBLK = 64 * (NP_IN / 64) + 64 * 16;
          const CvGenP0 gen{args.w_in, args.w_mem_kv, bx, G};
          (void)cv_stream(gen, (NBLK - bx + G - 1) / G, ws, lds, wave, lane, nullptr, 0u); }
        for (int m = gw; m < M; m += NGW) rms_row_to_bf16(args.x + (size_t)m * DM, args.g_mix, HB, m, lane);
        for (int m = gw; m < MEMROWS; m += NGW) rms_row_to_bf16(args.mem + (size_t)m * DM, args.g_mem, MEMN, m, lane);
    }
    SEAM(0);

    if (IN(1)) REP(1) {
        pg8::Gemm g{HB, Win_t, MEMN, Wkv_t, DM};
        pg8::StaticOrder S; S.init(M, NP_IN, G, bx, 8, 4);
        pg8::EpiInProj E{ACAT, KVA, BQKV, GATES, BA, MKV};
        pg8::gemm_phase<pg8::EpiInProj, pg8::StaticOrder, true, GEMM_MODE>(lds, g, S, E);
        BG_WORK(0, -1);
    }
    SEAM(1);

    if (IN(2)) REP(2) {
        const int per = GDN_UNITS / G, u0 = bx * per;
        { const int h = (u0 >> 7) & 15;
          if (tid < 384) { const int idx = tid * 4, xi = idx >> 9, j = (idx >> 7) & 3, c = idx & 127;
              *(LAS f32x4*)((LAS float*)(lds + L_CW) + idx) = *(const f32x4*)(args.conv_w + (size_t)j * 6144 + xi * 2048 + h * 128 + c); } }
        for (int i = 0; i < per; ++i) { int u = u0 + i; asm volatile("" : "+s"(u));
            gdn_local_unit(u, args, lds, BQKV, BA, GWp, GKDTp, GATTp, GLp, GQGp, GUTp, tid, wave); }
        BG_WORK(0, -1);
    }
    SEAM(2);

    if (IN(3)) REP(3) {
        bf16_t* ODST = ODST_OF(3);
        if (bx < 128) {
            const int j = bx >> 3; gdn_scan((bx & 7) * 4 + (j >> 2), j & 3, lds, GWp, GKDTp, GUTp, GLp, GSTp, GVTp, tid, lane, wave);
        }
        {   LAS int* qslot = (LAS int*)(lds + DEC_OFF + 1024);
            for (;;) {
                if (tid == 0) *qslot = (int)__hip_atomic_fetch_add(ctl + CW_QUEUE + 256 * _rep, 1u, __ATOMIC_RELAXED, __HIP_MEMORY_SCOPE_AGENT);
                __syncthreads();
                const int u = *qslot;
                __syncthreads();
                if (u >= 512) break;
                swa_unit(u, args, lds, ACAT, ODST, KVA, tid, lane, wave);
            }
            for (;;) {
                if (tid == 0) *qslot = (int)__hip_atomic_fetch_add(ctl + CW_QUEUE + 64 + 256 * _rep, 1u, __ATOMIC_RELAXED, __HIP_MEMORY_SCOPE_AGENT);
                __syncthreads();
                const int u = *qslot;
                __syncthreads();
                if (u >= 256) break;
                mem_unit(u, lds, ACAT, ODST, MKV, tid, lane, wave);
            }
        }
        BG_WORK(0, 3);
    }
    SEAM(3);

    if (IN(4)) REP(4) {
        bf16_t* ODST = ODST_OF(4);
        { const int per = GDN_UNITS / G; gdn_out_units(bx * per, per, args, lds, ACAT, ODST, GQGp, GATTp, GSTp, GVTp, tid, lane, wave); }
        BG_WORK(BG_E0, -1);
    }
    SEAM(4);

    if (IN(5)) REP(5) {
        pg8::Gemm g{ACAT, Wbr_t, ACAT, Wbr_t, KCAT};
        pg8::StaticOrder S; S.init(M, DM, G, bx);
        pg8::EpiMerge E{GATES, YB};
        pg8::gemm_phase<pg8::EpiMerge, pg8::StaticOrder, true, GEMM_MODE>(lds, g, S, E);
        BG_WORK(BG_E1, -1);
    }
    SEAM(5);

    if (IN(6)) REP(6) {
        pg8::Gemm g{YB, Wo_t, YB, Wo_t, DM};
        pg8::StaticOrder S; S.init(M, DM, G, bx);
        pg8::EpiWo E{args.x, X1B, H2, args.g_ffn, PART1};
        pg8::gemm_phase<pg8::EpiWo, pg8::StaticOrder, true, GEMM_MODE>(lds, g, S, E);
        BG_WORK(BG_E2, -1);
    }
    SEAM(6);

    if (IN(7)) REP(7) {
        pg8::Gemm g{H2, Wf1_t, H2, Wf1_t, DM};
        pg8::RsOrder S; S.init(M, 2 * DFF, G, bx); S.part = PART1; S.rs = (LAS float*)(lds + RS_OFF); S.cur_pm = -1;
        pg8::EpiFfnIn E{HID, (const LAS float*)(lds + RS_OFF)};
        pg8::gemm_phase<pg8::EpiFfnIn, pg8::RsOrder, true, GEMM_MODE>(lds, g, S, E);
        BG_WORK(BG_E3, -1);
    }
    SEAM(7);

    if (IN(8)) REP(8) {
        pg8::Gemm g{HID, Wf2_t, HID, Wf2_t, DFF};
        pg8::StaticOrder S; S.init(M, DM, G, bx);
        pg8::EpiFfnOut E{X1B, PART2};
        pg8::gemm_phase<pg8::EpiFfnOut, pg8::StaticOrder, true, GEMM_MODE>(lds, g, S, E);
    }
    SEAM(8);

    if (IN(9)) REP(9) {
        const int gw = vcu * 8 + wave, NGW = G * 8;
        for (int m = gw; m < M; m += NGW) {
            const float ss = wave_sum(PART2[(size_t)lane * M + m]);
            const float rstd = __builtin_amdgcn_rsqf(ss * (1.0f / DM) + EPS);
            const u32x4* xr = (const u32x4*)(X1B + (size_t)m * DM) + lane; f32x4* orow = (f32x4*)(args.out + (size_t)m * DM) + 2 * lane; const f32x4* gr = (const f32x4*)args.g_final + 2 * lane;
            u32x4 v[8];
#pragma unroll
            for (int j = 0; j < 8; ++j) v[j] = xr[64 * j];
#pragma unroll
            for (int j = 0; j < 8; ++j) { const f32x4 a = {bflo(v[j].x), bfhi(v[j].x), bflo(v[j].y), bfhi(v[j].y)}, b = {bflo(v[j].z), bfhi(v[j].z), bflo(v[j].w), bfhi(v[j].w)};
                orow[128 * j] = a * rstd * gr[128 * j]; orow[128 * j + 1] = b * rstd * gr[128 * j + 1]; }
        }
    }
#undef IN
#undef SEAM
}

extern "C" void kernel_launch(void* const* d_in, const int* in_sizes, int n_in, void* d_out, int out_size, void* d_ws, size_t ws_size, hipStream_t stream) {
    static int grid = 0;
    if (grid == 0) {
        if (n_in != 20 || in_sizes[0] != M * DM || out_size != M * DM || ws_size < WS_END) {
            fprintf(stderr, "kernel_launch: unexpected shapes (n_in %d, in0 %d, out %d, ws %zu < %zu): nothing launched\n", n_in, n_in > 0 ? in_sizes[0] : -1, out_size, ws_size, (size_t)WS_END); grid = -1; return; }
        if (hipFuncSetAttribute((const void*)hybrid_fwd, hipFuncAttributeMaxDynamicSharedMemorySize, LDS_BYTES) != hipSuccess) { fprintf(stderr, "kernel_launch: hipFuncSetAttribute failed\n"); grid = -1; return; }
        int per_cu = 0;
        if (hipOccupancyMaxActiveBlocksPerMultiprocessor(&per_cu, (const void*)hybrid_fwd, 512, LDS_BYTES) != hipSuccess || per_cu < 1)
            fprintf(stderr, "kernel_launch: note: occupancy query reports %d workgroups per CU\n", per_cu);
        (void)hipGetLastError();
        grid = 256;
    }
    if (grid < 0) return;
    if (hipMemsetAsync((char*)d_ws + WS_CTL, 0, CTL_ZERO_BYTES, stream) != hipSuccess) { fprintf(stderr, "kernel_launch: memset failed\n"); return; }
    Args a{};
    a.x = (const float*)d_in[0]; a.mem = (const float*)d_in[1]; a.rel_bias = (const float*)d_in[2]; a.g_mix = (const float*)d_in[3]; a.w_in = (const float*)d_in[4];
    a.conv_w = (const float*)d_in[5]; a.a_log = (const float*)d_in[6]; a.dt_bias = (const float*)d_in[7]; a.g_dn_out = (const float*)d_in[8]; a.sinks = (const float*)d_in[9];
    a.g_mem = (const float*)d_in[10]; a.w_mem_kv = (const float*)d_in[11]; a.w_br_a = (const float*)d_in[12]; a.w_br_b = (const float*)d_in[13]; a.w_br_m = (const float*)d_in[14];
    a.w_o = (const float*)d_in[15]; a.g_ffn = (const float*)d_in[16]; a.w_ffn_in = (const float*)d_in[17]; a.w_ffn_out = (const float*)d_in[18]; a.g_final = (const float*)d_in[19];
    a.out = (float*)d_out; a.ws = (unsigned char*)d_ws;
#if MK_ONE_LAUNCH
    a.ph_lo = 0; a.ph_hi = NPHASE;
    hipLaunchKernelGGL(hybrid_fwd, dim3(grid), dim3(512), LDS_BYTES, stream, a);
#else
    for (int p = 0; p < NPHASE; ++p) { a.ph_lo = p; a.ph_hi = p + 1; hipLaunchKernelGGL(hybrid_fwd, dim3(grid), dim3(512), LDS_BYTES, stream, a); }
#endif
    const hipError_t le = hipPeekAtLastError();
    if (le != hipSuccess) fprintf(stderr, "kernel_launch: launch failed: %s\n", hipGetErrorName(le));
}
```

```cpp
#include <hip/hip_runtime.h>
#include <cstdio>

#ifndef GEMM_MODE
#define GEMM_MODE 1
#endif
#ifndef MK_ONE_LAUNCH
#define MK_ONE_LAUNCH 1
#endif

#define LAS __attribute__((address_space(3)))
#define GAS __attribute__((address_space(1)))
typedef unsigned short bf16_t;
typedef short bf16x8 __attribute__((ext_vector_type(8)));
typedef float f32x4 __attribute__((ext_vector_type(4)));
typedef float f32x2 __attribute__((ext_vector_type(2)));
typedef unsigned u32x4 __attribute__((ext_vector_type(4)));
typedef unsigned u32x2 __attribute__((ext_vector_type(2)));

constexpr int DM = 4096, BATCH = 2, SEQ = 8192, M = BATCH * SEQ, MEMLEN = 256, MEMROWS = BATCH * MEMLEN;
constexpr int N_IN = 23584, NP_IN = 23808;
constexpr int DFF = 11008, KCAT = 4608;
constexpr int A_HEADS = 32, A_KVH = 4, A_HD = 64, WINDOW = 128;
constexpr int B_HEADS = 16, B_DK = 128;
constexpr int M_HEADS = 4, M_HD = 128;
constexpr float EPS = 1e-6f;

constexpr size_t MiB = 1u << 20;
constexpr size_t WS_CTL = 0, CTL_ZERO_BYTES = 1 * MiB;
constexpr size_t WS_WIN = 2 * MiB;
constexpr size_t WS_WKV = 188 * MiB;
constexpr size_t WS_WBR = 196 * MiB;
constexpr size_t WS_WO = 232 * MiB;
constexpr size_t WS_WF1 = 264 * MiB;
constexpr size_t WS_WF2 = 436 * MiB;
constexpr size_t WS_H = 522 * MiB;
constexpr size_t WS_ACAT = 650 * MiB;
constexpr size_t WS_KVA = 794 * MiB;
constexpr size_t WS_BQKV = 810 * MiB;
constexpr size_t WS_GATES = 1002 * MiB;
constexpr size_t WS_BA = 1386 * MiB;
constexpr size_t WS_MEMN = 1388 * MiB;
constexpr size_t WS_MKV = 1392 * MiB;
constexpr size_t WS_PART1 = 1393 * MiB;
constexpr size_t WS_PART2 = 1397 * MiB;
constexpr size_t WS_END = 1401 * MiB;
constexpr size_t WS_H2 = WS_BQKV;
constexpr size_t WS_HID = WS_GATES;
constexpr size_t WS_GW = WS_WIN, WS_GKDT = 66 * MiB, WS_GATT = 130 * MiB, WS_GL = 162 * MiB, WS_GQG = WS_H, WS_GUT = 586 * MiB, WS_GST = WS_BQKV, WS_GVT = 938 * MiB;
constexpr int CW_TMO = 0, CW_CODE = 1, CW_QUEUE = 64, CW_DONE = 1024, CW_BGHEAD = 2048, CW_BAR = 4096;

constexpr int RING_BYTES = 147456;
constexpr int DEC_OFF = RING_BYTES;
constexpr int RS_OFF = 159744;
constexpr int MISC_OFF = 161792;
constexpr int LDS_BYTES = 163840;

__device__ __forceinline__ unsigned f2bf(float f) { unsigned u = __builtin_bit_cast(unsigned, f); return (u + 0x7fffu + ((u >> 16) & 1u)) >> 16; }
__device__ __forceinline__ float bf2f(unsigned short b) { return __builtin_bit_cast(float, (unsigned)b << 16); }
__device__ __forceinline__ float bflo(unsigned w) { return __builtin_bit_cast(float, w << 16); }
__device__ __forceinline__ float bfhi(unsigned w) { return __builtin_bit_cast(float, w & 0xffff0000u); }
typedef __bf16 bf16x2_t __attribute__((ext_vector_type(2)));
__device__ __forceinline__ unsigned cvt_pk_bf16(float lo, float hi) { const f32x2 v = {lo, hi}; const bf16x2_t b = __builtin_convertvector(v, bf16x2_t); return __builtin_bit_cast(unsigned, b); }
__device__ __forceinline__ unsigned pk2(float lo, float hi) { return cvt_pk_bf16(lo, hi); }
__device__ __forceinline__ float sigmoidf_(float x) { return __builtin_amdgcn_rcpf(1.0f + __expf(-x)); }
__device__ __forceinline__ float siluf_(float x) { return x * __builtin_amdgcn_rcpf(1.0f + __expf(-x)); }
__host__ __device__ __forceinline__ size_t tiled_off(int row, int col, int ktiles) { return ((size_t)(row >> 7) * ktiles + (size_t)(col >> 6)) * 8192 + (size_t)((row & 127) * 64 + (col & 63)); }
__device__ __forceinline__ float wave_sum(float v) {
#pragma unroll
    for (int o = 1; o < 64; o <<= 1) v += __shfl_xor(v, o);
    return v;
}

namespace pg8 {
constexpr int BM = 256, BK = 64, HALF = 128, HTB = HALF * BK * 2, STAGE_BYTES = 8 * HTB, NXCD = 8, WGM = 8;
__host__ __device__ __forceinline__ int lds_byte(int r, int c) { const int st = (r >> 4) * 2 + (c >> 5), rr = r & 15, cc = c & 31, ob = rr * 64 + cc * 2; return st * 1024 + (ob ^ (((ob >> 9) & 1) << 5)); }
__host__ __device__ __forceinline__ void stage_rc(int b, int& R, int& C) { const int st = b / 1024, sb = b % 1024, swz = sb ^ (((sb >> 9) & 1) << 5); R = (st >> 1) * 16 + swz / 64; C = (st & 1) * 32 + (swz % 64) / 2; }
__host__ __device__ __forceinline__ int perm32(int rho) { const int n = rho >> 4, i = rho & 15; return 8 * (i >> 2) + 4 * n + (i & 3); }

struct Unit { int pm, pn, sel; };
struct Gemm { const bf16_t* A; const bf16_t* Bt; const bf16_t* A2; const bf16_t* B2; int K; };

struct StaticOrder {
    int nM, nN, nwg, G, c, nextra, exN;
    __device__ void init(int M_, int N_, int G_, int c_, int nextra_ = 0, int exN_ = 1) { nM = M_ / BM; nN = N_ / BM; nwg = nM * nN; G = G_; c = c_; nextra = nextra_; exN = exN_; }
    __device__ bool next(int i, Unit& u) const {
        const long L = (long)i * G + c; if (L >= nwg + nextra) return false;
        if (L >= nwg) { const int e = (int)(L - nwg); u.pm = e / exN; u.pn = e % exN; u.sel = 1; return true; }
        int wgid = (int)L; { const int q = nwg / NXCD, r = nwg % NXCD, xcd = wgid % NXCD, off = wgid / NXCD; wgid = (xcd < r ? xcd * (q + 1) : r * (q + 1) + (xcd - r) * q) + off; }
        const int nig = WGM * nN, gid = wgid / nig, fm = gid * WGM, gsz = (nM - fm) < WGM ? (nM - fm) : WGM;
        u.pm = fm + ((wgid % nig) % gsz); u.pn = (wgid % nig) / gsz; u.sel = 0; return true;
    }
    __device__ __forceinline__ void a_ready(const Unit&) {}
    __device__ __forceinline__ void done(const Unit&) {}
};

template <class Epi, class Sched, bool ALIGN_EPI, int SP2>
__device__ __forceinline__ void gemm_phase(LAS unsigned char* lds, const Gemm g, Sched& S, Epi& E) {
    const int tid = threadIdx.x, wid = __builtin_amdgcn_readfirstlane(tid >> 6), lane = tid & 63, wr = wid >> 2, wc = wid & 3, fr = lane & 15, fq = lane >> 4;
    const int K = g.K, nt = K / BK;
    unsigned voffA[2], voffB[2];
#pragma unroll
    for (int i = 0; i < 2; ++i) { int R, C; stage_rc(tid * 16 + i * 8192, R, C); const int Rb = Epi::PERM ? ((R & ~31) + perm32(R & 31)) : R;
        voffA[i] = (unsigned)(R * 64 + C) * 2u; voffB[i] = (unsigned)(Rb * 64 + C) * 2u; }
    const size_t kstep = (size_t)HTB;
    const size_t hstepA = (size_t)nt * HTB, hstepB = hstepA;
    const unsigned ldsw = (unsigned)wid * 1024u;
    const int aoff = lds_byte(wr * 64 + fr, fq * 8), boff = lds_byte(wc * 32 + fr, fq * 8);
#define PG8_SA(b, h) (((b) * 2 + (h)) * HTB)
#define PG8_SB(b, h) ((4 + (b) * 2 + (h)) * HTB)
#define PG8_STAGE(bufoff, gbase, voff) do { _Pragma("unroll") for (int _i = 0; _i < 2; ++_i) \
        __builtin_amdgcn_global_load_lds((const unsigned*)((const char*)(gbase) + (voff)[_i]), (LAS unsigned*)(lds + (bufoff) + ldsw + _i * 8192), 16, 0, 0); } while (0)
#define PG8_LDA(dst, b, h) do { _Pragma("unroll") for (int m = 0; m < 4; ++m) _Pragma("unroll") for (int k = 0; k < 2; ++k) dst[m][k] = *(const LAS bf16x8*)(lds + PG8_SA(b, h) + aoff + m * 2048 + k * 1024); } while (0)
#define PG8_LDB(dst, b, h) do { _Pragma("unroll") for (int n = 0; n < 2; ++n) _Pragma("unroll") for (int k = 0; k < 2; ++k) dst[n][k] = *(const LAS bf16x8*)(lds + PG8_SB(b, h) + boff + n * 2048 + k * 1024); } while (0)
#define PG8_MMA(ai, bj, At, Bt) do { __builtin_amdgcn_s_setprio(1); _Pragma("unroll") for (int m = 0; m < 4; ++m) _Pragma("unroll") for (int n = 0; n < 2; ++n) _Pragma("unroll") for (int k = 0; k < 2; ++k) \
        acc[ai][bj][m][n] = __builtin_amdgcn_mfma_f32_16x16x32_bf16(Bt[n][k], At[m][k], acc[ai][bj][m][n], 0, 0, 0); __builtin_amdgcn_s_setprio(0); } while (0)
#define PG8_WAIT_V(n) asm volatile("s_waitcnt vmcnt(" #n ")" ::: "memory")
#define PG8_WAIT_L(n) asm volatile("s_waitcnt lgkmcnt(" #n ")" ::: "memory")
#define PG8_BAR __builtin_amdgcn_s_barrier()
#define PG8_SCHED __builtin_amdgcn_sched_barrier(0)
#define PG8_ATILE(u) ((const char*)((u).sel ? g.A2 : g.A) + (size_t)(u).pm * 2 * hstepA)
#define PG8_BTILE(u) ((const char*)((u).sel ? g.B2 : g.Bt) + (size_t)(u).pn * 2 * hstepB)
    Unit cur, nxt; int ui = 0;
    if (!S.next(0, cur)) return;
    f32x4 acc[2][2][4][2];
#pragma unroll
    for (int a = 0; a < 2; ++a)
#pragma unroll
        for (int b = 0; b < 2; ++b)
#pragma unroll
            for (int m = 0; m < 4; ++m)
#pragma unroll
                for (int n = 0; n < 2; ++n) acc[a][b][m][n] = (f32x4){0.f, 0.f, 0.f, 0.f};
    bf16x8 At[4][2], B0[2][2], B1[2][2];
    const char* cA = PG8_ATILE(cur); const char* cB = PG8_BTILE(cur);
    S.a_ready(cur);
    if constexpr (SP2 != 0) {
        PG8_STAGE(PG8_SB(0, 0), cB, voffB); PG8_STAGE(PG8_SB(0, 1), cB + hstepB, voffB); PG8_STAGE(PG8_SA(0, 0), cA, voffA); PG8_STAGE(PG8_SA(0, 1), cA + hstepA, voffA);
        if (wr == 1) PG8_BAR;
        PG8_WAIT_V(2); PG8_BAR;
        PG8_STAGE(PG8_SB(1, 0), cB + kstep, voffB); PG8_STAGE(PG8_SA(1, 0), cA + kstep, voffA); PG8_STAGE(PG8_SB(1, 1), cB + hstepB + kstep, voffB);
        PG8_WAIT_V(6); PG8_BAR;
    } else {
        PG8_STAGE(PG8_SB(0, 0), cB, voffB); PG8_STAGE(PG8_SA(0, 0), cA, voffA); PG8_STAGE(PG8_SB(0, 1), cB + hstepB, voffB); PG8_STAGE(PG8_SA(0, 1), cA + hstepA, voffA);
        if (wr == 1) PG8_BAR;
        PG8_WAIT_V(4); PG8_BAR;
        PG8_STAGE(PG8_SB(1, 0), cB + kstep, voffB); PG8_STAGE(PG8_SA(1, 0), cA + kstep, voffA); PG8_STAGE(PG8_SB(1, 1), cB + hstepB + kstep, voffB);
        PG8_WAIT_V(6); PG8_BAR;
    }
    for (;;) {
        const bool has_next = S.next(ui + 1, nxt);
        const char* nA = has_next ? PG8_ATILE(nxt) : cA; const char* nB = has_next ? PG8_BTILE(nxt) : cB;
        for (int t = 0; t < nt; t += 2) {
            const bool last = (t == nt - 2);
            const char* a1 = cA + (size_t)(t + 1) * kstep;
            const char* a2 = last ? nA : cA + (size_t)(t + 2) * kstep; const char* b2 = last ? nB : cB + (size_t)(t + 2) * kstep;
            const char* a3 = a2 + kstep; const char* b3 = b2 + kstep;
            if (last && has_next) S.a_ready(nxt);
            if constexpr (Epi::HOOK) { if (t == Epi::H1 || t == Epi::H2) E.hook(acc, cur, t, wr, wc, fr, fq); }
            if constexpr (SP2 == 2) {
            PG8_LDB(B0, 0, 0); PG8_LDB(B1, 0, 1); PG8_SCHED; PG8_LDA(At, 0, 0);
            PG8_WAIT_V(6); PG8_WAIT_L(0); PG8_BAR; PG8_MMA(0, 0, At, B0); PG8_STAGE(PG8_SA(1, 1), a1 + hstepA, voffA); PG8_MMA(0, 1, At, B1); PG8_BAR; PG8_SCHED;
            PG8_LDA(At, 0, 1);
            PG8_WAIT_V(2); PG8_WAIT_L(0); PG8_BAR; PG8_MMA(1, 0, At, B0); PG8_STAGE(PG8_SB(0, 0), b2, voffB); PG8_STAGE(PG8_SB(0, 1), b2 + hstepB, voffB); PG8_STAGE(PG8_SA(0, 0), a2, voffA); PG8_MMA(1, 1, At, B1); PG8_BAR; PG8_SCHED;
            PG8_LDB(B0, 1, 0); PG8_LDB(B1, 1, 1); PG8_SCHED; PG8_LDA(At, 1, 0);
            PG8_WAIT_V(6); PG8_WAIT_L(0); PG8_BAR; PG8_MMA(0, 0, At, B0); PG8_STAGE(PG8_SA(0, 1), a2 + hstepA, voffA); PG8_MMA(0, 1, At, B1); PG8_BAR; PG8_SCHED;
            PG8_LDA(At, 1, 1);
            PG8_WAIT_V(2); PG8_WAIT_L(0); PG8_BAR; PG8_MMA(1, 0, At, B0); PG8_STAGE(PG8_SB(1, 0), b3, voffB); PG8_STAGE(PG8_SB(1, 1), b3 + hstepB, voffB); PG8_STAGE(PG8_SA(1, 0), a3, voffA); PG8_MMA(1, 1, At, B1); PG8_BAR; PG8_SCHED;
            } else if constexpr (SP2 == 1) {
            PG8_LDB(B0, 0, 0); PG8_LDB(B1, 0, 1); PG8_SCHED; PG8_LDA(At, 0, 0); PG8_STAGE(PG8_SA(1, 1), a1 + hstepA, voffA);
            PG8_WAIT_V(8); PG8_WAIT_L(0); PG8_BAR; PG8_MMA(0, 0, At, B0); PG8_MMA(0, 1, At, B1); PG8_BAR; PG8_SCHED;
            PG8_LDA(At, 0, 1); PG8_STAGE(PG8_SB(0, 0), b2, voffB); PG8_STAGE(PG8_SB(0, 1), b2 + hstepB, voffB); PG8_STAGE(PG8_SA(0, 0), a2, voffA);
            PG8_WAIT_V(8); PG8_WAIT_L(0); PG8_BAR; PG8_MMA(1, 0, At, B0); PG8_MMA(1, 1, At, B1); PG8_BAR; PG8_SCHED;
            PG8_LDB(B0, 1, 0); PG8_LDB(B1, 1, 1); PG8_SCHED; PG8_LDA(At, 1, 0); PG8_STAGE(PG8_SA(0, 1), a2 + hstepA, voffA);
            PG8_WAIT_V(8); PG8_WAIT_L(0); PG8_BAR; PG8_MMA(0, 0, At, B0); PG8_MMA(0, 1, At, B1); PG8_BAR; PG8_SCHED;
            PG8_LDA(At, 1, 1); PG8_STAGE(PG8_SB(1, 0), b3, voffB); PG8_STAGE(PG8_SB(1, 1), b3 + hstepB, voffB); PG8_STAGE(PG8_SA(1, 0), a3, voffA);
            PG8_WAIT_V(8); PG8_WAIT_L(0); PG8_BAR; PG8_MMA(1, 0, At, B0); PG8_MMA(1, 1, At, B1); PG8_BAR; PG8_SCHED;
            } else {
            PG8_LDB(B0, 0, 0); PG8_SCHED; PG8_LDA(At, 0, 0); PG8_STAGE(PG8_SA(1, 1), a1 + hstepA, voffA);
            PG8_WAIT_L(8); PG8_BAR; PG8_WAIT_L(0); PG8_MMA(0, 0, At, B0); PG8_BAR; PG8_SCHED;
            PG8_LDB(B1, 0, 1); PG8_STAGE(PG8_SB(0, 0), b2, voffB);
            PG8_BAR; PG8_WAIT_L(0); PG8_MMA(0, 1, At, B1); PG8_BAR;
            PG8_LDA(At, 0, 1); PG8_STAGE(PG8_SA(0, 0), a2, voffA);
            PG8_BAR; PG8_WAIT_L(0); PG8_MMA(1, 0, At, B0); PG8_BAR; PG8_SCHED;
            PG8_STAGE(PG8_SB(0, 1), b2 + hstepB, voffB);
            PG8_WAIT_V(6); PG8_BAR; PG8_MMA(1, 1, At, B1); PG8_BAR;
            PG8_LDB(B0, 1, 0); PG8_SCHED; PG8_LDA(At, 1, 0); PG8_STAGE(PG8_SA(0, 1), a2 + hstepA, voffA);
            PG8_WAIT_L(8); PG8_BAR; PG8_WAIT_L(0); PG8_MMA(0, 0, At, B0); PG8_BAR; PG8_SCHED;
            PG8_LDB(B1, 1, 1); PG8_STAGE(PG8_SB(1, 0), b3, voffB);
            PG8_BAR; PG8_WAIT_L(0); PG8_MMA(0, 1, At, B1); PG8_BAR;
            PG8_LDA(At, 1, 1); PG8_STAGE(PG8_SA(1, 0), a3, voffA);
            PG8_BAR; PG8_WAIT_L(0); PG8_MMA(1, 0, At, B0); PG8_BAR; PG8_SCHED;
            PG8_STAGE(PG8_SB(1, 1), b3 + hstepB, voffB);
            PG8_WAIT_V(6); PG8_BAR; PG8_MMA(1, 1, At, B1); PG8_BAR;
            }
        }
        if constexpr (ALIGN_EPI) { if (wr == 0) PG8_BAR; }
        E(acc, cur, wr, wc, fr, fq); S.done(cur);
        if (!has_next) break;
#pragma unroll
        for (int a = 0; a < 2; ++a)
#pragma unroll
            for (int b = 0; b < 2; ++b)
#pragma unroll
                for (int m = 0; m < 4; ++m)
#pragma unroll
                    for (int n = 0; n < 2; ++n) acc[a][b][m][n] = (f32x4){0.f, 0.f, 0.f, 0.f};
        cur = nxt; cA = nA; cB = nB; ++ui;
        if constexpr (ALIGN_EPI) { if (wr == 1) PG8_BAR; }
    }
    PG8_WAIT_V(0);
    if constexpr (!ALIGN_EPI) { if (wr == 0) PG8_BAR; }
    PG8_BAR;
#undef PG8_SA
#undef PG8_SB
#undef PG8_STAGE
#undef PG8_LDA
#undef PG8_LDB
#undef PG8_MMA
#undef PG8_WAIT_V
#undef PG8_WAIT_L
#undef PG8_BAR
#undef PG8_SCHED
#undef PG8_ATILE
#undef PG8_BTILE
}

__device__ __forceinline__ size_t gate_frag_off(int g, int pm, int pn, int s, int tid) { return ((((size_t)(g * 64 + pm) * 16 + pn) * 16 + s) * 512 + tid) * 8; }
__device__ __forceinline__ unsigned gate_q4(const f32x4 v) {
    unsigned r = 0;
#pragma unroll
    for (int j = 0; j < 4; ++j) { const float s = __builtin_amdgcn_rcpf(1.0f + __expf(-v[j])); const float q = fminf(fmaxf(s * 255.0f + 0.5f, 1.0f), 255.0f); r |= (unsigned)q << (8 * j); }
    return r;
}
__device__ __forceinline__ float gate_b(unsigned w, int k) { return (float)((w >> (8 * k)) & 0xffu); }
struct EpiInProj {
    static constexpr bool PERM = true, HOOK = false; static constexpr int H1 = -1, H2 = -1;
    bf16_t* acat; bf16_t* kva; bf16_t* bqkv; bf16_t* gates; float* ba; bf16_t* mkv;
    __device__ __forceinline__ void hook(f32x4 (&)[2][2][4][2], const Unit&, int, int, int, int, int) {}
    __device__ __forceinline__ void operator()(const f32x4 (&acc)[2][2][4][2], const Unit& u, int wr, int wc, int fr, int fq) const {
        const int row0 = u.pm * BM + wr * 64 + fr;
        bf16_t* base; int ldc, colt; const int pn = u.pn;
        if (u.sel) { base = mkv; ldc = 1024; colt = pn * 256; }
        else if (pn < 8) { base = acat; ldc = KCAT; colt = pn * 256; }
        else if (pn < 10) { base = kva; ldc = 512; colt = (pn - 8) * 256; }
        else if (pn < 34) { base = bqkv; ldc = 6144; colt = (pn - 10) * 256; }
        else if (pn < 42) { base = acat; ldc = KCAT; colt = 2048 + (pn - 34) * 256; }
        else if (pn < 44) { base = acat; ldc = KCAT; colt = 4096 + (pn - 42) * 256; }
        else if (pn < 92) { base = gates; ldc = 12288; colt = (pn - 44) * 256; }
        else {
            if (wc == 0) {
#pragma unroll
                for (int ai = 0; ai < 2; ++ai)
#pragma unroll
                    for (int m = 0; m < 4; ++m) { float* rowp = ba + (size_t)(row0 + ai * HALF + m * 16) * 32 + 8 * fq;
                        *(f32x4*)(rowp) = acc[ai][0][m][0]; *(f32x4*)(rowp + 4) = acc[ai][0][m][1]; }
            }
            return;
        }
        const int col0 = colt + wc * 32 + 8 * fq; const bool tiled = (base == acat), isgate = (base == gates);
#pragma unroll
        for (int ai = 0; ai < 2; ++ai)
#pragma unroll
            for (int m = 0; m < 4; ++m) { const int r = row0 + ai * HALF + m * 16;
#pragma unroll
                for (int bj = 0; bj < 2; ++bj) { f32x4 v0 = acc[ai][bj][m][0], v1 = acc[ai][bj][m][1];
                    if (isgate) {
                        u32x2 wq; wq.x = gate_q4(v0); wq.y = gate_q4(v1);
                        *(u32x2*)((unsigned char*)base + gate_frag_off((pn - 44) >> 4, u.pm, (pn - 44) & 15, (ai * 4 + m) * 2 + bj, (wr * 4 + wc) * 64 + fq * 16 + fr)) = wq;
                        continue; }
                    u32x4 w; w.x = cvt_pk_bf16(v0[0], v0[1]); w.y = cvt_pk_bf16(v0[2], v0[3]); w.z = cvt_pk_bf16(v1[0], v1[1]); w.w = cvt_pk_bf16(v1[2], v1[3]);
                    bf16_t* p = tiled ? base + tiled_off(r, col0 + bj * HALF, KCAT / 64) : base + (size_t)r * ldc + col0 + bj * HALF;
                    *(u32x4*)p = w; } }
    }
};

struct EpiMerge {
    static constexpr bool PERM = true, HOOK = true; static constexpr int H1 = 32, H2 = 64;
    const bf16_t* gates; bf16_t* y;
    __device__ __forceinline__ void hook(f32x4 (&acc)[2][2][4][2], const Unit& u, int t, int wr, int wc, int fr, int fq) const {
        const int gsel = (t == H1) ? 0 : 1; const int tid_ = (wr * 4 + wc) * 64 + fq * 16 + fr;
        const unsigned char* gpb = (const unsigned char*)gates + gate_frag_off(gsel, u.pm, u.pn, 0, tid_); const unsigned char* gnb = (const unsigned char*)gates + gate_frag_off(gsel + 1, u.pm, u.pn, 0, tid_);
        u32x2 gp[16], gn[16];
#pragma unroll
        for (int sl = 0; sl < 16; ++sl) { gp[sl] = *(const u32x2*)(gpb + (size_t)sl * 4096); gn[sl] = *(const u32x2*)(gnb + (size_t)sl * 4096); }
        asm volatile("" ::: "memory");
#pragma unroll
        for (int sl = 0; sl < 16; ++sl) { const int ai = sl >> 3, m = (sl >> 1) & 3, bj = sl & 1;
#pragma unroll
            for (int n = 0; n < 2; ++n) { const unsigned wp = n ? gp[sl].y : gp[sl].x, wn = n ? gn[sl].y : gn[sl].x;
#pragma unroll
                for (int k = 0; k < 4; ++k) acc[ai][bj][m][n][k] *= gate_b(wp, k) * __builtin_amdgcn_rcpf(gate_b(wn, k)); } }
        asm volatile("" ::: "memory");
    }
    __device__ __forceinline__ void operator()(const f32x4 (&acc)[2][2][4][2], const Unit& u, int wr, int wc, int fr, int fq) const {
        const int row0 = u.pm * BM + wr * 64 + fr, col0 = u.pn * BM + wc * 32 + 8 * fq;
        const unsigned char* gmb = (const unsigned char*)gates + gate_frag_off(2, u.pm, u.pn, 0, (wr * 4 + wc) * 64 + fq * 16 + fr);
        u32x2 gm[16];
#pragma unroll
        for (int sl = 0; sl < 16; ++sl) gm[sl] = *(const u32x2*)(gmb + (size_t)sl * 4096);
        asm volatile("" ::: "memory");
#pragma unroll
        for (int sl = 0; sl < 16; ++sl) { const int ai = sl >> 3, m = (sl >> 1) & 3, bj = sl & 1; const size_t r = (size_t)(row0 + ai * HALF + m * 16); float o[8];
#pragma unroll
            for (int k = 0; k < 4; ++k) { o[k] = acc[ai][bj][m][0][k] * (gate_b(gm[sl].x, k) * (1.0f / 255.0f)); o[4 + k] = acc[ai][bj][m][1][k] * (gate_b(gm[sl].y, k) * (1.0f / 255.0f)); }
            u32x4 w; w.x = cvt_pk_bf16(o[0], o[1]); w.y = cvt_pk_bf16(o[2], o[3]); w.z = cvt_pk_bf16(o[4], o[5]); w.w = cvt_pk_bf16(o[6], o[7]);
            *(u32x4*)(y + tiled_off((int)r, col0 + bj * HALF, DM / 64)) = w; }
    }
};

struct EpiWo {
    static constexpr bool PERM = true, HOOK = false; static constexpr int H1 = -1, H2 = -1;
    const float* xin; bf16_t* x1b; bf16_t* h2; const float* gain; float* part;
    __device__ __forceinline__ void hook(f32x4 (&)[2][2][4][2], const Unit&, int, int, int, int, int) {}
    __device__ __forceinline__ void operator()(const f32x4 (&acc)[2][2][4][2], const Unit& u, int wr, int wc, int fr, int fq) const {
        const int row0 = u.pm * BM + wr * 64 + fr, col0 = u.pn * BM + wc * 32 + 8 * fq;
        f32x4 gv[2][2];
#pragma unroll
        for (int bj = 0; bj < 2; ++bj)
#pragma unroll
            for (int n = 0; n < 2; ++n) gv[bj][n] = *(const f32x4*)(gain + col0 + bj * HALF + n * 4);
#pragma unroll
        for (int ai = 0; ai < 2; ++ai) {
#pragma unroll
            for (int mp = 0; mp < 2; ++mp) {
            f32x4 xv[2][2][2];
#pragma unroll
            for (int m2 = 0; m2 < 2; ++m2)
#pragma unroll
                for (int bj = 0; bj < 2; ++bj)
#pragma unroll
                    for (int n = 0; n < 2; ++n) xv[m2][bj][n] = *(const f32x4*)(xin + (size_t)(row0 + ai * HALF + (2 * mp + m2) * 16) * DM + col0 + bj * HALF + n * 4);
            asm volatile("" ::: "memory");
#pragma unroll
            for (int m2 = 0; m2 < 2; ++m2) { const int m = 2 * mp + m2; const int r = row0 + ai * HALF + m * 16; const size_t off = (size_t)r * DM + col0; float s = 0.f;
#pragma unroll
                for (int bj = 0; bj < 2; ++bj) { u32x4 wx, wh;
#pragma unroll
                    for (int n = 0; n < 2; ++n) { const f32x4 x1 = xv[m2][bj][n] + acc[ai][bj][m][n];
                        s += (x1[0] * x1[0] + x1[1] * x1[1]) + (x1[2] * x1[2] + x1[3] * x1[3]);
                        const f32x4 hv = x1 * gv[bj][n];
                        wx[2 * n] = cvt_pk_bf16(x1[0], x1[1]); wx[2 * n + 1] = cvt_pk_bf16(x1[2], x1[3]);
                        wh[2 * n] = cvt_pk_bf16(hv[0], hv[1]); wh[2 * n + 1] = cvt_pk_bf16(hv[2], hv[3]); }
                    *(u32x4*)(x1b + off + bj * HALF) = wx;
                    *(u32x4*)(h2 + tiled_off(r, col0 + bj * HALF, DM / 64)) = wh; }
                s += __shfl_xor(s, 16); s += __shfl_xor(s, 32);
                if (fq == 0) part[(size_t)(u.pn * 4 + wc) * M + r] = s; }
            asm volatile("" ::: "memory");
            }
        }
    }
};

struct EpiFfnIn {
    static constexpr bool PERM = true, HOOK = false; static constexpr int H1 = -1, H2 = -1;
    bf16_t* hid; const LAS float* rs;
    __device__ __forceinline__ void hook(f32x4 (&)[2][2][4][2], const Unit&, int, int, int, int, int) {}
    __device__ __forceinline__ void operator()(const f32x4 (&acc)[2][2][4][2], const Unit& u, int wr, int wc, int fr, int fq) const {
        const int rl0 = wr * 64 + fr, col0 = u.pn * HALF + wc * 32 + 8 * fq;
#pragma unroll
        for (int ai = 0; ai < 2; ++ai)
#pragma unroll
            for (int m = 0; m < 4; ++m) { const int rl = rl0 + ai * HALF + m * 16; const float sc = rs[rl]; float o[8];
#pragma unroll
                for (int n = 0; n < 2; ++n)
#pragma unroll
                    for (int j = 0; j < 4; ++j) { const float gt = acc[ai][0][m][n][j] * sc, up = acc[ai][1][m][n][j] * sc; o[4 * n + j] = siluf_(gt) * up; }
                u32x4 w; w.x = cvt_pk_bf16(o[0], o[1]); w.y = cvt_pk_bf16(o[2], o[3]); w.z = cvt_pk_bf16(o[4], o[5]); w.w = cvt_pk_bf16(o[6], o[7]);
                *(u32x4*)(hid + tiled_off(u.pm * BM + rl, col0, DFF / 64)) = w;
                asm volatile("" ::: "memory"); }
    }
};
struct RsOrder : StaticOrder {
    const float* part; LAS float* rs; int cur_pm;
    __device__ __forceinline__ void a_ready(const Unit& u) {
        if (u.pm == cur_pm) return;
        cur_pm = u.pm;
        const int tid = threadIdx.x, row = tid >> 1, hf = tid & 1; float s = 0.f;
        const float* p = part + (size_t)(hf * 32) * M + (size_t)u.pm * BM + row;
#pragma unroll 8
        for (int j = 0; j < 32; ++j) s += p[(size_t)j * M];
        s += __shfl_xor(s, 1);
        if (hf == 0) rs[row] = 1.0f / sqrtf(s * (1.0f / DM) + EPS);
        asm volatile("s_waitcnt lgkmcnt(0)" ::: "memory");
    }
};

struct EpiFfnOut {
    static constexpr bool PERM = true, HOOK = false; static constexpr int H1 = -1, H2 = -1;
    bf16_t* x1b; float* part;
    __device__ __forceinline__ void hook(f32x4 (&)[2][2][4][2], const Unit&, int, int, int, int, int) {}
    __device__ __forceinline__ void operator()(const f32x4 (&acc)[2][2][4][2], const Unit& u, int wr, int wc, int fr, int fq) const {
        const int row0 = u.pm * BM + wr * 64 + fr, col0 = u.pn * BM + wc * 32 + 8 * fq;
#pragma unroll
        for (int ai = 0; ai < 2; ++ai) {
            u32x4 xv[4][2];
#pragma unroll
            for (int m = 0; m < 4; ++m)
#pragma unroll
                for (int bj = 0; bj < 2; ++bj) xv[m][bj] = *(const u32x4*)(x1b + (size_t)(row0 + ai * HALF + m * 16) * DM + col0 + bj * HALF);
            asm volatile("" ::: "memory");
#pragma unroll
            for (int m = 0; m < 4; ++m) { const int r = row0 + ai * HALF + m * 16; const size_t off = (size_t)r * DM + col0; float s = 0.f;
#pragma unroll
                for (int bj = 0; bj < 2; ++bj) { u32x4 wx;
#pragma unroll
                    for (int n = 0; n < 2; ++n) { const unsigned w0 = xv[m][bj][2 * n], w1 = xv[m][bj][2 * n + 1];
                        const f32x4 x1 = {bflo(w0), bfhi(w0), bflo(w1), bfhi(w1)}; const f32x4 x2 = x1 + acc[ai][bj][m][n];
                        s += (x2[0] * x2[0] + x2[1] * x2[1]) + (x2[2] * x2[2] + x2[3] * x2[3]);
                        wx[2 * n] = cvt_pk_bf16(x2[0], x2[1]); wx[2 * n + 1] = cvt_pk_bf16(x2[2], x2[3]); }
                    *(u32x4*)(x1b + off + bj * HALF) = wx; }
                s += __shfl_xor(s, 16); s += __shfl_xor(s, 32);
                if (fq == 0) part[(size_t)(u.pn * 4 + wc) * M + r] = s; }
            asm volatile("" ::: "memory");
        }
    }
};
}

#define XB_TMO      128
#define XB_XCNT(j)  (256  + 64 * (j))
#define XB_XSUB(j)  (1280 + 64 * (j))
#define XB_XGEN(j)  (2304 + 64 * (j))
#define XB_TOP      3328
#define XB_TOPGEN   3392
#define XCD_BAR_WORDS 3456
#define XB_SPIN_CAP (1u << 18)
__device__ __forceinline__ unsigned xb_ld(unsigned* p)              { return __hip_atomic_load(p, __ATOMIC_RELAXED, __HIP_MEMORY_SCOPE_AGENT); }
__device__ __forceinline__ unsigned xb_add(unsigned* p, unsigned v) { return __hip_atomic_fetch_add(p, v, __ATOMIC_RELAXED, __HIP_MEMORY_SCOPE_AGENT); }
__device__ __forceinline__ unsigned xb_xcc_id() { return (unsigned)__builtin_amdgcn_s_getreg((3 << 11) | 20) & 0xFu; }
#define XB_SPIN(cond, bar) do { unsigned _sp = 0; while (cond) { __builtin_amdgcn_s_sleep(1); \
    if ((++_sp & 255u) == 0u) { if (xb_ld(&(bar)[XB_TMO])) break; if (_sp > XB_SPIN_CAP) { atomicAdd(&(bar)[XB_TMO], 1u); break; } } } } while (0)
struct XcdBarrier { unsigned* bar; unsigned x; volatile LAS unsigned* st; };
__device__ __forceinline__ XcdBarrier xcd_barrier_post(unsigned* bar, volatile LAS unsigned* st) {
    XcdBarrier b; b.bar = bar; b.x = xb_xcc_id(); b.st = st;
    if (threadIdx.x == 0) (void)xb_add(&bar[XB_XCNT(b.x)], 1u);
    return b;
}
__device__ __forceinline__ void xcd_barrier_complete(unsigned* bar, unsigned x, unsigned& nloc, unsigned& nx) {
    const unsigned G = gridDim.x * gridDim.y * gridDim.z;
    unsigned sum, cnt, mine, sp = 0u;
    for (;;) {
        sum = 0u; cnt = 0u; mine = 0u;
#pragma unroll
        for (unsigned j = 0; j < 16; ++j) { const unsigned c = xb_ld(&bar[XB_XCNT(j)]); sum += c; cnt += (c > 0u) ? 1u : 0u; mine = (j == x) ? c : mine; }
        if (sum == G) break;
        __builtin_amdgcn_s_sleep(1);
        if ((++sp & 255u) == 0u) { if (xb_ld(&bar[XB_TMO])) break; if (sp > XB_SPIN_CAP) { atomicAdd(&bar[XB_TMO], 1u); break; } }
    }
    nloc = mine > 0u ? mine : 1u; nx = cnt > 0u ? cnt : 1u;
}
__device__ __forceinline__ void xcd_barrier(const XcdBarrier& b) {
    asm volatile("s_waitcnt vmcnt(0)" ::: "memory");
    __syncthreads();
    if (threadIdx.x == 0) {
        unsigned* bar = b.bar;
        __builtin_amdgcn_s_waitcnt(0);
        unsigned nloc = b.st[0], nx = b.st[1];
        if (nloc == 0u) { xcd_barrier_complete(bar, b.x, nloc, nx); b.st[0] = nloc; b.st[1] = nx; }
        const unsigned old = xb_add(&bar[XB_XSUB(b.x)], 1u);
        const unsigned gen = old / nloc;
        if (old + 1u == (gen + 1u) * nloc) {
            __builtin_amdgcn_fence(__ATOMIC_RELEASE, "agent");
            asm volatile("s_waitcnt vmcnt(0)" ::: "memory");
            const unsigned og = xb_add(&bar[XB_TOP], 1u);
            const unsigned tg = og / nx;
            if (og + 1u == (tg + 1u) * nx) xb_add(&bar[XB_TOPGEN], 1u);
            else XB_SPIN(xb_ld(&bar[XB_TOPGEN]) == tg, bar);
            __builtin_amdgcn_fence(__ATOMIC_ACQUIRE, "agent");
            xb_add(&bar[XB_XGEN(b.x)], 1u);
            asm volatile("s_waitcnt vmcnt(0)" ::: "memory");
        } else {
            XB_SPIN(xb_ld(&bar[XB_XGEN(b.x)]) == gen, bar);
            __builtin_amdgcn_fence(__ATOMIC_ACQUIRE, "agent");
            asm volatile("s_waitcnt vmcnt(0)" ::: "memory");
        }
    }
    __syncthreads();
}

struct Args {
    const float *x, *mem, *rel_bias, *g_mix, *w_in, *conv_w, *a_log, *dt_bias, *g_dn_out, *sinks, *g_mem, *w_mem_kv, *w_br_a, *w_br_b, *w_br_m, *w_o, *g_ffn, *w_ffn_in, *w_ffn_out, *g_final;
    float* out; unsigned char* ws; int ph_lo, ph_hi;
};
constexpr int NPHASE = 10;

__device__ __forceinline__ void p0_transpose_item(const float* W, int ldw, int src_col0, int k0, bf16_t* WT, size_t dst_row0, int ldt  , int dst_k0, LAS float* scr, int lane) {
    if (src_col0 >= 0) {
#pragma unroll 8
        for (int i = 0; i < 32; ++i) { const int kk = 2 * i + (lane >> 5); scr[kk * 33 + (lane & 31)] = W[(size_t)(k0 + kk) * ldw + src_col0 + (lane & 31)]; }
    } else {
#pragma unroll 8
        for (int i = 0; i < 32; ++i) { const int kk = 2 * i + (lane >> 5); scr[kk * 33 + (lane & 31)] = 0.f; }
    }
    asm volatile("s_waitcnt lgkmcnt(0)" ::: "memory");
    const int c = lane & 7;
#pragma unroll
    for (int j = 0; j < 4; ++j) { const int n = (lane >> 3) + 8 * j; const LAS float* s = scr + (8 * c) * 33 + n;
        u32x4 o; o.x = pk2(s[0 * 33], s[1 * 33]); o.y = pk2(s[2 * 33], s[3 * 33]); o.z = pk2(s[4 * 33], s[5 * 33]); o.w = pk2(s[6 * 33], s[7 * 33]);
        *(u32x4*)(WT + tiled_off((int)dst_row0 + n, dst_k0 + k0 + 8 * c, ldt / 64)) = o; }
    asm volatile("s_waitcnt lgkmcnt(0)" ::: "memory");
}
__device__ __forceinline__ void rms_row_to_bf16(const float* xrow, const float* gain, bf16_t* obase, int row, int lane) {
    const f32x4* xr = (const f32x4*)xrow + lane; const f32x4* gr = (const f32x4*)gain + lane;
    f32x4 v[16]; float s = 0.f;
#pragma unroll
    for (int j = 0; j < 16; ++j) { v[j] = xr[64 * j]; s += (v[j][0] * v[j][0] + v[j][1] * v[j][1]) + (v[j][2] * v[j][2] + v[j][3] * v[j][3]); }
    const float rstd = 1.0f / sqrtf(wave_sum(s) * (1.0f / DM) + EPS);
#pragma unroll
    for (int j = 0; j < 16; ++j) { const f32x4 gv = gr[64 * j]; u32x2 w; w.x = pk2(v[j][0] * rstd * gv[0], v[j][1] * rstd * gv[1]); w.y = pk2(v[j][2] * rstd * gv[2], v[j][3] * rstd * gv[3]);
        *(u32x2*)(obase + tiled_off(row, 4 * lane + 256 * j, DM / 64)) = w; }
}

__device__ __forceinline__ int t5_bucket_dev(int n) {
    if (n < 16) return n;
    const float nf = (float)n;
    int large = 16 + (int)(logf(nf / 16.0f) / 2.0794415416798357f * 16.0f);
    return large < 31 ? large : 31;
}
constexpr int GDN_UNITS = BATCH * B_HEADS * (SEQ / 64);
constexpr int L_QS = 0, L_KS = 17408, L_RT = 34816, L_KDT = 71680, L_AM = 90112, L_TB = 107520, L_G = 116736, L_CW = 117504;
__device__ __forceinline__ f32x4 mfma16(bf16x8 a, bf16x8 b, f32x4 c) { return __builtin_amdgcn_mfma_f32_16x16x32_bf16(a, b, c, 0, 0, 0); }
__device__ __forceinline__ int perm_pos(int t) { const int t32 = t & 31; return (t & 32) + 8 * ((t32 >> 2) & 3) + 4 * (t32 >> 4) + (t32 & 3); }

constexpr int L_DINV = 123648;
struct GdnRaw { u32x4 w[3][4][2]; };
__device__ __forceinline__ void gdn_load_raw(GdnRaw& R, int unit, const bf16_t* bqkv, int tid) {
    const int bh = unit >> 7, n = unit & 127, b = bh >> 4, h = bh & 15, t = tid >> 3, c0 = (tid & 7) * 16;
    const long tok0 = (long)b * SEQ + (long)n * 64;
#pragma unroll
    for (int xi = 0; xi < 3; ++xi)
#pragma unroll
        for (int j = 0; j < 4; ++j) { const int row = t + j - 3;
            if (n * 64 + row >= 0) { const bf16_t* src = bqkv + (size_t)(tok0 + row) * 6144 + xi * 2048 + h * 128 + c0;
                R.w[xi][j][0] = *(const u32x4*)src; R.w[xi][j][1] = *(const u32x4*)(src + 8); }
            else { R.w[xi][j][0] = (u32x4){0u, 0u, 0u, 0u}; R.w[xi][j][1] = (u32x4){0u, 0u, 0u, 0u}; } }
}
__device__ __forceinline__ f32x4 mfma4f(float a, float b, f32x4 c) { return __builtin_amdgcn_mfma_f32_16x16x4f32(a, b, c, 0, 0, 0); }

__device__ __forceinline__ void gdn_local_unit(int unit, const Args& a, LAS unsigned char* lds0, const bf16_t* bqkv, const float* ba,
        bf16_t* GW, bf16_t* GKDT, bf16_t* GATT, float* GL, bf16_t* GQG, bf16_t* GUT, int tid0, int wave) {
    LAS unsigned char* lds = lds0; asm volatile("" : "+v"(lds));
    int tid = tid0; asm volatile("" : "+v"(tid));
    const int lane = tid & 63;
    const int bh = unit >> 7, n = unit & 127, b = bh >> 4, h = bh & 15, fr = lane & 15, fq = lane >> 4;
    const long tok0 = (long)b * SEQ + (long)n * 64;
    LAS float* CW = (LAS float*)(lds + L_CW);
    LAS float* Gs = (LAS float*)(lds + L_G); LAS float* GCs = Gs + 64; LAS float* BTs = Gs + 128;
    const int t = tid >> 3, cg = tid & 7, c0 = cg * 16;
#ifndef GP_A
#define GP_A 1
#define GP_B 1
#define GP_C 1
#define GP_D 1
#endif
    for (int rrA = 0; rrA < GP_A; ++rrA) {
    float beta;
    { const float bb = ba[(tok0 + t) * 32 + h], bav = ba[(tok0 + t) * 32 + 16 + h];
      beta = sigmoidf_(bb); const float z = bav + a.dt_bias[h]; const float sp = z > 20.f ? z : log1pf(__expf(z));
      const float g = -__expf(a.a_log[h]) * sp;
      if (cg == 0) { Gs[t] = g; BTs[t] = beta; } }
    __syncthreads();
    if (wave == 0) { float v = Gs[lane];
#pragma unroll
        for (int o = 1; o < 64; o <<= 1) { const float u = __shfl_up(v, o); if (lane >= o) v += u; }
        GCs[lane] = v; }
    float y[3][16];
#pragma unroll
    for (int xi = 0; xi < 3; ++xi) {
#pragma unroll
        for (int i = 0; i < 16; ++i) y[xi][i] = 0.f;
#pragma unroll
        for (int j = 0; j < 4; ++j) {
            const int row = t + j - 3;
            if (j == 2) asm volatile("" ::: "memory");
            const bool rok = (n * 64 + row >= 0);
            const bf16_t* src = bqkv + (size_t)(tok0 + (rok ? row : 0)) * 6144 + xi * 2048 + h * 128 + c0;
            u32x4 w0 = *(const u32x4*)src, w1 = *(const u32x4*)(src + 8);
            const unsigned msk = rok ? 0xffffffffu : 0u; w0 = w0 & msk; w1 = w1 & msk;
            const LAS float* cw = CW + xi * 512 + j * 128 + c0;
            const f32x4 k0 = *(const LAS f32x4*)cw, k1 = *(const LAS f32x4*)(cw + 4), k2 = *(const LAS f32x4*)(cw + 8), k3 = *(const LAS f32x4*)(cw + 12);
            y[xi][0] += k0[0] * bflo(w0[0]); y[xi][1] += k0[1] * bfhi(w0[0]); y[xi][2] += k0[2] * bflo(w0[1]); y[xi][3] += k0[3] * bfhi(w0[1]);
            y[xi][4] += k1[0] * bflo(w0[2]); y[xi][5] += k1[1] * bfhi(w0[2]); y[xi][6] += k1[2] * bflo(w0[3]); y[xi][7] += k1[3] * bfhi(w0[3]);
            y[xi][8] += k2[0] * bflo(w1[0]); y[xi][9] += k2[1] * bfhi(w1[0]); y[xi][10] += k2[2] * bflo(w1[1]); y[xi][11] += k2[3] * bfhi(w1[1]);
            y[xi][12] += k3[0] * bflo(w1[2]); y[xi][13] += k3[1] * bfhi(w1[2]); y[xi][14] += k3[2] * bflo(w1[3]); y[xi][15] += k3[3] * bfhi(w1[3]);
        }
#pragma unroll
        for (int i = 0; i < 16; ++i) y[xi][i] = siluf_(y[xi][i]);
        asm volatile("" ::: "memory");
    }
    float sq = 0.f, sk = 0.f;
#pragma unroll
    for (int i = 0; i < 16; ++i) { sq += y[0][i] * y[0][i]; sk += y[1][i] * y[1][i]; }
    sq += __shfl_xor(sq, 1); sq += __shfl_xor(sq, 2); sq += __shfl_xor(sq, 4);
    sk += __shfl_xor(sk, 1); sk += __shfl_xor(sk, 2); sk += __shfl_xor(sk, 4);
    const float rq = __builtin_amdgcn_rsqf(sq + EPS) * 0.08838834764831845f, rk = __builtin_amdgcn_rsqf(sk + EPS);
    __syncthreads();
    const float gct = GCs[t], glast = GCs[63];
    const float e1 = __expf(gct), e2 = __expf(glast - gct);
    if (tid == 0) GL[unit] = __expf(glast);
    {
        u32x4 kq[2], qq[2], qg[2];
#pragma unroll
        for (int i = 0; i < 8; ++i) { const float k0 = y[1][2 * i] * rk, k1 = y[1][2 * i + 1] * rk, q0 = y[0][2 * i] * rq, q1 = y[0][2 * i + 1] * rq;
            kq[i >> 2][i & 3] = cvt_pk_bf16(k0, k1); qq[i >> 2][i & 3] = cvt_pk_bf16(q0, q1); qg[i >> 2][i & 3] = cvt_pk_bf16(q0 * e1, q1 * e1); }
        *(LAS u32x4*)(lds + L_KS + t * 272 + c0 * 2) = kq[0]; *(LAS u32x4*)(lds + L_KS + t * 272 + c0 * 2 + 16) = kq[1];
        *(LAS u32x4*)(lds + L_QS + t * 272 + c0 * 2) = qq[0]; *(LAS u32x4*)(lds + L_QS + t * 272 + c0 * 2 + 16) = qq[1];
        bf16_t* qgp = GQG + (size_t)unit * 8192 + t * 128 + (c0 & ~31) + 4 * (cg & 1);
        *(u32x2*)(qgp) = (u32x2){qg[0].x, qg[0].y}; *(u32x2*)(qgp + 8) = (u32x2){qg[0].z, qg[0].w}; *(u32x2*)(qgp + 16) = (u32x2){qg[1].x, qg[1].y}; *(u32x2*)(qgp + 24) = (u32x2){qg[1].z, qg[1].w};
    }
    {
        const int tp = (t + 8 * cg) & 63, pt = (perm_pos(t) + 8 * cg) & 63;
#pragma unroll
        for (int i = 0; i < 16; i += 2) { const float kn0 = y[1][i] * rk, kn1 = y[1][i + 1] * rk;
            const unsigned pv = cvt_pk_bf16(beta * y[2][i], beta * y[2][i + 1]), pk = cvt_pk_bf16(beta * kn0 * e1, beta * kn1 * e1), pd = cvt_pk_bf16(kn0 * e2, kn1 * e2);
            *(LAS unsigned short*)(lds + L_RT + (c0 + i) * 144 + tp * 2) = (unsigned short)(pv & 0xffffu); *(LAS unsigned short*)(lds + L_RT + (c0 + i + 1) * 144 + tp * 2) = (unsigned short)(pv >> 16);
            *(LAS unsigned short*)(lds + L_RT + (128 + c0 + i) * 144 + tp * 2) = (unsigned short)(pk & 0xffffu); *(LAS unsigned short*)(lds + L_RT + (128 + c0 + i + 1) * 144 + tp * 2) = (unsigned short)(pk >> 16);
            *(LAS unsigned short*)(lds + L_KDT + (c0 + i) * 144 + pt * 2) = (unsigned short)(pd & 0xffffu); *(LAS unsigned short*)(lds + L_KDT + (c0 + i + 1) * 144 + pt * 2) = (unsigned short)(pd >> 16); }
    }
    __syncthreads();
    }
    for (int rrB = 0; rrB < GP_B; ++rrB) {
#pragma unroll
    for (int q = 0; q < 2; ++q) {
        const int idx = 2 * wave + q, ct = idx >> 2, st = idx & 3;
        f32x4 acc = (f32x4){0.f, 0.f, 0.f, 0.f}, acc2 = (f32x4){0.f, 0.f, 0.f, 0.f};
        if (st <= ct) {
#pragma unroll
            for (int kk = 0; kk < 4; ++kk) {
                const bf16x8 kc = *(const LAS bf16x8*)(lds + L_KS + (ct * 16 + fr) * 272 + (32 * kk + 8 * fq) * 2);
                const bf16x8 ks = *(const LAS bf16x8*)(lds + L_KS + (st * 16 + fr) * 272 + (32 * kk + 8 * fq) * 2);
                const bf16x8 qc = *(const LAS bf16x8*)(lds + L_QS + (ct * 16 + fr) * 272 + (32 * kk + 8 * fq) * 2);
                acc = mfma16(kc, ks, acc);
                acc2 = mfma16(ks, qc, acc2);
            }
        }
        {   const int sc = st * 16 + fr; const float gcs = GCs[sc];
#pragma unroll
            for (int r = 0; r < 4; ++r) { const int c = ct * 16 + 4 * fq + r; const float dl = fminf(GCs[c] - gcs, 0.f);
                const float v = (sc < c) ? BTs[c] * acc[r] * __expf(dl) : 0.f;
                *(LAS float*)(lds + L_AM + c * 272 + sc * 4) = v; } }
        {   const int c = ct * 16 + fr; const float gcc = GCs[c]; float o[4];
#pragma unroll
            for (int r = 0; r < 4; ++r) { const int sr = st * 16 + 4 * fq + r; const float dl = fminf(gcc - GCs[sr], 0.f); o[r] = (sr <= c) ? acc2[r] * __expf(dl) : 0.f; }
            u32x2 w; w.x = cvt_pk_bf16(o[0], o[1]); w.y = cvt_pk_bf16(o[2], o[3]);
            *(u32x2*)(GATT + (size_t)unit * 4096 + c * 64 + 32 * (st >> 1) + 8 * fq + 4 * (st & 1)) = w; }
    }
    __syncthreads();
    }
    for (int rrC = 0; rrC < GP_C; ++rrC) {
    if (wave < 4) {
        const int bi = wave; float x[16];
#pragma unroll
        for (int i = 0; i < 16; ++i) x[i] = 0.f;
#pragma unroll
        for (int i = 0; i < 16; ++i) {
            float s0 = (fr == i) ? 1.f : 0.f, s1 = 0.f, s2 = 0.f, s3 = 0.f;
#pragma unroll
            for (int m4 = 0; m4 < (i + 3) / 4; ++m4) { const f32x4 a4 = *(const LAS f32x4*)(lds + L_AM + (16 * bi + i) * 272 + (16 * bi) * 4 + m4 * 16);
                s0 -= a4[0] * x[4 * m4]; s1 -= a4[1] * x[4 * m4 + 1]; s2 -= a4[2] * x[4 * m4 + 2]; s3 -= a4[3] * x[4 * m4 + 3]; }
            x[i] = (s0 + s1) + (s2 + s3);
        }
        if (fq == 0) {
#pragma unroll
            for (int i = 0; i < 16; ++i) { *(LAS float*)(lds + L_DINV + bi * 1280 + i * 80 + fr * 4) = x[i];
                *(LAS unsigned short*)(lds + L_TB + (16 * bi + i) * 144 + (16 * bi + fr) * 2) = (unsigned short)(cvt_pk_bf16(x[i], 0.f) & 0xffffu); }
        } else {
            const int bj = bi + fq;
            if (bj < 4) {
#pragma unroll
                for (int i = 0; i < 16; ++i) *(LAS unsigned short*)(lds + L_TB + (16 * bi + i) * 144 + (16 * bj + fr) * 2) = (unsigned short)0; }
        }
    } else {
        for (int idx = tid - 256; idx < 1024; idx += 256) { const int row = idx >> 3, ch = idx & 7;
            *(u32x4*)(GKDT + (size_t)unit * 8192 + row * 64 + ch * 8) = *(const LAS u32x4*)(lds + L_KDT + row * 144 + (((8 * ch + 8 * (row >> 4)) & 63) * 2)); }
    }
    __syncthreads();
    if (wave < 3) {
        const int j = wave;
        f32x4 Tc[4];
#pragma unroll
        for (int k = 0; k < 4; ++k) Tc[k] = (f32x4){0.f, 0.f, 0.f, 0.f};
#pragma unroll
        for (int k = 0; k < 3; ++k) if (k == j) {
#pragma unroll
            for (int kk = 0; kk < 4; ++kk) Tc[k][kk] = *(const LAS float*)(lds + L_DINV + k * 1280 + (4 * fq + kk) * 80 + fr * 4); }
#pragma unroll
        for (int i = 1; i < 4; ++i) if (i > j) {
            f32x4 Mx = (f32x4){0.f, 0.f, 0.f, 0.f};
#pragma unroll
            for (int k = 0; k < 3; ++k) if (k >= j && k < i) {
                const f32x4 a4 = *(const LAS f32x4*)(lds + L_AM + (16 * i + fr) * 272 + (16 * k + 4 * fq) * 4);
#pragma unroll
                for (int kk = 0; kk < 4; ++kk) Mx = mfma4f(a4[kk], Tc[k][kk], Mx); }
            f32x4 Tx = (f32x4){0.f, 0.f, 0.f, 0.f};
            const f32x4 d4 = *(const LAS f32x4*)(lds + L_DINV + i * 1280 + fr * 80 + (4 * fq) * 4);
#pragma unroll
            for (int kk = 0; kk < 4; ++kk) Tx = mfma4f(d4[kk], Mx[kk], Tx);
            Tc[i] = -Tx;
#pragma unroll
            for (int kk = 0; kk < 4; ++kk) *(LAS unsigned short*)(lds + L_TB + (16 * i + 4 * fq + kk) * 144 + (16 * j + fr) * 2) = (unsigned short)(cvt_pk_bf16(Tc[i][kk], 0.f) & 0xffffu);
        }
    }
    __syncthreads();
    }
    for (int rrD = 0; rrD < GP_D; ++rrD) {
#pragma unroll
    for (int q = 0; q < 4; ++q) {
        const int idx = 4 * wave + q;
        {   const int ct = idx >> 3, nt = idx & 7; f32x4 acc = (f32x4){0.f, 0.f, 0.f, 0.f};
#pragma unroll
            for (int kk = 0; kk < 2; ++kk) {
                const bf16x8 ta = *(const LAS bf16x8*)(lds + L_TB + (ct * 16 + fr) * 144 + (32 * kk + 8 * fq) * 2);
                const bf16x8 rb = *(const LAS bf16x8*)(lds + L_RT + (nt * 16 + fr) * 144 + (((32 * kk + 8 * fq + 8 * nt) & 63) * 2));
                acc = mfma16(ta, rb, acc); }
            u32x2 w; w.x = cvt_pk_bf16(acc[0], acc[1]); w.y = cvt_pk_bf16(acc[2], acc[3]);
            *(u32x2*)(GUT + (size_t)unit * 8192 + (nt * 16 + fr) * 64 + ct * 16 + 4 * fq) = w; }
        {   const int it = idx >> 2, ct = idx & 3; f32x4 acc = (f32x4){0.f, 0.f, 0.f, 0.f};
#pragma unroll
            for (int kk = 0; kk < 2; ++kk) {
                const bf16x8 ra = *(const LAS bf16x8*)(lds + L_RT + (128 + it * 16 + fr) * 144 + (((32 * kk + 8 * fq + 8 * it) & 63) * 2));
                const bf16x8 tb = *(const LAS bf16x8*)(lds + L_TB + (ct * 16 + fr) * 144 + (32 * kk + 8 * fq) * 2);
                acc = mfma16(ra, tb, acc); }
            u32x2 w; w.x = cvt_pk_bf16(acc[0], acc[1]); w.y = cvt_pk_bf16(acc[2], acc[3]);
            *(u32x2*)(GW + (size_t)unit * 8192 + (ct * 16 + fr) * 128 + 32 * (it >> 1) + 8 * fq + 4 * (it & 1)) = w; }
    }
    __syncthreads();
    }
}

constexpr int GS_SPW = 2, GS_SLOT = 36864, GS_D = 4;
__device__ __forceinline__ void gdn_scan(int bh, int sg, LAS unsigned char* lds, const bf16_t* GW, const bf16_t* GKDT, const bf16_t* GUT, const float* GL, bf16_t* GST, bf16_t* GVT, int tid, int lane, int wave) {
    const int fr = lane & 15, fq = lane >> 4;
    LAS float* DEC = (LAS float*)(lds + DEC_OFF);
    if (tid < 128) DEC[tid] = GL[bh * 128 + tid];
    const bool comp = wave < GS_SPW;
    const int slice = sg * GS_SPW + wave;
    const size_t ubase = (size_t)bh * 128;
    unsigned goff[6], dsto[6]; int kind[6];
#pragma unroll
    for (int k = 0; k < 6; ++k) { const int p = (wave - GS_SPW) * 6 + k;
        if (p < 16) { const int r = 4 * p + (lane >> 4), qd = lane & 15; goff[k] = (unsigned)(r * 256 + ((qd ^ (r & 15)) * 16)); dsto[k] = (unsigned)p * 1024u; kind[k] = 0; }
        else if (p < 32) { const int pp = p - 16, r = 8 * pp + (lane >> 3), qd = lane & 7; goff[k] = (unsigned)(r * 128 + ((qd ^ ((r >> 1) & 7)) * 16)); dsto[k] = 16384u + (unsigned)pp * 1024u; kind[k] = 1; }
        else { const int u = p - 32, cw = u >> 1, k2 = u & 1; goff[k] = (unsigned)((sg * GS_SPW + cw) * 2048 + k2 * 1024 + lane * 16); dsto[k] = 32768u + (unsigned)(cw * 2048 + k2 * 1024); kind[k] = 2; } }
#define GS_ISSUE(step, slot) do { if (!comp) { const size_t _u = ubase + (size_t)(step); \
        _Pragma("unroll") for (int _k = 0; _k < 6; ++_k) { const char* _g = (const char*)((kind[_k] == 0 ? GW : (kind[_k] == 1 ? GKDT : GUT)) + _u * 8192); \
            __builtin_amdgcn_global_load_lds((const unsigned*)(_g + goff[_k]), (LAS unsigned*)(lds + (slot) * GS_SLOT + dsto[_k]), 16, 0, 0); } } \
        asm volatile("" ::: "memory"); } while (0)
    f32x4 S[8];
#pragma unroll
    for (int i = 0; i < 8; ++i) S[i] = (f32x4){0.f, 0.f, 0.f, 0.f};
    asm volatile("s_waitcnt vmcnt(0) lgkmcnt(0)" ::: "memory");
    __builtin_amdgcn_s_barrier();
    GS_ISSUE(0, 0); GS_ISSUE(1, 1); GS_ISSUE(2, 2);
    for (int n = 0; n < 128; ++n) {
        if (!comp) asm volatile("s_waitcnt vmcnt(12)" ::: "memory");
        __builtin_amdgcn_s_barrier();
        asm volatile("" ::: "memory");
        { const int nn = n + 3 < 128 ? n + 3 : 127; const int sl = (n + 3) & 3; GS_ISSUE(nn, sl); }
        if (comp) {
            LAS const unsigned char* sb = lds + (n & 3) * GS_SLOT;
            const size_t unit = ubase + n;
            bf16x8 aw[4][4], ak[2][8];
#pragma unroll
            for (int kk = 0; kk < 4; ++kk)
#pragma unroll
                for (int ct = 0; ct < 4; ++ct) aw[kk][ct] = *(const LAS bf16x8*)(sb + (16 * ct + fr) * 256 + (((4 * kk + fq) ^ fr) * 16));
#pragma unroll
            for (int kk = 0; kk < 2; ++kk)
#pragma unroll
                for (int i = 0; i < 8; ++i) ak[kk][i] = *(const LAS bf16x8*)(sb + 16384 + (16 * i + fr) * 128 + (((4 * kk + fq) ^ ((fr >> 1) & 7)) * 16));
            u32x2 uu[4];
#pragma unroll
            for (int ct = 0; ct < 4; ++ct) uu[ct] = *(const LAS u32x2*)(sb + 32768 + wave * 2048 + fr * 128 + (16 * ct + 4 * fq) * 2);
            const float dec = DEC[n];
            asm volatile("" ::: "memory");
            bf16x8 bs[4];
#pragma unroll
            for (int kk = 0; kk < 4; ++kk) { u32x4 bw; bw.x = cvt_pk_bf16(S[2 * kk][0], S[2 * kk][1]); bw.y = cvt_pk_bf16(S[2 * kk][2], S[2 * kk][3]);
                bw.z = cvt_pk_bf16(S[2 * kk + 1][0], S[2 * kk + 1][1]); bw.w = cvt_pk_bf16(S[2 * kk + 1][2], S[2 * kk + 1][3]);
                *(u32x4*)(GST + unit * 16384 + (16 * slice + fr) * 128 + 32 * kk + 8 * fq) = bw;
                bs[kk] = __builtin_bit_cast(bf16x8, bw); }
            f32x4 av[4];
#pragma unroll
            for (int ct = 0; ct < 4; ++ct) av[ct] = (f32x4){0.f, 0.f, 0.f, 0.f};
#pragma unroll
            for (int kk = 0; kk < 4; ++kk)
#pragma unroll
                for (int ct = 0; ct < 4; ++ct) av[ct] = mfma16(aw[kk][ct], bs[kk], av[ct]);
            bf16x8 bv[2];
#pragma unroll
            for (int kk = 0; kk < 2; ++kk) { u32x4 bw;
                { const int ct = 2 * kk; bw.x = cvt_pk_bf16(bflo(uu[ct].x) - av[ct][0], bfhi(uu[ct].x) - av[ct][1]); bw.y = cvt_pk_bf16(bflo(uu[ct].y) - av[ct][2], bfhi(uu[ct].y) - av[ct][3]); }
                { const int ct = 2 * kk + 1; bw.z = cvt_pk_bf16(bflo(uu[ct].x) - av[ct][0], bfhi(uu[ct].x) - av[ct][1]); bw.w = cvt_pk_bf16(bflo(uu[ct].y) - av[ct][2], bfhi(uu[ct].y) - av[ct][3]); }
                *(u32x4*)(GVT + unit * 8192 + (16 * slice + fr) * 64 + 32 * kk + 8 * fq) = bw;
                bv[kk] = __builtin_bit_cast(bf16x8, bw); }
#pragma unroll
            for (int i = 0; i < 8; ++i) S[i] = S[i] * dec;
#pragma unroll
            for (int kk = 0; kk < 2; ++kk)
#pragma unroll
                for (int i = 0; i < 8; ++i) S[i] = mfma16(ak[kk][i], bv[kk], S[i]);
        }
    }
#undef GS_ISSUE
    asm volatile("s_waitcnt vmcnt(0)" ::: "memory");
    __builtin_amdgcn_s_barrier();
}

constexpr int GO_SLOT = 49152;
__device__ __forceinline__ void gdn_out_units(int u0, int nu, const Args& a, LAS unsigned char* lds, bf16_t* acat, bf16_t* odst, const bf16_t* GQG, const bf16_t* GATT, const bf16_t* GST, const bf16_t* GVT, int tid, int lane, int wave) {
    const int fr = lane & 15, fq = lane >> 4, ct = wave & 3, dvh = wave >> 2;
    LAS float* SSQ = (LAS float*)(lds + DEC_OFF);
    unsigned goff[6]; unsigned dsto[6]; bool isv[6];
#pragma unroll
    for (int k = 0; k < 6; ++k) { const int p = wave * 6 + k;
        if (p < 32) { const int r = 4 * p + (lane >> 4), qd = lane & 15; goff[k] = (unsigned)(r * 256 + ((qd ^ (r & 15)) * 16)); dsto[k] = (unsigned)p * 1024u; isv[k] = false; }
        else { const int pp = p - 32, r = 8 * pp + (lane >> 3), qd = lane & 7; goff[k] = (unsigned)(r * 128 + ((qd ^ ((r >> 1) & 7)) * 16)); dsto[k] = 32768u + (unsigned)pp * 1024u; isv[k] = true; } }
#define GO_ISSUE(unit, slot) do { const char* _s = (const char*)(GST + (size_t)(unit) * 16384); const char* _v = (const char*)(GVT + (size_t)(unit) * 8192); \
        _Pragma("unroll") for (int _k = 0; _k < 6; ++_k) __builtin_amdgcn_global_load_lds((const unsigned*)((isv[_k] ? _v : _s) + goff[_k]), (LAS unsigned*)(lds + (slot) * GO_SLOT + dsto[_k]), 16, 0, 0); \
        asm volatile("" ::: "memory"); } while (0)
    f32x4 gv[4];
#pragma unroll
    for (int i4 = 0; i4 < 4; ++i4) gv[i4] = *(const f32x4*)(a.g_dn_out + 16 * (4 * dvh + i4) + 4 * fq);
    asm volatile("s_waitcnt vmcnt(0) lgkmcnt(0)" ::: "memory");
    __builtin_amdgcn_s_barrier();
    GO_ISSUE(u0, 0); GO_ISSUE(u0 + (nu > 1 ? 1 : 0), 1);
    for (int i = 0; i < nu; ++i) {
        const int unit = u0 + i;
        if (i == 0) asm volatile("s_waitcnt vmcnt(6)" ::: "memory"); else if (i == 1) asm volatile("s_waitcnt vmcnt(20)" ::: "memory"); else asm volatile("s_waitcnt vmcnt(24)" ::: "memory");
        __builtin_amdgcn_s_barrier();
        asm volatile("" ::: "memory");
        const int bh = unit >> 7, n = unit & 127, b = bh >> 4, h = bh & 15;
        const bf16_t* qg = GQG + (size_t)unit * 8192 + (16 * ct + fr) * 128 + 8 * fq;
        const bf16_t* at = GATT + (size_t)unit * 4096 + (16 * ct + fr) * 64 + 8 * fq;
        bf16x8 bq[4], bt[2];
#pragma unroll
        for (int kk = 0; kk < 4; ++kk) bq[kk] = *(const bf16x8*)(qg + 32 * kk);
#pragma unroll
        for (int kk = 0; kk < 2; ++kk) bt[kk] = *(const bf16x8*)(at + 32 * kk);
        const size_t zoff = tiled_off(b * SEQ + n * 64 + 16 * ct + fr, 2048 + h * 128 + 64 * dvh + 4 * fq, KCAT / 64);
        u32x2 zz[4];
#pragma unroll
        for (int i4 = 0; i4 < 4; ++i4) zz[i4] = *(const u32x2*)(acat + zoff + 16 * i4);
        asm volatile("" ::: "memory");
        { const int un = (i + 2 < nu) ? unit + 2 : unit; GO_ISSUE(un, (i + 2) % 3); }
        LAS const unsigned char* sb = lds + (i % 3) * GO_SLOT;
        bf16x8 fs[4][4], fv[4][2];
#pragma unroll
        for (int i4 = 0; i4 < 4; ++i4) { const int row = 16 * (4 * dvh + i4) + fr;
#pragma unroll
            for (int kk = 0; kk < 4; ++kk) fs[i4][kk] = *(const LAS bf16x8*)(sb + row * 256 + (((4 * kk + fq) ^ fr) * 16));
#pragma unroll
            for (int kk = 0; kk < 2; ++kk) fv[i4][kk] = *(const LAS bf16x8*)(sb + 32768 + row * 128 + (((4 * kk + fq) ^ ((fr >> 1) & 7)) * 16)); }
        f32x4 o[4]; float ss = 0.f;
#pragma unroll
        for (int i4 = 0; i4 < 4; ++i4) { f32x4 acc = (f32x4){0.f, 0.f, 0.f, 0.f};
#pragma unroll
            for (int kk = 0; kk < 4; ++kk) acc = mfma16(fs[i4][kk], bq[kk], acc);
#pragma unroll
            for (int kk = 0; kk < 2; ++kk) acc = mfma16(fv[i4][kk], bt[kk], acc);
            o[i4] = acc; ss += (acc[0] * acc[0] + acc[1] * acc[1]) + (acc[2] * acc[2] + acc[3] * acc[3]); }
        ss += __shfl_xor(ss, 16); ss += __shfl_xor(ss, 32);
        LAS float* sq = SSQ + (i & 1) * 128;
        if (fq == 0) sq[dvh * 64 + ct * 16 + fr] = ss;
        asm volatile("s_waitcnt lgkmcnt(0)" ::: "memory");
        __builtin_amdgcn_s_barrier();
        asm volatile("" ::: "memory");
        const float tot = sq[ct * 16 + fr] + sq[64 + ct * 16 + fr];
        const float rstd = __builtin_amdgcn_rsqf(tot * (1.0f / 128.0f) + EPS);
#pragma unroll
        for (int i4 = 0; i4 < 4; ++i4) { const u32x2 z = zz[i4]; const f32x4 g = gv[i4];
            u32x2 w; w.x = pk2(o[i4][0] * rstd * g[0] * siluf_(bflo(z.x)), o[i4][1] * rstd * g[1] * siluf_(bfhi(z.x)));
            w.y = pk2(o[i4][2] * rstd * g[2] * siluf_(bflo(z.y)), o[i4][3] * rstd * g[3] * siluf_(bfhi(z.y)));
            *(u32x2*)(odst + zoff + 16 * i4) = w; }
        asm volatile("" ::: "memory");
    }
#undef GO_ISSUE
    asm volatile("s_waitcnt vmcnt(0)" ::: "memory");
    __builtin_amdgcn_s_barrier();
}

typedef float f32x16 __attribute__((ext_vector_type(16)));
__device__ __forceinline__ f32x16 mfma32(bf16x8 a, bf16x8 b, f32x16 c) { return __builtin_amdgcn_mfma_f32_32x32x16_bf16(a, b, c, 0, 0, 0); }
__device__ __forceinline__ int perm16(int k) { const int k16 = k & 15; return (k & ~15) + 8 * ((k16 >> 2) & 1) + 4 * (k16 >> 3) + (k16 & 3); }
__device__ __forceinline__ bf16x8 pack8(const f32x16& p, int base) {
    u32x4 w; w.x = cvt_pk_bf16(p[base + 0], p[base + 1]); w.y = cvt_pk_bf16(p[base + 2], p[base + 3]); w.z = cvt_pk_bf16(p[base + 4], p[base + 5]); w.w = cvt_pk_bf16(p[base + 6], p[base + 7]);
    return __builtin_bit_cast(bf16x8, w); }

constexpr int SW_VT = 36864, SW_BT = 70656;
__device__ __forceinline__ void swa_unit(int unit, const Args& a, LAS unsigned char* lds, bf16_t* acat, bf16_t* odst, const bf16_t* kva, int tid, int lane, int wave) {
    const int kvh = unit & 3, nb = (unit >> 2) & 63, b = unit >> 8, hq = kvh * 8 + wave;
    const long tok0 = (long)b * SEQ + (long)nb * 128, tokw = tok0 - 128;
#pragma unroll
    for (int i = 0; i < 4; ++i) { const int idx = tid + 512 * i, row = idx >> 3, ch = idx & 7; u32x4 v = (u32x4){0u, 0u, 0u, 0u};
        if (nb > 0 || row >= 128) v = *(const u32x4*)(kva + (size_t)(tokw + row) * 512 + kvh * 64 + ch * 8);
        *(LAS u32x4*)(lds + row * 144 + ch * 16) = v; }
#pragma unroll
    for (int i = 0; i < 4; ++i) { const int idx = tid + 512 * i, key = idx & 255, ch = idx >> 8; u32x4 v = (u32x4){0u, 0u, 0u, 0u};
        if (nb > 0 || key >= 128) v = *(const u32x4*)(kva + (size_t)(tokw + key) * 512 + 256 + kvh * 64 + ch * 8);
        const int pos = perm16(key);
#pragma unroll
        for (int e = 0; e < 4; ++e) { *(LAS unsigned short*)(lds + SW_VT + (8 * ch + 2 * e) * 528 + pos * 2) = (unsigned short)(v[e] & 0xffffu);
            *(LAS unsigned short*)(lds + SW_VT + (8 * ch + 2 * e + 1) * 528 + pos * 2) = (unsigned short)(v[e] >> 16); } }
    LAS float* BT = (LAS float*)(lds + SW_BT) + wave * 128;
    BT[lane] = a.rel_bias[t5_bucket_dev(lane) * A_HEADS + hq]; BT[lane + 64] = a.rel_bias[t5_bucket_dev(lane + 64) * A_HEADS + hq];
    __syncthreads();
    const int r = lane & 31, hh = lane >> 5;
    const float sink = a.sinks[hq];
#pragma unroll 1
    for (int i = 0; i < 4; ++i) {
        bf16_t* qrow = acat + tiled_off((int)tok0 + 32 * i + r, hq * 64, KCAT / 64);
        bf16x8 qf[4];
#pragma unroll
        for (int s = 0; s < 4; ++s) qf[s] = *(const bf16x8*)(qrow + 16 * s + 8 * hh);
        f32x16 sc[5];
#pragma unroll
        for (int d = 0; d < 5; ++d) { f32x16 acc;
#pragma unroll
            for (int e = 0; e < 16; ++e) acc[e] = 0.f;
#pragma unroll
            for (int s = 0; s < 4; ++s) acc = mfma32(*(const LAS bf16x8*)(lds + (32 * (i + d) + r) * 144 + (16 * s + 8 * hh) * 2), qf[s], acc);
            sc[d] = acc;  asm volatile("" ::: "memory"); }
        float mx = sink;
#pragma unroll
        for (int d = 0; d < 5; ++d) { const bool tile_ok = (nb > 0) || (i + d >= 4);
#pragma unroll
            for (int e = 0; e < 16; ++e) { const int krow = (e & 3) + 8 * (e >> 2) + 4 * hh, dist = 128 - 32 * d + r - krow;
                const bool valid = tile_ok && (d == 0 ? (krow > r) : (d == 4 ? (krow <= r) : true));
                const float v = valid ? sc[d][e] * 0.125f + BT[dist & 127] : -1e30f;
                sc[d][e] = v; mx = fmaxf(mx, v); }  asm volatile("" ::: "memory"); }
        mx = fmaxf(mx, __shfl_xor(mx, 32));
        float ls = 0.f;
#pragma unroll
        for (int d = 0; d < 5; ++d)
#pragma unroll
            for (int e = 0; e < 16; ++e) { const float p = __expf(sc[d][e] - mx); sc[d][e] = p; ls += p; }
        ls += __shfl_xor(ls, 32); ls += __expf(sink - mx);
        f32x16 o[2];
#pragma unroll
        for (int dt = 0; dt < 2; ++dt)
#pragma unroll
            for (int e = 0; e < 16; ++e) o[dt][e] = 0.f;
#pragma unroll
        for (int d = 0; d < 5; ++d)
#pragma unroll
            for (int s2 = 0; s2 < 2; ++s2) { const bf16x8 pf = pack8(sc[d], 8 * s2);
#pragma unroll
                for (int dt = 0; dt < 2; ++dt) o[dt] = mfma32(*(const LAS bf16x8*)(lds + SW_VT + (32 * dt + r) * 528 + (32 * (i + d) + 16 * s2) * 2 + hh * 16), pf, o[dt]);
                asm volatile("" ::: "memory"); }
        const float inv = 1.0f / ls;
#pragma unroll
        for (int dt = 0; dt < 2; ++dt)
#pragma unroll
            for (int g4 = 0; g4 < 4; ++g4) { u32x2 w; w.x = cvt_pk_bf16(o[dt][4 * g4] * inv, o[dt][4 * g4 + 1] * inv); w.y = cvt_pk_bf16(o[dt][4 * g4 + 2] * inv, o[dt][4 * g4 + 3] * inv);
                *(u32x2*)(odst + (qrow - acat) + 32 * dt + 8 * g4 + 4 * hh) = w; }
    }
    __syncthreads();
}

constexpr int MA_VT = 69632;
__device__ __forceinline__ void mem_unit(int unit, LAS unsigned char* lds, bf16_t* acat, bf16_t* odst, const bf16_t* mkv, int tid, int lane, int wave) {
    const int h = unit & 3, qb = (unit >> 2) & 31, b = unit >> 7;
    const bf16_t* kbase = mkv + (size_t)b * MEMLEN * 1024 + h * 128;
#pragma unroll
    for (int i = 0; i < 8; ++i) { const int idx = tid + 512 * i, row = idx >> 4, ch = idx & 15;
        *(LAS u32x4*)(lds + row * 272 + ch * 16) = *(const u32x4*)(kbase + (size_t)row * 1024 + ch * 8); }
#pragma unroll
    for (int i = 0; i < 8; ++i) { const int idx = tid + 512 * i, key = idx & 255, ch = idx >> 8;
        const u32x4 v = *(const u32x4*)(kbase + (size_t)key * 1024 + 512 + ch * 8);
        const int pos = perm16(key);
#pragma unroll
        for (int e = 0; e < 4; ++e) { *(LAS unsigned short*)(lds + MA_VT + (8 * ch + 2 * e) * 528 + pos * 2) = (unsigned short)(v[e] & 0xffffu);
            *(LAS unsigned short*)(lds + MA_VT + (8 * ch + 2 * e + 1) * 528 + pos * 2) = (unsigned short)(v[e] >> 16); } }
    __syncthreads();
    const int r = lane & 31, hh = lane >> 5;
    bf16_t* qrow = acat + tiled_off(b * SEQ + qb * 256 + 32 * wave + r, 4096 + h * 128, KCAT / 64);
    bf16x8 qf[8];
#pragma unroll
    for (int s = 0; s < 8; ++s) qf[s] = *(const bf16x8*)(qrow + (s >> 2) * 8192 + 16 * (s & 3) + 8 * hh);
    f32x16 o[4];
#pragma unroll
    for (int dt = 0; dt < 4; ++dt)
#pragma unroll
        for (int e = 0; e < 16; ++e) o[dt][e] = 0.f;
    float mx = -1e30f, ls = 0.f;
#pragma unroll 1
    for (int grp = 0; grp < 4; ++grp) {
        f32x16 sc[2]; float gm = -1e30f;
#pragma unroll
        for (int d = 0; d < 2; ++d) { f32x16 acc;
#pragma unroll
            for (int e = 0; e < 16; ++e) acc[e] = 0.f;
#pragma unroll
            for (int s = 0; s < 8; ++s) acc = mfma32(*(const LAS bf16x8*)(lds + (32 * (2 * grp + d) + r) * 272 + (16 * s + 8 * hh) * 2), qf[s], acc);
#pragma unroll
            for (int e = 0; e < 16; ++e) { acc[e] *= 0.08838834764831845f; gm = fmaxf(gm, acc[e]); }
            sc[d] = acc; }
        gm = fmaxf(gm, __shfl_xor(gm, 32));
        const float mn = fmaxf(mx, gm), alpha = __expf(mx - mn);
        float ps = 0.f;
#pragma unroll
        for (int d = 0; d < 2; ++d)
#pragma unroll
            for (int e = 0; e < 16; ++e) { const float p = __expf(sc[d][e] - mn); sc[d][e] = p; ps += p; }
        ps += __shfl_xor(ps, 32);
        ls = ls * alpha + ps; mx = mn;
#pragma unroll
        for (int dt = 0; dt < 4; ++dt)
#pragma unroll
            for (int e = 0; e < 16; ++e) o[dt][e] *= alpha;
#pragma unroll
        for (int d = 0; d < 2; ++d)
#pragma unroll
            for (int s2 = 0; s2 < 2; ++s2) { const bf16x8 pf = pack8(sc[d], 8 * s2);
#pragma unroll
                for (int dt = 0; dt < 4; ++dt) o[dt] = mfma32(*(const LAS bf16x8*)(lds + MA_VT + (32 * dt + r) * 528 + (32 * (2 * grp + d) + 16 * s2) * 2 + hh * 16), pf, o[dt]); }
    }
    const float inv = 1.0f / ls;
#pragma unroll
    for (int dt = 0; dt < 4; ++dt)
#pragma unroll
        for (int g4 = 0; g4 < 4; ++g4) { u32x2 w; w.x = cvt_pk_bf16(o[dt][4 * g4] * inv, o[dt][4 * g4 + 1] * inv); w.y = cvt_pk_bf16(o[dt][4 * g4 + 2] * inv, o[dt][4 * g4 + 3] * inv);
            *(u32x2*)(odst + (qrow - acat) + (dt >> 1) * 8192 + 32 * (dt & 1) + 8 * g4 + 4 * hh) = w; }
    __syncthreads();
}


constexpr int BG_BRA = 128 * 32, BG_BRM = 128 * 8, BG_O = 128 * 64, BG_F1 = (2 * DFF / 32) * 64, BG_F2 = 128 * (DFF / 64);
constexpr int BG_ITEMS = 2 * BG_BRA + BG_BRM + BG_O + BG_F1 + BG_F2;
constexpr int BG_CH = 32;
constexpr int BG_E0 = (2 * BG_BRA + BG_BRM) / BG_CH, BG_E1 = BG_E0 + BG_O / BG_CH, BG_E2 = BG_E1 + BG_F1 / BG_CH, BG_E3 = BG_ITEMS / BG_CH;
static_assert(BG_ITEMS % BG_CH == 0 && (2 * BG_BRA + BG_BRM) % BG_CH == 0 && BG_O % BG_CH == 0 && BG_F1 % BG_CH == 0, "whole chunks per segment");
__device__ __forceinline__ void bg_item(int r, const Args& args, bf16_t* Wbr_t, bf16_t* Wo_t, bf16_t* Wf1_t, bf16_t* Wf2_t, LAS float* scr, int lane) {
    if (r < BG_BRA) { const int kb = r / 128, gd = r % 128; p0_transpose_item(args.w_br_a, DM, gd * 32, kb * 64, Wbr_t, (size_t)gd * 32, KCAT, 0, scr, lane); return; } r -= BG_BRA;
    if (r < BG_BRA) { const int kb = r / 128, gd = r % 128; p0_transpose_item(args.w_br_b, DM, gd * 32, kb * 64, Wbr_t, (size_t)gd * 32, KCAT, 2048, scr, lane); return; } r -= BG_BRA;
    if (r < BG_BRM) { const int kb = r / 128, gd = r % 128; p0_transpose_item(args.w_br_m, DM, gd * 32, kb * 64, Wbr_t, (size_t)gd * 32, KCAT, 4096, scr, lane); return; } r -= BG_BRM;
    if (r < BG_O) { const int kb = r / 128, gd = r % 128; p0_transpose_item(args.w_o, DM, gd * 32, kb * 64, Wo_t, (size_t)gd * 32, DM, 0, scr, lane); return; } r -= BG_O;
    if (r < BG_F1) { const int kb = r / (2 * DFF / 32), gd = r % (2 * DFF / 32), tj = gd / 8, wi = gd % 8;
        const int src = wi < 4 ? tj * 128 + wi * 32 : DFF + tj * 128 + (wi - 4) * 32;
        p0_transpose_item(args.w_ffn_in, 2 * DFF, src, kb * 64, Wf1_t, (size_t)gd * 32, DM, 0, scr, lane); return; } r -= BG_F1;
    { const int kb = r / 128, gd = r % 128; p0_transpose_item(args.w_ffn_out, DM, gd * 32, kb * 64, Wf2_t, (size_t)gd * 32, DFF, 0, scr, lane); }
}

__global__ void __launch_bounds__(512, 2) hybrid_fwd(Args args) {
    extern __shared__ __attribute__((aligned(16))) unsigned char lds_raw[];
    LAS unsigned char* lds = (LAS unsigned char*)lds_raw;
    volatile LAS unsigned* MISC = (volatile LAS unsigned*)(lds + MISC_OFF);
    const int tid = threadIdx.x, lane = tid & 63, wave = __builtin_amdgcn_readfirstlane(tid >> 6);
    const int G = gridDim.x, bx = blockIdx.x;
    const int vcu = (G % 8 == 0) ? (bx % 8) * (G / 8) + bx / 8 : bx;
    unsigned char* ws = args.ws;
    unsigned* ctl = (unsigned*)(ws + WS_CTL);
    bf16_t* Win_t = (bf16_t*)(ws + WS_WIN); bf16_t* Wkv_t = (bf16_t*)(ws + WS_WKV); bf16_t* Wbr_t = (bf16_t*)(ws + WS_WBR); bf16_t* Wo_t = (bf16_t*)(ws + WS_WO);
    bf16_t* Wf1_t = (bf16_t*)(ws + WS_WF1); bf16_t* Wf2_t = (bf16_t*)(ws + WS_WF2);
    bf16_t* HB = (bf16_t*)(ws + WS_H); bf16_t* ACAT = (bf16_t*)(ws + WS_ACAT); bf16_t* KVA = (bf16_t*)(ws + WS_KVA); bf16_t* BQKV = (bf16_t*)(ws + WS_BQKV);
    bf16_t* GATES = (bf16_t*)(ws + WS_GATES); float* BA = (float*)(ws + WS_BA); bf16_t* MEMN = (bf16_t*)(ws + WS_MEMN); bf16_t* MKV = (bf16_t*)(ws + WS_MKV);
    float* PART1 = (float*)(ws + WS_PART1); float* PART2 = (float*)(ws + WS_PART2); bf16_t* H2 = (bf16_t*)(ws + WS_H2); bf16_t* HID = (bf16_t*)(ws + WS_HID);
    bf16_t* YB = HB;
    bf16_t* X1B = (bf16_t*)(ws + WS_ACAT);
    bf16_t* GWp = (bf16_t*)(ws + WS_GW); bf16_t* GKDTp = (bf16_t*)(ws + WS_GKDT); bf16_t* GATTp = (bf16_t*)(ws + WS_GATT); float* GLp = (float*)(ws + WS_GL);
    bf16_t* GQGp = (bf16_t*)(ws + WS_GQG); bf16_t* GUTp = (bf16_t*)(ws + WS_GUT); bf16_t* GSTp = (bf16_t*)(ws + WS_GST); bf16_t* GVTp = (bf16_t*)(ws + WS_GVT);

    for (int u = tid; u < (LDS_BYTES - RS_OFF) / 4; u += 512) ((LAS unsigned*)(lds + RS_OFF))[u] = 0u;
    __syncthreads();
    XcdBarrier bar; bar.bar = ctl + CW_BAR; bar.x = 0; bar.st = nullptr;
    if (MK_ONE_LAUNCH) bar = xcd_barrier_post(ctl + CW_BAR, MISC + 8);
    const int lo = args.ph_lo, hi = args.ph_hi;
#ifndef DISABLE_MASK
#define DISABLE_MASK 0
#endif
#define IN(k) (lo <= (k) && (k) < hi && !((DISABLE_MASK >> (k)) & 1))
#ifndef REPEAT_MASK
#define REPEAT_MASK 0
#endif
#define REP(k) for (int _rep = 0; _rep < 1 + ((REPEAT_MASK >> (k)) & 1); ++_rep)
#define ODST_OF(k) ((_rep < ((REPEAT_MASK >> (k)) & 1)) ? (bf16_t*)args.out : ACAT)
#define SEAM(k) do { if (IN(k) && IN((k) + 1)) xcd_barrier(bar); } while (0)
#define AT_LD(p) __hip_atomic_load((p), __ATOMIC_RELAXED, __HIP_MEMORY_SCOPE_AGENT)
#define BG_WORK(need, steal_k) do { \
    LAS int* _qs = (LAS int*)(lds + DEC_OFF + 1024); \
    __syncthreads(); \
    if ((steal_k) >= 0 && tid == 0) (void)__hip_atomic_fetch_add(ctl + CW_DONE + 64 * ((steal_k) < 0 ? 0 : (steal_k)), 1u, __ATOMIC_RELAXED, __HIP_MEMORY_SCOPE_AGENT); \
    for (;;) { \
        if (tid == 0) { const unsigned _hd = AT_LD(ctl + CW_BGHEAD); bool _go = _hd < (unsigned)(need); \
            if (!_go && (steal_k) >= 0 && _hd < (unsigned)BG_E3) _go = AT_LD(ctl + CW_DONE + 64 * ((steal_k) < 0 ? 0 : (steal_k))) < (unsigned)G; \
            _qs[0] = _go ? (int)__hip_atomic_fetch_add(ctl + CW_BGHEAD, 1u, __ATOMIC_RELAXED, __HIP_MEMORY_SCOPE_AGENT) : -1; } \
        __syncthreads(); const int _c = _qs[0]; __syncthreads(); \
        if (_c < 0 || _c >= BG_E3) break; \
        for (int _q = 0; _q < BG_CH / 8; ++_q) bg_item(_c * BG_CH + _q * 8 + wave, args, Wbr_t, Wo_t, Wf1_t, Wf2_t, (LAS float*)(lds + wave * 16384), lane); \
    } } while (0)

    if (IN(0)) REP(0) {
        LAS float* scr = (LAS float*)(lds + wave * 16384);
        const int gw = vcu * 8 + wave, NGW = G * 8;
        constexpr int I_IN = (NP_IN / 32) * 64, I_KV = 32 * 64;
        constexpr int NITEMS = I_IN + I_KV;
        for (int it = gw; it < NITEMS; it += NGW) {
            int r = it;
            if (r < I_IN) { const int kb = r / (NP_IN / 32), gd = r % (NP_IN / 32), n0 = gd * 32;
                const int src = n0 < 10752 ? n0 : (n0 < 23552 ? n0 + 32 : (n0 < 23584 ? n0 - 23552 + 10752 : -1));
                p0_transpose_item(args.w_in, N_IN, src, kb * 64, Win_t, (size_t)n0, DM, 0, scr, lane); continue; } r -= I_IN;
            { const int kb = r / 32, gd = r % 32; p0_transpose_item(args.w_mem_kv, 1024, gd * 32, kb * 64, Wkv_t, (size_t)gd * 32, DM, 0, scr, lane); }
        }
        for (int m = gw; m < M; m += NGW) rms_row_to_bf16(args.x + (size_t)m * DM, args.g_mix, HB, m, lane);
        for (int m = gw; m < MEMROWS; m += NGW) rms_row_to_bf16(args.mem + (size_t)m * DM, args.g_mem, MEMN, m, lane);
    }
    SEAM(0);

    if (IN(1)) REP(1) {
        pg8::Gemm g{HB, Win_t, MEMN, Wkv_t, DM};
        pg8::StaticOrder S; S.init(M, NP_IN, G, bx, 8, 4);
        pg8::EpiInProj E{ACAT, KVA, BQKV, GATES, BA, MKV};
        pg8::gemm_phase<pg8::EpiInProj, pg8::StaticOrder, true, GEMM_MODE>(lds, g, S, E);
        BG_WORK(0, -1);
    }
    SEAM(1);

    if (IN(2)) REP(2) {
        const int per = GDN_UNITS / G, u0 = bx * per;
        { const int h = (u0 >> 7) & 15;
          if (tid < 384) { const int idx = tid * 4, xi = idx >> 9, j = (idx >> 7) & 3, c = idx & 127;
              *(LAS f32x4*)((LAS float*)(lds + L_CW) + idx) = *(const f32x4*)(args.conv_w + (size_t)j * 6144 + xi * 2048 + h * 128 + c); } }
        for (int i = 0; i < per; ++i) { int u = u0 + i; asm volatile("" : "+s"(u));
            gdn_local_unit(u, args, lds, BQKV, BA, GWp, GKDTp, GATTp, GLp, GQGp, GUTp, tid, wave); }
        BG_WORK(0, -1);
    }
    SEAM(2);

    if (IN(3)) REP(3) {
        bf16_t* ODST = ODST_OF(3);
        if (bx < 128) {
            const int j = bx >> 3; gdn_scan((bx & 7) * 4 + (j >> 2), j & 3, lds, GWp, GKDTp, GUTp, GLp, GSTp, GVTp, tid, lane, wave);
        }
        {   LAS int* qslot = (LAS int*)(lds + DEC_OFF + 1024);
            for (;;) {
                if (tid == 0) *qslot = (int)__hip_atomic_fetch_add(ctl + CW_QUEUE + 256 * _rep, 1u, __ATOMIC_RELAXED, __HIP_MEMORY_SCOPE_AGENT);
                __syncthreads();
                const int u = *qslot;
                __syncthreads();
                if (u >= 512) break;
                swa_unit(u, args, lds, ACAT, ODST, KVA, tid, lane, wave);
            }
            for (;;) {
                if (tid == 0) *qslot = (int)__hip_atomic_fetch_add(ctl + CW_QUEUE + 64 + 256 * _rep, 1u, __ATOMIC_RELAXED, __HIP_MEMORY_SCOPE_AGENT);
                __syncthreads();
                const int u = *qslot;
                __syncthreads();
                if (u >= 256) break;
                mem_unit(u, lds, ACAT, ODST, MKV, tid, lane, wave);
            }
        }
        BG_WORK(0, 3);
    }
    SEAM(3);

    if (IN(4)) REP(4) {
        bf16_t* ODST = ODST_OF(4);
        { const int per = GDN_UNITS / G; gdn_out_units(bx * per, per, args, lds, ACAT, ODST, GQGp, GATTp, GSTp, GVTp, tid, lane, wave); }
        BG_WORK(BG_E0, -1);
    }
    SEAM(4);

    if (IN(5)) REP(5) {
        pg8::Gemm g{ACAT, Wbr_t, ACAT, Wbr_t, KCAT};
        pg8::StaticOrder S; S.init(M, DM, G, bx);
        pg8::EpiMerge E{GATES, YB};
        pg8::gemm_phase<pg8::EpiMerge, pg8::StaticOrder, true, GEMM_MODE>(lds, g, S, E);
        BG_WORK(BG_E1, -1);
    }
    SEAM(5);

    if (IN(6)) REP(6) {
        pg8::Gemm g{YB, Wo_t, YB, Wo_t, DM};
        pg8::StaticOrder S; S.init(M, DM, G, bx);
        pg8::EpiWo E{args.x, X1B, H2, args.g_ffn, PART1};
        pg8::gemm_phase<pg8::EpiWo, pg8::StaticOrder, true, GEMM_MODE>(lds, g, S, E);
        BG_WORK(BG_E2, -1);
    }
    SEAM(6);

    if (IN(7)) REP(7) {
        pg8::Gemm g{H2, Wf1_t, H2, Wf1_t, DM};
        pg8::RsOrder S; S.init(M, 2 * DFF, G, bx); S.part = PART1; S.rs = (LAS float*)(lds + RS_OFF); S.cur_pm = -1;
        pg8::EpiFfnIn E{HID, (const LAS float*)(lds + RS_OFF)};
        pg8::gemm_phase<pg8::EpiFfnIn, pg8::RsOrder, true, GEMM_MODE>(lds, g, S, E);
        BG_WORK(BG_E3, -1);
    }
    SEAM(7);

    if (IN(8)) REP(8) {
        pg8::Gemm g{HID, Wf2_t, HID, Wf2_t, DFF};
        pg8::StaticOrder S; S.init(M, DM, G, bx);
        pg8::EpiFfnOut E{X1B, PART2};
        pg8::gemm_phase<pg8::EpiFfnOut, pg8::StaticOrder, true, GEMM_MODE>(lds, g, S, E);
    }
    SEAM(8);

    if (IN(9)) REP(9) {
        const int gw = vcu * 8 + wave, NGW = G * 8;
        for (int m = gw; m < M; m += NGW) {
            const float ss = wave_sum(PART2[(size_t)lane * M + m]);
            const float rstd = __builtin_amdgcn_rsqf(ss * (1.0f / DM) + EPS);
            const u32x4* xr = (const u32x4*)(X1B + (size_t)m * DM) + lane; f32x4* orow = (f32x4*)(args.out + (size_t)m * DM) + 2 * lane; const f32x4* gr = (const f32x4*)args.g_final + 2 * lane;
            u32x4 v[8];
#pragma unroll
            for (int j = 0; j < 8; ++j) v[j] = xr[64 * j];
#pragma unroll
            for (int j = 0; j < 8; ++j) { const f32x4 a = {bflo(v[j].x), bfhi(v[j].x), bflo(v[j].y), bfhi(v[j].y)}, b = {bflo(v[j].z), bfhi(v[j].z), bflo(v[j].w), bfhi(v[j].w)};
                orow[128 * j] = a * rstd * gr[128 * j]; orow[128 * j + 1] = b * rstd * gr[128 * j + 1]; }
        }
    }
#undef IN
#undef SEAM
}

extern "C" void kernel_launch(void* const* d_in, const int* in_sizes, int n_in, void* d_out, int out_size, void* d_ws, size_t ws_size, hipStream_t stream) {
    static int grid = 0;
    if (grid == 0) {
        if (n_in != 20 || in_sizes[0] != M * DM || out_size != M * DM || ws_size < WS_END) {
            fprintf(stderr, "kernel_launch: unexpected shapes (n_in %d, in0 %d, out %d, ws %zu < %zu): nothing launched\n", n_in, n_in > 0 ? in_sizes[0] : -1, out_size, ws_size, (size_t)WS_END); grid = -1; return; }
        if (hipFuncSetAttribute((const void*)hybrid_fwd, hipFuncAttributeMaxDynamicSharedMemorySize, LDS_BYTES) != hipSuccess) { fprintf(stderr, "kernel_launch: hipFuncSetAttribute failed\n"); grid = -1; return; }
        int per_cu = 0;
        if (hipOccupancyMaxActiveBlocksPerMultiprocessor(&per_cu, (const void*)hybrid_fwd, 512, LDS_BYTES) != hipSuccess || per_cu < 1)
            fprintf(stderr, "kernel_launch: note: occupancy query reports %d workgroups per CU\n", per_cu);
        (void)hipGetLastError();
        grid = 256;
    }
    if (grid < 0) return;
    if (hipMemsetAsync((char*)d_ws + WS_CTL, 0, CTL_ZERO_BYTES, stream) != hipSuccess) { fprintf(stderr, "kernel_launch: memset failed\n"); return; }
    Args a{};
    a.x = (const float*)d_in[0]; a.mem = (const float*)d_in[1]; a.rel_bias = (const float*)d_in[2]; a.g_mix = (const float*)d_in[3]; a.w_in = (const float*)d_in[4];
    a.conv_w = (const float*)d_in[5]; a.a_log = (const float*)d_in[6]; a.dt_bias = (const float*)d_in[7]; a.g_dn_out = (const float*)d_in[8]; a.sinks = (const float*)d_in[9];
    a.g_mem = (const float*)d_in[10]; a.w_mem_kv = (const float*)d_in[11]; a.w_br_a = (const float*)d_in[12]; a.w_br_b = (const float*)d_in[13]; a.w_br_m = (const float*)d_in[14];
    a.w_o = (const float*)d_in[15]; a.g_ffn = (const float*)d_in[16]; a.w_ffn_in = (const float*)d_in[17]; a.w_ffn_out = (const float*)d_in[18]; a.g_final = (const float*)d_in[19];
    a.out = (float*)d_out; a.ws = (unsigned char*)d_ws;
#if MK_ONE_LAUNCH
    a.ph_lo = 0; a.ph_hi = NPHASE;
    hipLaunchKernelGGL(hybrid_fwd, dim3(grid), dim3(512), LDS_BYTES, stream, a);
#else
    for (int p = 0; p < NPHASE; ++p) { a.ph_lo = p; a.ph_hi = p + 1; hipLaunchKernelGGL(hybrid_fwd, dim3(grid), dim3(512), LDS_BYTES, stream, a); }
#endif
    const hipError_t le = hipPeekAtLastError();
    if (le != hipSuccess) fprintf(stderr, "kernel_launch: launch failed: %s\n", hipGetErrorName(le));
}
```

```cpp
#include <hip/hip_runtime.h>
#include <cstdio>

#ifndef GEMM_MODE
#define GEMM_MODE 1
#endif
#ifndef MK_ONE_LAUNCH
#define MK_ONE_LAUNCH 1
#endif

#define LAS __attribute__((address_space(3)))
#define GAS __attribute__((address_space(1)))
typedef unsigned short bf16_t;
typedef short bf16x8 __attribute__((ext_vector_type(8)));
typedef float f32x4 __attribute__((ext_vector_type(4)));
typedef float f32x2 __attribute__((ext_vector_type(2)));
typedef unsigned u32x4 __attribute__((ext_vector_type(4)));
typedef unsigned u32x2 __attribute__((ext_vector_type(2)));

constexpr int DM = 4096, BATCH = 2, SEQ = 8192, M = BATCH * SEQ, MEMLEN = 256, MEMROWS = BATCH * MEMLEN;
constexpr int N_IN = 23584, NP_IN = 23808;
constexpr int DFF = 11008, KCAT = 4608;
constexpr int A_HEADS = 32, A_KVH = 4, A_HD = 64, WINDOW = 128;
constexpr int B_HEADS = 16, B_DK = 128;
constexpr int M_HEADS = 4, M_HD = 128;
constexpr float EPS = 1e-6f;

constexpr size_t MiB = 1u << 20;
constexpr size_t WS_CTL = 0, CTL_ZERO_BYTES = 1 * MiB;
constexpr size_t WS_WIN = 2 * MiB;
constexpr size_t WS_WKV = 188 * MiB;
constexpr size_t WS_WBR = 196 * MiB;
constexpr size_t WS_WO = 232 * MiB;
constexpr size_t WS_WF1 = 264 * MiB;
constexpr size_t WS_WF2 = 436 * MiB;
constexpr size_t WS_H = 522 * MiB;
constexpr size_t WS_ACAT = 650 * MiB;
constexpr size_t WS_KVA = 794 * MiB;
constexpr size_t WS_BQKV = 810 * MiB;
constexpr size_t WS_GATES = 1002 * MiB;
constexpr size_t WS_BA = 1386 * MiB;
constexpr size_t WS_MEMN = 1388 * MiB;
constexpr size_t WS_MKV = 1392 * MiB;
constexpr size_t WS_PART1 = 1393 * MiB;
constexpr size_t WS_PART2 = 1397 * MiB;
constexpr size_t WS_END = 1401 * MiB;
constexpr size_t WS_H2 = WS_BQKV;
constexpr size_t WS_HID = WS_GATES;
constexpr size_t WS_GW = WS_WIN, WS_GKDT = 66 * MiB, WS_GATT = 130 * MiB, WS_GL = 162 * MiB, WS_GQG = WS_H, WS_GUT = 586 * MiB, WS_GST = WS_BQKV, WS_GVT = 938 * MiB;
constexpr int CW_TMO = 0, CW_CODE = 1, CW_QUEUE = 64, CW_DONE = 1024, CW_BGHEAD = 2048, CW_BAR = 4096;

constexpr int RING_BYTES = 147456;
constexpr int DEC_OFF = RING_BYTES;
constexpr int RS_OFF = 159744;
constexpr int MISC_OFF = 161792;
constexpr int LDS_BYTES = 163840;

__device__ __forceinline__ unsigned f2bf(float f) { unsigned u = __builtin_bit_cast(unsigned, f); return (u + 0x7fffu + ((u >> 16) & 1u)) >> 16; }
__device__ __forceinline__ float bf2f(unsigned short b) { return __builtin_bit_cast(float, (unsigned)b << 16); }
__device__ __forceinline__ float bflo(unsigned w) { return __builtin_bit_cast(float, w << 16); }
__device__ __forceinline__ float bfhi(unsigned w) { return __builtin_bit_cast(float, w & 0xffff0000u); }
typedef __bf16 bf16x2_t __attribute__((ext_vector_type(2)));
__device__ __forceinline__ unsigned cvt_pk_bf16(float lo, float hi) { const f32x2 v = {lo, hi}; const bf16x2_t b = __builtin_convertvector(v, bf16x2_t); return __builtin_bit_cast(unsigned, b); }
__device__ __forceinline__ unsigned pk2(float lo, float hi) { return cvt_pk_bf16(lo, hi); }
__device__ __forceinline__ float sigmoidf_(float x) { return __builtin_amdgcn_rcpf(1.0f + __expf(-x)); }
__device__ __forceinline__ float siluf_(float x) { return x * __builtin_amdgcn_rcpf(1.0f + __expf(-x)); }
__host__ __device__ __forceinline__ size_t tiled_off(int row, int col, int ktiles) { return ((size_t)(row >> 7) * ktiles + (size_t)(col >> 6)) * 8192 + (size_t)((row & 127) * 64 + (col & 63)); }
__device__ __forceinline__ float wave_sum(float v) {
#pragma unroll
    for (int o = 1; o < 64; o <<= 1) v += __shfl_xor(v, o);
    return v;
}

namespace pg8 {
constexpr int BM = 256, BK = 64, HALF = 128, HTB = HALF * BK * 2, STAGE_BYTES = 8 * HTB, NXCD = 8, WGM = 8;
__host__ __device__ __forceinline__ int lds_byte(int r, int c) { const int st = (r >> 4) * 2 + (c >> 5), rr = r & 15, cc = c & 31, ob = rr * 64 + cc * 2; return st * 1024 + (ob ^ (((ob >> 9) & 1) << 5)); }
__host__ __device__ __forceinline__ void stage_rc(int b, int& R, int& C) { const int st = b / 1024, sb = b % 1024, swz = sb ^ (((sb >> 9) & 1) << 5); R = (st >> 1) * 16 + swz / 64; C = (st & 1) * 32 + (swz % 64) / 2; }
__host__ __device__ __forceinline__ int perm32(int rho) { const int n = rho >> 4, i = rho & 15; return 8 * (i >> 2) + 4 * n + (i & 3); }

struct Unit { int pm, pn, sel; };
struct Gemm { const bf16_t* A; const bf16_t* Bt; const bf16_t* A2; const bf16_t* B2; int K; };

struct StaticOrder {
    int nM, nN, nwg, G, c, nextra, exN;
    __device__ void init(int M_, int N_, int G_, int c_, int nextra_ = 0, int exN_ = 1) { nM = M_ / BM; nN = N_ / BM; nwg = nM * nN; G = G_; c = c_; nextra = nextra_; exN = exN_; }
    __device__ bool next(int i, Unit& u) const {
        const long L = (long)i * G + c; if (L >= nwg + nextra) return false;
        if (L >= nwg) { const int e = (int)(L - nwg); u.pm = e / exN; u.pn = e % exN; u.sel = 1; return true; }
        int wgid = (int)L; { const int q = nwg / NXCD, r = nwg % NXCD, xcd = wgid % NXCD, off = wgid / NXCD; wgid = (xcd < r ? xcd * (q + 1) : r * (q + 1) + (xcd - r) * q) + off; }
        const int nig = WGM * nN, gid = wgid / nig, fm = gid * WGM, gsz = (nM - fm) < WGM ? (nM - fm) : WGM;
        u.pm = fm + ((wgid % nig) % gsz); u.pn = (wgid % nig) / gsz; u.sel = 0; return true;
    }
    __device__ __forceinline__ void a_ready(const Unit&) {}
    __device__ __forceinline__ void done(const Unit&) {}
};

template <class Epi, class Sched, bool ALIGN_EPI, int SP2>
__device__ __forceinline__ void gemm_phase(LAS unsigned char* lds, const Gemm g, Sched& S, Epi& E) {
    const int tid = threadIdx.x, wid = __builtin_amdgcn_readfirstlane(tid >> 6), lane = tid & 63, wr = wid >> 2, wc = wid & 3, fr = lane & 15, fq = lane >> 4;
    const int K = g.K, nt = K / BK;
    unsigned voffA[2], voffB[2];
#pragma unroll
    for (int i = 0; i < 2; ++i) { int R, C; stage_rc(tid * 16 + i * 8192, R, C); const int Rb = Epi::PERM ? ((R & ~31) + perm32(R & 31)) : R;
        voffA[i] = (unsigned)(R * 64 + C) * 2u; voffB[i] = (unsigned)(Rb * 64 + C) * 2u; }
    const size_t kstep = (size_t)HTB;
    const size_t hstepA = (size_t)nt * HTB, hstepB = hstepA;
    const unsigned ldsw = (unsigned)wid * 1024u;
    const int aoff = lds_byte(wr * 64 + fr, fq * 8), boff = lds_byte(wc * 32 + fr, fq * 8);
#define PG8_SA(b, h) (((b) * 2 + (h)) * HTB)
#define PG8_SB(b, h) ((4 + (b) * 2 + (h)) * HTB)
#define PG8_STAGE(bufoff, gbase, voff) do { _Pragma("unroll") for (int _i = 0; _i < 2; ++_i) \
        __builtin_amdgcn_global_load_lds((const unsigned*)((const char*)(gbase) + (voff)[_i]), (LAS unsigned*)(lds + (bufoff) + ldsw + _i * 8192), 16, 0, 0); } while (0)
#define PG8_LDA(dst, b, h) do { _Pragma("unroll") for (int m = 0; m < 4; ++m) _Pragma("unroll") for (int k = 0; k < 2; ++k) dst[m][k] = *(const LAS bf16x8*)(lds + PG8_SA(b, h) + aoff + m * 2048 + k * 1024); } while (0)
#define PG8_LDB(dst, b, h) do { _Pragma("unroll") for (int n = 0; n < 2; ++n) _Pragma("unroll") for (int k = 0; k < 2; ++k) dst[n][k] = *(const LAS bf16x8*)(lds + PG8_SB(b, h) + boff + n * 2048 + k * 1024); } while (0)
#define PG8_MMA(ai, bj, At, Bt) do { __builtin_amdgcn_s_setprio(1); _Pragma("unroll") for (int m = 0; m < 4; ++m) _Pragma("unroll") for (int n = 0; n < 2; ++n) _Pragma("unroll") for (int k = 0; k < 2; ++k) \
        acc[ai][bj][m][n] = __builtin_amdgcn_mfma_f32_16x16x32_bf16(Bt[n][k], At[m][k], acc[ai][bj][m][n], 0, 0, 0); __builtin_amdgcn_s_setprio(0); } while (0)
#define PG8_WAIT_V(n) asm volatile("s_waitcnt vmcnt(" #n ")" ::: "memory")
#define PG8_WAIT_L(n) asm volatile("s_waitcnt lgkmcnt(" #n ")" ::: "memory")
#define PG8_BAR __builtin_amdgcn_s_barrier()
#define PG8_SCHED __builtin_amdgcn_sched_barrier(0)
#define PG8_ATILE(u) ((const char*)((u).sel ? g.A2 : g.A) + (size_t)(u).pm * 2 * hstepA)
#define PG8_BTILE(u) ((const char*)((u).sel ? g.B2 : g.Bt) + (size_t)(u).pn * 2 * hstepB)
    Unit cur, nxt; int ui = 0;
    if (!S.next(0, cur)) return;
    f32x4 acc[2][2][4][2];
#pragma unroll
    for (int a = 0; a < 2; ++a)
#pragma unroll
        for (int b = 0; b < 2; ++b)
#pragma unroll
            for (int m = 0; m < 4; ++m)
#pragma unroll
                for (int n = 0; n < 2; ++n) acc[a][b][m][n] = (f32x4){0.f, 0.f, 0.f, 0.f};
    bf16x8 At[4][2], B0[2][2], B1[2][2];
    const char* cA = PG8_ATILE(cur); const char* cB = PG8_BTILE(cur);
    S.a_ready(cur);
    if constexpr (SP2 != 0) {
        PG8_STAGE(PG8_SB(0, 0), cB, voffB); PG8_STAGE(PG8_SB(0, 1), cB + hstepB, voffB); PG8_STAGE(PG8_SA(0, 0), cA, voffA); PG8_STAGE(PG8_SA(0, 1), cA + hstepA, voffA);
        if (wr == 1) PG8_BAR;
        PG8_WAIT_V(2); PG8_BAR;
        PG8_STAGE(PG8_SB(1, 0), cB + kstep, voffB); PG8_STAGE(PG8_SA(1, 0), cA + kstep, voffA); PG8_STAGE(PG8_SB(1, 1), cB + hstepB + kstep, voffB);
        PG8_WAIT_V(6); PG8_BAR;
    } else {
        PG8_STAGE(PG8_SB(0, 0), cB, voffB); PG8_STAGE(PG8_SA(0, 0), cA, voffA); PG8_STAGE(PG8_SB(0, 1), cB + hstepB, voffB); PG8_STAGE(PG8_SA(0, 1), cA + hstepA, voffA);
        if (wr == 1) PG8_BAR;
        PG8_WAIT_V(4); PG8_BAR;
        PG8_STAGE(PG8_SB(1, 0), cB + kstep, voffB); PG8_STAGE(PG8_SA(1, 0), cA + kstep, voffA); PG8_STAGE(PG8_SB(1, 1), cB + hstepB + kstep, voffB);
        PG8_WAIT_V(6); PG8_BAR;
    }
    for (;;) {
        const bool has_next = S.next(ui + 1, nxt);
        const char* nA = has_next ? PG8_ATILE(nxt) : cA; const char* nB = has_next ? PG8_BTILE(nxt) : cB;
        for (int t = 0; t < nt; t += 2) {
            const bool last = (t == nt - 2);
            const char* a1 = cA + (size_t)(t + 1) * kstep;
            const char* a2 = last ? nA : cA + (size_t)(t + 2) * kstep; const char* b2 = last ? nB : cB + (size_t)(t + 2) * kstep;
            const char* a3 = a2 + kstep; const char* b3 = b2 + kstep;
            if (last && has_next) S.a_ready(nxt);
            if constexpr (Epi::HOOK) { if (t == Epi::H1 || t == Epi::H2) E.hook(acc, cur, t, wr, wc, fr, fq); }
            if constexpr (SP2 == 2) {
            PG8_LDB(B0, 0, 0); PG8_LDB(B1, 0, 1); PG8_SCHED; PG8_LDA(At, 0, 0);
            PG8_WAIT_V(6); PG8_WAIT_L(0); PG8_BAR; PG8_MMA(0, 0, At, B0); PG8_STAGE(PG8_SA(1, 1), a1 + hstepA, voffA); PG8_MMA(0, 1, At, B1); PG8_BAR; PG8_SCHED;
            PG8_LDA(At, 0, 1);
            PG8_WAIT_V(2); PG8_WAIT_L(0); PG8_BAR; PG8_MMA(1, 0, At, B0); PG8_STAGE(PG8_SB(0, 0), b2, voffB); PG8_STAGE(PG8_SB(0, 1), b2 + hstepB, voffB); PG8_STAGE(PG8_SA(0, 0), a2, voffA); PG8_MMA(1, 1, At, B1); PG8_BAR; PG8_SCHED;
            PG8_LDB(B0, 1, 0); PG8_LDB(B1, 1, 1); PG8_SCHED; PG8_LDA(At, 1, 0);
            PG8_WAIT_V(6); PG8_WAIT_L(0); PG8_BAR; PG8_MMA(0, 0, At, B0); PG8_STAGE(PG8_SA(0, 1), a2 + hstepA, voffA); PG8_MMA(0, 1, At, B1); PG8_BAR; PG8_SCHED;
            PG8_LDA(At, 1, 1);
            PG8_WAIT_V(2); PG8_WAIT_L(0); PG8_BAR; PG8_MMA(1, 0, At, B0); PG8_STAGE(PG8_SB(1, 0), b3, voffB); PG8_STAGE(PG8_SB(1, 1), b3 + hstepB, voffB); PG8_STAGE(PG8_SA(1, 0), a3, voffA); PG8_MMA(1, 1, At, B1); PG8_BAR; PG8_SCHED;
            } else if constexpr (SP2 == 1) {
            PG8_LDB(B0, 0, 0); PG8_LDB(B1, 0, 1); PG8_SCHED; PG8_LDA(At, 0, 0); PG8_STAGE(PG8_SA(1, 1), a1 + hstepA, voffA);
            PG8_WAIT_V(8); PG8_WAIT_L(0); PG8_BAR; PG8_MMA(0, 0, At, B0); PG8_MMA(0, 1, At, B1); PG8_BAR; PG8_SCHED;
            PG8_LDA(At, 0, 1); PG8_STAGE(PG8_SB(0, 0), b2, voffB); PG8_STAGE(PG8_SB(0, 1), b2 + hstepB, voffB); PG8_STAGE(PG8_SA(0, 0), a2, voffA);
            PG8_WAIT_V(8); PG8_WAIT_L(0); PG8_BAR; PG8_MMA(1, 0, At, B0); PG8_MMA(1, 1, At, B1); PG8_BAR; PG8_SCHED;
            PG8_LDB(B0, 1, 0); PG8_LDB(B1, 1, 1); PG8_SCHED; PG8_LDA(At, 1, 0); PG8_STAGE(PG8_SA(0, 1), a2 + hstepA, voffA);
            PG8_WAIT_V(8); PG8_WAIT_L(0); PG8_BAR; PG8_MMA(0, 0, At, B0); PG8_MMA(0, 1, At, B1); PG8_BAR; PG8_SCHED;
            PG8_LDA(At, 1, 1); PG8_STAGE(PG8_SB(1, 0), b3, voffB); PG8_STAGE(PG8_SB(1, 1), b3 + hstepB, voffB); PG8_STAGE(PG8_SA(1, 0), a3, voffA);
            PG8_WAIT_V(8); PG8_WAIT_L(0); PG8_BAR; PG8_MMA(1, 0, At, B0); PG8_MMA(1, 1, At, B1); PG8_BAR; PG8_SCHED;
            } else {
            PG8_LDB(B0, 0, 0); PG8_SCHED; PG8_LDA(At, 0, 0); PG8_STAGE(PG8_SA(1, 1), a1 + hstepA, voffA);
            PG8_WAIT_L(8); PG8_BAR; PG8_WAIT_L(0); PG8_MMA(0, 0, At, B0); PG8_BAR; PG8_SCHED;
            PG8_LDB(B1, 0, 1); PG8_STAGE(PG8_SB(0, 0), b2, voffB);
            PG8_BAR; PG8_WAIT_L(0); PG8_MMA(0, 1, At, B1); PG8_BAR;
            PG8_LDA(At, 0, 1); PG8_STAGE(PG8_SA(0, 0), a2, voffA);
            PG8_BAR; PG8_WAIT_L(0); PG8_MMA(1, 0, At, B0); PG8_BAR; PG8_SCHED;
            PG8_STAGE(PG8_SB(0, 1), b2 + hstepB, voffB);
            PG8_WAIT_V(6); PG8_BAR; PG8_MMA(1, 1, At, B1); PG8_BAR;
            PG8_LDB(B0, 1, 0); PG8_SCHED; PG8_LDA(At, 1, 0); PG8_STAGE(PG8_SA(0, 1), a2 + hstepA, voffA);
            PG8_WAIT_L(8); PG8_BAR; PG8_WAIT_L(0); PG8_MMA(0, 0, At, B0); PG8_BAR; PG8_SCHED;
            PG8_LDB(B1, 1, 1); PG8_STAGE(PG8_SB(1, 0), b3, voffB);
            PG8_BAR; PG8_WAIT_L(0); PG8_MMA(0, 1, At, B1); PG8_BAR;
            PG8_LDA(At, 1, 1); PG8_STAGE(PG8_SA(1, 0), a3, voffA);
            PG8_BAR; PG8_WAIT_L(0); PG8_MMA(1, 0, At, B0); PG8_BAR; PG8_SCHED;
            PG8_STAGE(PG8_SB(1, 1), b3 + hstepB, voffB);
            PG8_WAIT_V(6); PG8_BAR; PG8_MMA(1, 1, At, B1); PG8_BAR;
            }
        }
        if constexpr (ALIGN_EPI) { if (wr == 0) PG8_BAR; }
        E(acc, cur, wr, wc, fr, fq); S.done(cur);
        if (!has_next) break;
#pragma unroll
        for (int a = 0; a < 2; ++a)
#pragma unroll
            for (int b = 0; b < 2; ++b)
#pragma unroll
                for (int m = 0; m < 4; ++m)
#pragma unroll
                    for (int n = 0; n < 2; ++n) acc[a][b][m][n] = (f32x4){0.f, 0.f, 0.f, 0.f};
        cur = nxt; cA = nA; cB = nB; ++ui;
        if constexpr (ALIGN_EPI) { if (wr == 1) PG8_BAR; }
    }
    PG8_WAIT_V(0);
    if constexpr (!ALIGN_EPI) { if (wr == 0) PG8_BAR; }
    PG8_BAR;
#undef PG8_SA
#undef PG8_SB
#undef PG8_STAGE
#undef PG8_LDA
#undef PG8_LDB
#undef PG8_MMA
#undef PG8_WAIT_V
#undef PG8_WAIT_L
#undef PG8_BAR
#undef PG8_SCHED
#undef PG8_ATILE
#undef PG8_BTILE
}

__device__ __forceinline__ size_t gate_frag_off(int g, int pm, int pn, int s, int tid) { return ((((size_t)(g * 64 + pm) * 16 + pn) * 16 + s) * 512 + tid) * 8; }
__device__ __forceinline__ unsigned gate_q4(const f32x4 v) {
    unsigned r = 0;
#pragma unroll
    for (int j = 0; j < 4; ++j) { const float s = __builtin_amdgcn_rcpf(1.0f + __expf(-v[j])); const float q = fminf(fmaxf(s * 255.0f + 0.5f, 1.0f), 255.0f); r |= (unsigned)q << (8 * j); }
    return r;
}
__device__ __forceinline__ float gate_b(unsigned w, int k) { return (float)((w >> (8 * k)) & 0xffu); }
struct EpiInProj {
    static constexpr bool PERM = true, HOOK = false; static constexpr int H1 = -1, H2 = -1;
    bf16_t* acat; bf16_t* kva; bf16_t* bqkv; bf16_t* gates; float* ba; bf16_t* mkv;
    __device__ __forceinline__ void hook(f32x4 (&)[2][2][4][2], const Unit&, int, int, int, int, int) {}
    __device__ __forceinline__ void operator()(const f32x4 (&acc)[2][2][4][2], const Unit& u, int wr, int wc, int fr, int fq) const {
        const int row0 = u.pm * BM + wr * 64 + fr;
        bf16_t* base; int ldc, colt; const int pn = u.pn;
        if (u.sel) { base = mkv; ldc = 1024; colt = pn * 256; }
        else if (pn < 8) { base = acat; ldc = KCAT; colt = pn * 256; }
        else if (pn < 10) { base = kva; ldc = 512; colt = (pn - 8) * 256; }
        else if (pn < 34) { base = bqkv; ldc = 6144; colt = (pn - 10) * 256; }
        else if (pn < 42) { base = acat; ldc = KCAT; colt = 2048 + (pn - 34) * 256; }
        else if (pn < 44) { base = acat; ldc = KCAT; colt = 4096 + (pn - 42) * 256; }
        else if (pn < 92) { base = gates; ldc = 12288; colt = (pn - 44) * 256; }
        else {
            if (wc == 0) {
#pragma unroll
                for (int ai = 0; ai < 2; ++ai)
#pragma unroll
                    for (int m = 0; m < 4; ++m) { float* rowp = ba + (size_t)(row0 + ai * HALF + m * 16) * 32 + 8 * fq;
                        *(f32x4*)(rowp) = acc[ai][0][m][0]; *(f32x4*)(rowp + 4) = acc[ai][0][m][1]; }
            }
            return;
        }
        const int col0 = colt + wc * 32 + 8 * fq; const bool tiled = (base == acat), isgate = (base == gates);
#pragma unroll
        for (int ai = 0; ai < 2; ++ai)
#pragma unroll
            for (int m = 0; m < 4; ++m) { const int r = row0 + ai * HALF + m * 16;
#pragma unroll
                for (int bj = 0; bj < 2; ++bj) { f32x4 v0 = acc[ai][bj][m][0], v1 = acc[ai][bj][m][1];
                    if (isgate) {
                        u32x2 wq; wq.x = gate_q4(v0); wq.y = gate_q4(v1);
                        *(u32x2*)((unsigned char*)base + gate_frag_off((pn - 44) >> 4, u.pm, (pn - 44) & 15, (ai * 4 + m) * 2 + bj, (wr * 4 + wc) * 64 + fq * 16 + fr)) = wq;
                        continue; }
                    u32x4 w; w.x = cvt_pk_bf16(v0[0], v0[1]); w.y = cvt_pk_bf16(v0[2], v0[3]); w.z = cvt_pk_bf16(v1[0], v1[1]); w.w = cvt_pk_bf16(v1[2], v1[3]);
                    bf16_t* p = tiled ? base + tiled_off(r, col0 + bj * HALF, KCAT / 64) : base + (size_t)r * ldc + col0 + bj * HALF;
                    *(u32x4*)p = w; } }
    }
};

struct EpiMerge {
    static constexpr bool PERM = true, HOOK = true; static constexpr int H1 = 32, H2 = 64;
    const bf16_t* gates; bf16_t* y;
    __device__ __forceinline__ void hook(f32x4 (&acc)[2][2][4][2], const Unit& u, int t, int wr, int wc, int fr, int fq) const {
        const int gsel = (t == H1) ? 0 : 1; const int tid_ = (wr * 4 + wc) * 64 + fq * 16 + fr;
        const unsigned char* gpb = (const unsigned char*)gates + gate_frag_off(gsel, u.pm, u.pn, 0, tid_); const unsigned char* gnb = (const unsigned char*)gates + gate_frag_off(gsel + 1, u.pm, u.pn, 0, tid_);
        u32x2 gp[16], gn[16];
#pragma unroll
        for (int sl = 0; sl < 16; ++sl) { gp[sl] = *(const u32x2*)(gpb + (size_t)sl * 4096); gn[sl] = *(const u32x2*)(gnb + (size_t)sl * 4096); }
        asm volatile("" ::: "memory");
#pragma unroll
        for (int sl = 0; sl < 16; ++sl) { const int ai = sl >> 3, m = (sl >> 1) & 3, bj = sl & 1;
#pragma unroll
            for (int n = 0; n < 2; ++n) { const unsigned wp = n ? gp[sl].y : gp[sl].x, wn = n ? gn[sl].y : gn[sl].x;
#pragma unroll
                for (int k = 0; k < 4; ++k) acc[ai][bj][m][n][k] *= gate_b(wp, k) * __builtin_amdgcn_rcpf(gate_b(wn, k)); } }
        asm volatile("" ::: "memory");
    }
    __device__ __forceinline__ void operator()(const f32x4 (&acc)[2][2][4][2], const Unit& u, int wr, int wc, int fr, int fq) const {
        const int row0 = u.pm * BM + wr * 64 + fr, col0 = u.pn * BM + wc * 32 + 8 * fq;
        const unsigned char* gmb = (const unsigned char*)gates + gate_frag_off(2, u.pm, u.pn, 0, (wr * 4 + wc) * 64 + fq * 16 + fr);
        u32x2 gm[16];
#pragma unroll
        for (int sl = 0; sl < 16; ++sl) gm[sl] = *(const u32x2*)(gmb + (size_t)sl * 4096);
        asm volatile("" ::: "memory");
#pragma unroll
        for (int sl = 0; sl < 16; ++sl) { const int ai = sl >> 3, m = (sl >> 1) & 3, bj = sl & 1; const size_t r = (size_t)(row0 + ai * HALF + m * 16); float o[8];
#pragma unroll
            for (int k = 0; k < 4; ++k) { o[k] = acc[ai][bj][m][0][k] * (gate_b(gm[sl].x, k) * (1.0f / 255.0f)); o[4 + k] = acc[ai][bj][m][1][k] * (gate_b(gm[sl].y, k) * (1.0f / 255.0f)); }
            u32x4 w; w.x = cvt_pk_bf16(o[0], o[1]); w.y = cvt_pk_bf16(o[2], o[3]); w.z = cvt_pk_bf16(o[4], o[5]); w.w = cvt_pk_bf16(o[6], o[7]);
            *(u32x4*)(y + tiled_off((int)r, col0 + bj * HALF, DM / 64)) = w; }
    }
};

struct EpiWo {
    static constexpr bool PERM = true, HOOK = false; static constexpr int H1 = -1, H2 = -1;
    const float* xin; bf16_t* x1b; float* part;
    __device__ __forceinline__ void hook(f32x4 (&)[2][2][4][2], const Unit&, int, int, int, int, int) {}
    __device__ __forceinline__ void operator()(const f32x4 (&acc)[2][2][4][2], const Unit& u, int wr, int wc, int fr, int fq) const {
        const int row0 = u.pm * BM + wr * 64 + fr, col0 = u.pn * BM + wc * 32 + 8 * fq;
#pragma unroll
        for (int ai = 0; ai < 2; ++ai) {
#pragma unroll
            for (int mp = 0; mp < 2; ++mp) {
            f32x4 xv[2][2][2];
#pragma unroll
            for (int m2 = 0; m2 < 2; ++m2)
#pragma unroll
                for (int bj = 0; bj < 2; ++bj)
#pragma unroll
                    for (int n = 0; n < 2; ++n) xv[m2][bj][n] = *(const f32x4*)(xin + (size_t)(row0 + ai * HALF + (2 * mp + m2) * 16) * DM + col0 + bj * HALF + n * 4);
            asm volatile("" ::: "memory");
#pragma unroll
            for (int m2 = 0; m2 < 2; ++m2) { const int m = 2 * mp + m2; const int r = row0 + ai * HALF + m * 16; float s = 0.f;
#pragma unroll
                for (int bj = 0; bj < 2; ++bj) { u32x4 wx;
#pragma unroll
                    for (int n = 0; n < 2; ++n) { const f32x4 x1 = xv[m2][bj][n] + acc[ai][bj][m][n];
                        s += (x1[0] * x1[0] + x1[1] * x1[1]) + (x1[2] * x1[2] + x1[3] * x1[3]);
                        wx[2 * n] = cvt_pk_bf16(x1[0], x1[1]); wx[2 * n + 1] = cvt_pk_bf16(x1[2], x1[3]); }
                    *(u32x4*)(x1b + tiled_off(r, col0 + bj * HALF, DM / 64)) = wx; }
                s += __shfl_xor(s, 16); s += __shfl_xor(s, 32);
                if (fq == 0) part[(size_t)(u.pn * 4 + wc) * M + r] = s; }
            asm volatile("" ::: "memory");
            }
        }
    }
};

struct EpiFfnIn {
    static constexpr bool PERM = true, HOOK = false; static constexpr int H1 = -1, H2 = -1;
    bf16_t* hid; const LAS float* rs;
    __device__ __forceinline__ void hook(f32x4 (&)[2][2][4][2], const Unit&, int, int, int, int, int) {}
    __device__ __forceinline__ void operator()(const f32x4 (&acc)[2][2][4][2], const Unit& u, int wr, int wc, int fr, int fq) const {
        const int rl0 = wr * 64 + fr, col0 = u.pn * HALF + wc * 32 + 8 * fq;
#pragma unroll
        for (int ai = 0; ai < 2; ++ai)
#pragma unroll
            for (int m = 0; m < 4; ++m) { const int rl = rl0 + ai * HALF + m * 16; const float sc = rs[rl]; float o[8];
#pragma unroll
                for (int n = 0; n < 2; ++n)
#pragma unroll
                    for (int j = 0; j < 4; ++j) { const float gt = acc[ai][0][m][n][j] * sc, up = acc[ai][1][m][n][j] * sc; o[4 * n + j] = siluf_(gt) * up; }
                u32x4 w; w.x = cvt_pk_bf16(o[0], o[1]); w.y = cvt_pk_bf16(o[2], o[3]); w.z = cvt_pk_bf16(o[4], o[5]); w.w = cvt_pk_bf16(o[6], o[7]);
                *(u32x4*)(hid + tiled_off(u.pm * BM + rl, col0, DFF / 64)) = w;
                asm volatile("" ::: "memory"); }
    }
};
struct RsOrder : StaticOrder {
    const float* part; LAS float* rs; int cur_pm;
    __device__ __forceinline__ void a_ready(const Unit& u) {
        if (u.pm == cur_pm) return;
        cur_pm = u.pm;
        const int tid = threadIdx.x, row = tid >> 1, hf = tid & 1; float s = 0.f;
        const float* p = part + (size_t)(hf * 32) * M + (size_t)u.pm * BM + row;
#pragma unroll 8
        for (int j = 0; j < 32; ++j) s += p[(size_t)j * M];
        s += __shfl_xor(s, 1);
        if (hf == 0) rs[row] = 1.0f / sqrtf(s * (1.0f / DM) + EPS);
        asm volatile("s_waitcnt lgkmcnt(0)" ::: "memory");
    }
};

struct EpiFfnOut {
    static constexpr bool PERM = true, HOOK = false; static constexpr int H1 = -1, H2 = -1;
    bf16_t* x1b; float* part;
    __device__ __forceinline__ void hook(f32x4 (&)[2][2][4][2], const Unit&, int, int, int, int, int) {}
    __device__ __forceinline__ void operator()(const f32x4 (&acc)[2][2][4][2], const Unit& u, int wr, int wc, int fr, int fq) const {
        const int row0 = u.pm * BM + wr * 64 + fr, col0 = u.pn * BM + wc * 32 + 8 * fq;
#pragma unroll
        for (int ai = 0; ai < 2; ++ai) {
            u32x4 xv[4][2];
#pragma unroll
            for (int m = 0; m < 4; ++m)
#pragma unroll
                for (int bj = 0; bj < 2; ++bj) xv[m][bj] = *(const u32x4*)(x1b + tiled_off(row0 + ai * HALF + m * 16, col0 + bj * HALF, DM / 64));
            asm volatile("" ::: "memory");
#pragma unroll
            for (int m = 0; m < 4; ++m) { const int r = row0 + ai * HALF + m * 16; float s = 0.f;
#pragma unroll
                for (int bj = 0; bj < 2; ++bj) { u32x4 wx;
#pragma unroll
                    for (int n = 0; n < 2; ++n) { const unsigned w0 = xv[m][bj][2 * n], w1 = xv[m][bj][2 * n + 1];
                        const f32x4 x1 = {bflo(w0), bfhi(w0), bflo(w1), bfhi(w1)}; const f32x4 x2 = x1 + acc[ai][bj][m][n];
                        s += (x2[0] * x2[0] + x2[1] * x2[1]) + (x2[2] * x2[2] + x2[3] * x2[3]);
                        wx[2 * n] = cvt_pk_bf16(x2[0], x2[1]); wx[2 * n + 1] = cvt_pk_bf16(x2[2], x2[3]); }
                    *(u32x4*)(x1b + tiled_off(r, col0 + bj * HALF, DM / 64)) = wx; }
                s += __shfl_xor(s, 16); s += __shfl_xor(s, 32);
                if (fq == 0) part[(size_t)(u.pn * 4 + wc) * M + r] = s; }
            asm volatile("" ::: "memory");
        }
    }
};
}

#define XB_TMO      128
#define XB_XCNT(j)  (256  + 64 * (j))
#define XB_XSUB(j)  (1280 + 64 * (j))
#define XB_XGEN(j)  (2304 + 64 * (j))
#define XB_TOP      3328
#define XB_TOPGEN   3392
#define XCD_BAR_WORDS 3456
#define XB_SPIN_CAP (1u << 18)
__device__ __forceinline__ unsigned xb_ld(unsigned* p)              { return __hip_atomic_load(p, __ATOMIC_RELAXED, __HIP_MEMORY_SCOPE_AGENT); }
__device__ __forceinline__ unsigned xb_add(unsigned* p, unsigned v) { return __hip_atomic_fetch_add(p, v, __ATOMIC_RELAXED, __HIP_MEMORY_SCOPE_AGENT); }
__device__ __forceinline__ unsigned xb_xcc_id() { return (unsigned)__builtin_amdgcn_s_getreg((3 << 11) | 20) & 0xFu; }
#define XB_SPIN(cond, bar) do { unsigned _sp = 0; while (cond) { __builtin_amdgcn_s_sleep(1); \
    if ((++_sp & 255u) == 0u) { if (xb_ld(&(bar)[XB_TMO])) break; if (_sp > XB_SPIN_CAP) { atomicAdd(&(bar)[XB_TMO], 1u); break; } } } } while (0)
struct XcdBarrier { unsigned* bar; unsigned x; volatile LAS unsigned* st; };
__device__ __forceinline__ XcdBarrier xcd_barrier_post(unsigned* bar, volatile LAS unsigned* st) {
    XcdBarrier b; b.bar = bar; b.x = xb_xcc_id(); b.st = st;
    if (threadIdx.x == 0) (void)xb_add(&bar[XB_XCNT(b.x)], 1u);
    return b;
}
__device__ __forceinline__ void xcd_barrier_complete(unsigned* bar, unsigned x, unsigned& nloc, unsigned& nx) {
    const unsigned G = gridDim.x * gridDim.y * gridDim.z;
    unsigned sum, cnt, mine, sp = 0u;
    for (;;) {
        sum = 0u; cnt = 0u; mine = 0u;
#pragma unroll
        for (unsigned j = 0; j < 16; ++j) { const unsigned c = xb_ld(&bar[XB_XCNT(j)]); sum += c; cnt += (c > 0u) ? 1u : 0u; mine = (j == x) ? c : mine; }
        if (sum == G) break;
        __builtin_amdgcn_s_sleep(1);
        if ((++sp & 255u) == 0u) { if (xb_ld(&bar[XB_TMO])) break; if (sp > XB_SPIN_CAP) { atomicAdd(&bar[XB_TMO], 1u); break; } }
    }
    nloc = mine > 0u ? mine : 1u; nx = cnt > 0u ? cnt : 1u;
}
__device__ __forceinline__ void xcd_barrier(const XcdBarrier& b) {
    asm volatile("s_waitcnt vmcnt(0)" ::: "memory");
    __syncthreads();
    if (threadIdx.x == 0) {
        unsigned* bar = b.bar;
        __builtin_amdgcn_s_waitcnt(0);
        unsigned nloc = b.st[0], nx = b.st[1];
        if (nloc == 0u) { xcd_barrier_complete(bar, b.x, nloc, nx); b.st[0] = nloc; b.st[1] = nx; }
        const unsigned old = xb_add(&bar[XB_XSUB(b.x)], 1u);
        const unsigned gen = old / nloc;
        if (old + 1u == (gen + 1u) * nloc) {
            __builtin_amdgcn_fence(__ATOMIC_RELEASE, "agent");
            asm volatile("s_waitcnt vmcnt(0)" ::: "memory");
            const unsigned og = xb_add(&bar[XB_TOP], 1u);
            const unsigned tg = og / nx;
            if (og + 1u == (tg + 1u) * nx) xb_add(&bar[XB_TOPGEN], 1u);
            else XB_SPIN(xb_ld(&bar[XB_TOPGEN]) == tg, bar);
            __builtin_amdgcn_fence(__ATOMIC_ACQUIRE, "agent");
            xb_add(&bar[XB_XGEN(b.x)], 1u);
            asm volatile("s_waitcnt vmcnt(0)" ::: "memory");
        } else {
            XB_SPIN(xb_ld(&bar[XB_XGEN(b.x)]) == gen, bar);
            __builtin_amdgcn_fence(__ATOMIC_ACQUIRE, "agent");
            asm volatile("s_waitcnt vmcnt(0)" ::: "memory");
        }
    }
    __syncthreads();
}

struct Args {
    const float *x, *mem, *rel_bias, *g_mix, *w_in, *conv_w, *a_log, *dt_bias, *g_dn_out, *sinks, *g_mem, *w_mem_kv, *w_br_a, *w_br_b, *w_br_m, *w_o, *g_ffn, *w_ffn_in, *w_ffn_out, *g_final;
    float* out; unsigned char* ws; int ph_lo, ph_hi;
};
constexpr int NPHASE = 10;

__device__ __forceinline__ void p0_transpose_item(const float* W, int ldw, int src_col0, int k0, bf16_t* WT, size_t dst_row0, int ldt  , int dst_k0, LAS float* scr, int lane, const float* rowgain = nullptr) {
    if (src_col0 >= 0 && rowgain != nullptr) {
#pragma unroll 8
        for (int i = 0; i < 32; ++i) { const int kk = 2 * i + (lane >> 5); scr[kk * 33 + (lane & 31)] = W[(size_t)(k0 + kk) * ldw + src_col0 + (lane & 31)] * rowgain[k0 + kk]; }
    } else if (src_col0 >= 0) {
#pragma unroll 8
        for (int i = 0; i < 32; ++i) { const int kk = 2 * i + (lane >> 5); scr[kk * 33 + (lane & 31)] = W[(size_t)(k0 + kk) * ldw + src_col0 + (lane & 31)]; }
    } else {
#pragma unroll 8
        for (int i = 0; i < 32; ++i) { const int kk = 2 * i + (lane >> 5); scr[kk * 33 + (lane & 31)] = 0.f; }
    }
    asm volatile("s_waitcnt lgkmcnt(0)" ::: "memory");
    const int c = lane & 7;
#pragma unroll
    for (int j = 0; j < 4; ++j) { const int n = (lane >> 3) + 8 * j; const LAS float* s = scr + (8 * c) * 33 + n;
        u32x4 o; o.x = pk2(s[0 * 33], s[1 * 33]); o.y = pk2(s[2 * 33], s[3 * 33]); o.z = pk2(s[4 * 33], s[5 * 33]); o.w = pk2(s[6 * 33], s[7 * 33]);
        *(u32x4*)(WT + tiled_off((int)dst_row0 + n, dst_k0 + k0 + 8 * c, ldt / 64)) = o; }
    asm volatile("s_waitcnt lgkmcnt(0)" ::: "memory");
}
__device__ __forceinline__ void rms_row_to_bf16(const float* xrow, const float* gain, bf16_t* obase, int row, int lane) {
    const f32x4* xr = (const f32x4*)xrow + lane; const f32x4* gr = (const f32x4*)gain + lane;
    f32x4 v[16]; float s = 0.f;
#pragma unroll
    for (int j = 0; j < 16; ++j) { v[j] = xr[64 * j]; s += (v[j][0] * v[j][0] + v[j][1] * v[j][1]) + (v[j][2] * v[j][2] + v[j][3] * v[j][3]); }
    const float rstd = 1.0f / sqrtf(wave_sum(s) * (1.0f / DM) + EPS);
#pragma unroll
    for (int j = 0; j < 16; ++j) { const f32x4 gv = gr[64 * j]; u32x2 w; w.x = pk2(v[j][0] * rstd * gv[0], v[j][1] * rstd * gv[1]); w.y = pk2(v[j][2] * rstd * gv[2], v[j][3] * rstd * gv[3]);
        *(u32x2*)(obase + tiled_off(row, 4 * lane + 256 * j, DM / 64)) = w; }
}

__device__ __forceinline__ int t5_bucket_dev(int n) {
    if (n < 16) return n;
    const float nf = (float)n;
    int large = 16 + (int)(logf(nf / 16.0f) / 2.0794415416798357f * 16.0f);
    return large < 31 ? large : 31;
}
constexpr int GDN_UNITS = BATCH * B_HEADS * (SEQ / 64);
constexpr int L_QS = 0, L_KS = 17408, L_RT = 34816, L_KDT = 71680, L_AM = 90112, L_TB = 107520, L_G = 116736, L_CW = 117504;
__device__ __forceinline__ f32x4 mfma16(bf16x8 a, bf16x8 b, f32x4 c) { return __builtin_amdgcn_mfma_f32_16x16x32_bf16(a, b, c, 0, 0, 0); }
__device__ __forceinline__ int perm_pos(int t) { const int t32 = t & 31; return (t & 32) + 8 * ((t32 >> 2) & 3) + 4 * (t32 >> 4) + (t32 & 3); }

constexpr int L_DINV = 123648;
struct GdnRaw { u32x4 w[3][4][2]; };
__device__ __forceinline__ void gdn_load_raw(GdnRaw& R, int unit, const bf16_t* bqkv, int tid) {
    const int bh = unit >> 7, n = unit & 127, b = bh >> 4, h = bh & 15, t = tid >> 3, c0 = (tid & 7) * 16;
    const long tok0 = (long)b * SEQ + (long)n * 64;
#pragma unroll
    for (int xi = 0; xi < 3; ++xi)
#pragma unroll
        for (int j = 0; j < 4; ++j) { const int row = t + j - 3;
            if (n * 64 + row >= 0) { const bf16_t* src = bqkv + (size_t)(tok0 + row) * 6144 + xi * 2048 + h * 128 + c0;
                R.w[xi][j][0] = *(const u32x4*)src; R.w[xi][j][1] = *(const u32x4*)(src + 8); }
            else { R.w[xi][j][0] = (u32x4){0u, 0u, 0u, 0u}; R.w[xi][j][1] = (u32x4){0u, 0u, 0u, 0u}; } }
}
__device__ __forceinline__ f32x4 mfma4f(float a, float b, f32x4 c) { return __builtin_amdgcn_mfma_f32_16x16x4f32(a, b, c, 0, 0, 0); }

__device__ __forceinline__ void gdn_local_unit(int unit, const Args& a, LAS unsigned char* lds0, const bf16_t* bqkv, const float* ba,
        bf16_t* GW, bf16_t* GKDT, bf16_t* GATT, float* GL, bf16_t* GQG, bf16_t* GUT, int tid0, int wave) {
    LAS unsigned char* lds = lds0; asm volatile("" : "+v"(lds));
    int tid = tid0; asm volatile("" : "+v"(tid));
    const int lane = tid & 63;
    const int bh = unit >> 7, n = unit & 127, b = bh >> 4, h = bh & 15, fr = lane & 15, fq = lane >> 4;
    const long tok0 = (long)b * SEQ + (long)n * 64;
    LAS float* CW = (LAS float*)(lds + L_CW);
    LAS float* Gs = (LAS float*)(lds + L_G); LAS float* GCs = Gs + 64; LAS float* BTs = Gs + 128;
    const int t = tid >> 3, cg = tid & 7, c0 = cg * 16;
#ifndef GP_A
#define GP_A 1
#define GP_B 1
#define GP_C 1
#define GP_D 1
#endif
    for (int rrA = 0; rrA < GP_A; ++rrA) {
    float beta;
    { const float bb = ba[(tok0 + t) * 32 + h], bav = ba[(tok0 + t) * 32 + 16 + h];
      beta = sigmoidf_(bb); const float z = bav + a.dt_bias[h]; const float sp = z > 20.f ? z : log1pf(__expf(z));
      const float g = -__expf(a.a_log[h]) * sp;
      if (cg == 0) { Gs[t] = g; BTs[t] = beta; } }
    __syncthreads();
    if (wave == 0) { float v = Gs[lane];
#pragma unroll
        for (int o = 1; o < 64; o <<= 1) { const float u = __shfl_up(v, o); if (lane >= o) v += u; }
        GCs[lane] = v; }
    float y[3][16];
#pragma unroll
    for (int xi = 0; xi < 3; ++xi) {
#pragma unroll
        for (int i = 0; i < 16; ++i) y[xi][i] = 0.f;
#pragma unroll
        for (int j = 0; j < 4; ++j) {
            const int row = t + j - 3;
            if (j == 2) asm volatile("" ::: "memory");
            const bool rok = (n * 64 + row >= 0);
            const bf16_t* src = bqkv + (size_t)(tok0 + (rok ? row : 0)) * 6144 + xi * 2048 + h * 128 + c0;
            u32x4 w0 = *(const u32x4*)src, w1 = *(const u32x4*)(src + 8);
            const unsigned msk = rok ? 0xffffffffu : 0u; w0 = w0 & msk; w1 = w1 & msk;
            const LAS float* cw = CW + xi * 512 + j * 128 + c0;
            const f32x4 k0 = *(const LAS f32x4*)cw, k1 = *(const LAS f32x4*)(cw + 4), k2 = *(const LAS f32x4*)(cw + 8), k3 = *(const LAS f32x4*)(cw + 12);
            y[xi][0] += k0[0] * bflo(w0[0]); y[xi][1] += k0[1] * bfhi(w0[0]); y[xi][2] += k0[2] * bflo(w0[1]); y[xi][3] += k0[3] * bfhi(w0[1]);
            y[xi][4] += k1[0] * bflo(w0[2]); y[xi][5] += k1[1] * bfhi(w0[2]); y[xi][6] += k1[2] * bflo(w0[3]); y[xi][7] += k1[3] * bfhi(w0[3]);
            y[xi][8] += k2[0] * bflo(w1[0]); y[xi][9] += k2[1] * bfhi(w1[0]); y[xi][10] += k2[2] * bflo(w1[1]); y[xi][11] += k2[3] * bfhi(w1[1]);
            y[xi][12] += k3[0] * bflo(w1[2]); y[xi][13] += k3[1] * bfhi(w1[2]); y[xi][14] += k3[2] * bflo(w1[3]); y[xi][15] += k3[3] * bfhi(w1[3]);
        }
#pragma unroll
        for (int i = 0; i < 16; ++i) y[xi][i] = siluf_(y[xi][i]);
        asm volatile("" ::: "memory");
    }
    float sq = 0.f, sk = 0.f;
#pragma unroll
    for (int i = 0; i < 16; ++i) { sq += y[0][i] * y[0][i]; sk += y[1][i] * y[1][i]; }
    sq += __shfl_xor(sq, 1); sq += __shfl_xor(sq, 2); sq += __shfl_xor(sq, 4);
    sk += __shfl_xor(sk, 1); sk += __shfl_xor(sk, 2); sk += __shfl_xor(sk, 4);
    const float rq = __builtin_amdgcn_rsqf(sq + EPS) * 0.08838834764831845f, rk = __builtin_amdgcn_rsqf(sk + EPS);
    __syncthreads();
    const float gct = GCs[t], glast = GCs[63];
    const float e1 = __expf(gct), e2 = __expf(glast - gct);
    if (tid == 0) GL[unit] = __expf(glast);
    {
        u32x4 kq[2], qq[2], qg[2];
#pragma unroll
        for (int i = 0; i < 8; ++i) { const float k0 = y[1][2 * i] * rk, k1 = y[1][2 * i + 1] * rk, q0 = y[0][2 * i] * rq, q1 = y[0][2 * i + 1] * rq;
            kq[i >> 2][i & 3] = cvt_pk_bf16(k0, k1); qq[i >> 2][i & 3] = cvt_pk_bf16(q0, q1); qg[i >> 2][i & 3] = cvt_pk_bf16(q0 * e1, q1 * e1); }
        *(LAS u32x4*)(lds + L_KS + t * 272 + c0 * 2) = kq[0]; *(LAS u32x4*)(lds + L_KS + t * 272 + c0 * 2 + 16) = kq[1];
        *(LAS u32x4*)(lds + L_QS + t * 272 + c0 * 2) = qq[0]; *(LAS u32x4*)(lds + L_QS + t * 272 + c0 * 2 + 16) = qq[1];
        bf16_t* qgp = GQG + (size_t)unit * 8192 + t * 128 + (c0 & ~31) + 4 * (cg & 1);
        *(u32x2*)(qgp) = (u32x2){qg[0].x, qg[0].y}; *(u32x2*)(qgp + 8) = (u32x2){qg[0].z, qg[0].w}; *(u32x2*)(qgp + 16) = (u32x2){qg[1].x, qg[1].y}; *(u32x2*)(qgp + 24) = (u32x2){qg[1].z, qg[1].w};
    }
    {
        const int tp = (t + 8 * cg) & 63, pt = (perm_pos(t) + 8 * cg) & 63;
#pragma unroll
        for (int i = 0; i < 16; i += 2) { const float kn0 = y[1][i] * rk, kn1 = y[1][i + 1] * rk;
            const unsigned pv = cvt_pk_bf16(beta * y[2][i], beta * y[2][i + 1]), pk = cvt_pk_bf16(beta * kn0 * e1, beta * kn1 * e1), pd = cvt_pk_bf16(kn0 * e2, kn1 * e2);
            *(LAS unsigned short*)(lds + L_RT + (c0 + i) * 144 + tp * 2) = (unsigned short)(pv & 0xffffu); *(LAS unsigned short*)(lds + L_RT + (c0 + i + 1) * 144 + tp * 2) = (unsigned short)(pv >> 16);
            *(LAS unsigned short*)(lds + L_RT + (128 + c0 + i) * 144 + tp * 2) = (unsigned short)(pk & 0xffffu); *(LAS unsigned short*)(lds + L_RT + (128 + c0 + i + 1) * 144 + tp * 2) = (unsigned short)(pk >> 16);
            *(LAS unsigned short*)(lds + L_KDT + (c0 + i) * 144 + pt * 2) = (unsigned short)(pd & 0xffffu); *(LAS unsigned short*)(lds + L_KDT + (c0 + i + 1) * 144 + pt * 2) = (unsigned short)(pd >> 16); }
    }
    __syncthreads();
    }
    for (int rrB = 0; rrB < GP_B; ++rrB) {
#pragma unroll
    for (int q = 0; q < 2; ++q) {
        const int idx = 2 * wave + q, ct = idx >> 2, st = idx & 3;
        f32x4 acc = (f32x4){0.f, 0.f, 0.f, 0.f}, acc2 = (f32x4){0.f, 0.f, 0.f, 0.f};
        if (st <= ct) {
#pragma unroll
            for (int kk = 0; kk < 4; ++kk) {
                const bf16x8 kc = *(const LAS bf16x8*)(lds + L_KS + (ct * 16 + fr) * 272 + (32 * kk + 8 * fq) * 2);
                const bf16x8 ks = *(const LAS bf16x8*)(lds + L_KS + (st * 16 + fr) * 272 + (32 * kk + 8 * fq) * 2);
                const bf16x8 qc = *(const LAS bf16x8*)(lds + L_QS + (ct * 16 + fr) * 272 + (32 * kk + 8 * fq) * 2);
                acc = mfma16(kc, ks, acc);
                acc2 = mfma16(ks, qc, acc2);
            }
        }
        {   const int sc = st * 16 + fr; const float gcs = GCs[sc];
#pragma unroll
            for (int r = 0; r < 4; ++r) { const int c = ct * 16 + 4 * fq + r; const float dl = fminf(GCs[c] - gcs, 0.f);
                const float v = (sc < c) ? BTs[c] * acc[r] * __expf(dl) : 0.f;
                *(LAS float*)(lds + L_AM + c * 272 + sc * 4) = v; } }
        {   const int c = ct * 16 + fr; const float gcc = GCs[c]; float o[4];
#pragma unroll
            for (int r = 0; r < 4; ++r) { const int sr = st * 16 + 4 * fq + r; const float dl = fminf(gcc - GCs[sr], 0.f); o[r] = (sr <= c) ? acc2[r] * __expf(dl) : 0.f; }
            u32x2 w; w.x = cvt_pk_bf16(o[0], o[1]); w.y = cvt_pk_bf16(o[2], o[3]);
            *(u32x2*)(GATT + (size_t)unit * 4096 + c * 64 + 32 * (st >> 1) + 8 * fq + 4 * (st & 1)) = w; }
    }
    __syncthreads();
    }
    for (int rrC = 0; rrC < GP_C; ++rrC) {
    if (wave < 4) {
        const int bi = wave; float x[16];
#pragma unroll
        for (int i = 0; i < 16; ++i) x[i] = 0.f;
#pragma unroll
        for (int i = 0; i < 16; ++i) {
            float s0 = (fr == i) ? 1.f : 0.f, s1 = 0.f, s2 = 0.f, s3 = 0.f;
#pragma unroll
            for (int m4 = 0; m4 < (i + 3) / 4; ++m4) { const f32x4 a4 = *(const LAS f32x4*)(lds + L_AM + (16 * bi + i) * 272 + (16 * bi) * 4 + m4 * 16);
                s0 -= a4[0] * x[4 * m4]; s1 -= a4[1] * x[4 * m4 + 1]; s2 -= a4[2] * x[4 * m4 + 2]; s3 -= a4[3] * x[4 * m4 + 3]; }
            x[i] = (s0 + s1) + (s2 + s3);
        }
        if (fq == 0) {
#pragma unroll
            for (int i = 0; i < 16; ++i) { *(LAS float*)(lds + L_DINV + bi * 1280 + i * 80 + fr * 4) = x[i];
                *(LAS unsigned short*)(lds + L_TB + (16 * bi + i) * 144 + (16 * bi + fr) * 2) = (unsigned short)(cvt_pk_bf16(x[i], 0.f) & 0xffffu); }
        } else {
            const int bj = bi + fq;
            if (bj < 4) {
#pragma unroll
                for (int i = 0; i < 16; ++i) *(LAS unsigned short*)(lds + L_TB + (16 * bi + i) * 144 + (16 * bj + fr) * 2) = (unsigned short)0; }
        }
    } else {
        for (int idx = tid - 256; idx < 1024; idx += 256) { const int row = idx >> 3, ch = idx & 7;
            *(u32x4*)(GKDT + (size_t)unit * 8192 + row * 64 + ch * 8) = *(const LAS u32x4*)(lds + L_KDT + row * 144 + (((8 * ch + 8 * (row >> 4)) & 63) * 2)); }
    }
    __syncthreads();
    if (wave < 3) {
        const int j = wave;
        f32x4 Tc[4];
#pragma unroll
        for (int k = 0; k < 4; ++k) Tc[k] = (f32x4){0.f, 0.f, 0.f, 0.f};
#pragma unroll
        for (int k = 0; k < 3; ++k) if (k == j) {
#pragma unroll
            for (int kk = 0; kk < 4; ++kk) Tc[k][kk] = *(const LAS float*)(lds + L_DINV + k * 1280 + (4 * fq + kk) * 80 + fr * 4); }
#pragma unroll
        for (int i = 1; i < 4; ++i) if (i > j) {
            f32x4 Mx = (f32x4){0.f, 0.f, 0.f, 0.f};
#pragma unroll
            for (int k = 0; k < 3; ++k) if (k >= j && k < i) {
                const f32x4 a4 = *(const LAS f32x4*)(lds + L_AM + (16 * i + fr) * 272 + (16 * k + 4 * fq) * 4);
#pragma unroll
                for (int kk = 0; kk < 4; ++kk) Mx = mfma4f(a4[kk], Tc[k][kk], Mx); }
            f32x4 Tx = (f32x4){0.f, 0.f, 0.f, 0.f};
            const f32x4 d4 = *(const LAS f32x4*)(lds + L_DINV + i * 1280 + fr * 80 + (4 * fq) * 4);
#pragma unroll
            for (int kk = 0; kk < 4; ++kk) Tx = mfma4f(d4[kk], Mx[kk], Tx);
            Tc[i] = -Tx;
#pragma unroll
            for (int kk = 0; kk < 4; ++kk) *(LAS unsigned short*)(lds + L_TB + (16 * i + 4 * fq + kk) * 144 + (16 * j + fr) * 2) = (unsigned short)(cvt_pk_bf16(Tc[i][kk], 0.f) & 0xffffu);
        }
    }
    __syncthreads();
    }
    for (int rrD = 0; rrD < GP_D; ++rrD) {
#pragma unroll
    for (int q = 0; q < 4; ++q) {
        const int idx = 4 * wave + q;
        {   const int ct = idx >> 3, nt = idx & 7; f32x4 acc = (f32x4){0.f, 0.f, 0.f, 0.f};
#pragma unroll
            for (int kk = 0; kk < 2; ++kk) {
                const bf16x8 ta = *(const LAS bf16x8*)(lds + L_TB + (ct * 16 + fr) * 144 + (32 * kk + 8 * fq) * 2);
                const bf16x8 rb = *(const LAS bf16x8*)(lds + L_RT + (nt * 16 + fr) * 144 + (((32 * kk + 8 * fq + 8 * nt) & 63) * 2));
                acc = mfma16(ta, rb, acc); }
            u32x2 w; w.x = cvt_pk_bf16(acc[0], acc[1]); w.y = cvt_pk_bf16(acc[2], acc[3]);
            *(u32x2*)(GUT + (size_t)unit * 8192 + (nt * 16 + fr) * 64 + ct * 16 + 4 * fq) = w; }
        {   const int it = idx >> 2, ct = idx & 3; f32x4 acc = (f32x4){0.f, 0.f, 0.f, 0.f};
#pragma unroll
            for (int kk = 0; kk < 2; ++kk) {
                const bf16x8 ra = *(const LAS bf16x8*)(lds + L_RT + (128 + it * 16 + fr) * 144 + (((32 * kk + 8 * fq + 8 * it) & 63) * 2));
                const bf16x8 tb = *(const LAS bf16x8*)(lds + L_TB + (ct * 16 + fr) * 144 + (32 * kk + 8 * fq) * 2);
                acc = mfma16(ra, tb, acc); }
            u32x2 w; w.x = cvt_pk_bf16(acc[0], acc[1]); w.y = cvt_pk_bf16(acc[2], acc[3]);
            *(u32x2*)(GW + (size_t)unit * 8192 + (ct * 16 + fr) * 128 + 32 * (it >> 1) + 8 * fq + 4 * (it & 1)) = w; }
    }
    __syncthreads();
    }
}

constexpr int GS_SPW = 2, GS_SLOT = 36864, GS_D = 4;
__device__ __forceinline__ void gdn_scan(int bh, int sg, LAS unsigned char* lds, const bf16_t* GW, const bf16_t* GKDT, const bf16_t* GUT, const float* GL, bf16_t* GST, bf16_t* GVT, int tid, int lane, int wave) {
    const int fr = lane & 15, fq = lane >> 4;
    LAS float* DEC = (LAS float*)(lds + DEC_OFF);
    if (tid < 128) DEC[tid] = GL[bh * 128 + tid];
    const bool comp = wave < GS_SPW;
    const int slice = sg * GS_SPW + wave;
    const size_t ubase = (size_t)bh * 128;
    unsigned goff[6], dsto[6]; int kind[6];
#pragma unroll
    for (int k = 0; k < 6; ++k) { const int p = (wave - GS_SPW) * 6 + k;
        if (p < 16) { const int r = 4 * p + (lane >> 4), qd = lane & 15; goff[k] = (unsigned)(r * 256 + ((qd ^ (r & 15)) * 16)); dsto[k] = (unsigned)p * 1024u; kind[k] = 0; }
        else if (p < 32) { const int pp = p - 16, r = 8 * pp + (lane >> 3), qd = lane & 7; goff[k] = (unsigned)(r * 128 + ((qd ^ ((r >> 1) & 7)) * 16)); dsto[k] = 16384u + (unsigned)pp * 1024u; kind[k] = 1; }
        else { const int u = p - 32, cw = u >> 1, k2 = u & 1; goff[k] = (unsigned)((sg * GS_SPW + cw) * 2048 + k2 * 1024 + lane * 16); dsto[k] = 32768u + (unsigned)(cw * 2048 + k2 * 1024); kind[k] = 2; } }
#define GS_ISSUE(step, slot) do { if (!comp) { const size_t _u = ubase + (size_t)(step); \
        _Pragma("unroll") for (int _k = 0; _k < 6; ++_k) { const char* _g = (const char*)((kind[_k] == 0 ? GW : (kind[_k] == 1 ? GKDT : GUT)) + _u * 8192); \
            __builtin_amdgcn_global_load_lds((const unsigned*)(_g + goff[_k]), (LAS unsigned*)(lds + (slot) * GS_SLOT + dsto[_k]), 16, 0, 0); } } \
        asm volatile("" ::: "memory"); } while (0)
    f32x4 S[8];
#pragma unroll
    for (int i = 0; i < 8; ++i) S[i] = (f32x4){0.f, 0.f, 0.f, 0.f};
    asm volatile("s_waitcnt vmcnt(0) lgkmcnt(0)" ::: "memory");
    __builtin_amdgcn_s_barrier();
    GS_ISSUE(0, 0); GS_ISSUE(1, 1); GS_ISSUE(2, 2);
    for (int n = 0; n < 128; ++n) {
        if (!comp) asm volatile("s_waitcnt vmcnt(12)" ::: "memory");
        __builtin_amdgcn_s_barrier();
        asm volatile("" ::: "memory");
        { const int nn = n + 3 < 128 ? n + 3 : 127; const int sl = (n + 3) & 3; GS_ISSUE(nn, sl); }
        if (comp) {
            LAS const unsigned char* sb = lds + (n & 3) * GS_SLOT;
            const size_t unit = ubase + n;
            bf16x8 aw[4][4], ak[2][8];
#pragma unroll
            for (int kk = 0; kk < 4; ++kk)
#pragma unroll
                for (int ct = 0; ct < 4; ++ct) aw[kk][ct] = *(const LAS bf16x8*)(sb + (16 * ct + fr) * 256 + (((4 * kk + fq) ^ fr) * 16));
#pragma unroll
            for (int kk = 0; kk < 2; ++kk)
#pragma unroll
                for (int i = 0; i < 8; ++i) ak[kk][i] = *(const LAS bf16x8*)(sb + 16384 + (16 * i + fr) * 128 + (((4 * kk + fq) ^ ((fr >> 1) & 7)) * 16));
            u32x2 uu[4];
#pragma unroll
            for (int ct = 0; ct < 4; ++ct) uu[ct] = *(const LAS u32x2*)(sb + 32768 + wave * 2048 + fr * 128 + (16 * ct + 4 * fq) * 2);
            const float dec = DEC[n];
            asm volatile("" ::: "memory");
            bf16x8 bs[4];
#pragma unroll
            for (int kk = 0; kk < 4; ++kk) { u32x4 bw; bw.x = cvt_pk_bf16(S[2 * kk][0], S[2 * kk][1]); bw.y = cvt_pk_bf16(S[2 * kk][2], S[2 * kk][3]);
                bw.z = cvt_pk_bf16(S[2 * kk + 1][0], S[2 * kk + 1][1]); bw.w = cvt_pk_bf16(S[2 * kk + 1][2], S[2 * kk + 1][3]);
                *(u32x4*)(GST + unit * 16384 + (16 * slice + fr) * 128 + 32 * kk + 8 * fq) = bw;
                bs[kk] = __builtin_bit_cast(bf16x8, bw); }
            f32x4 av[4];
#pragma unroll
            for (int ct = 0; ct < 4; ++ct) av[ct] = (f32x4){0.f, 0.f, 0.f, 0.f};
#pragma unroll
            for (int kk = 0; kk < 4; ++kk)
#pragma unroll
                for (int ct = 0; ct < 4; ++ct) av[ct] = mfma16(aw[kk][ct], bs[kk], av[ct]);
            bf16x8 bv[2];
#pragma unroll
            for (int kk = 0; kk < 2; ++kk) { u32x4 bw;
                { const int ct = 2 * kk; bw.x = cvt_pk_bf16(bflo(uu[ct].x) - av[ct][0], bfhi(uu[ct].x) - av[ct][1]); bw.y = cvt_pk_bf16(bflo(uu[ct].y) - av[ct][2], bfhi(uu[ct].y) - av[ct][3]); }
                { const int ct = 2 * kk + 1; bw.z = cvt_pk_bf16(bflo(uu[ct].x) - av[ct][0], bfhi(uu[ct].x) - av[ct][1]); bw.w = cvt_pk_bf16(bflo(uu[ct].y) - av[ct][2], bfhi(uu[ct].y) - av[ct][3]); }
                *(u32x4*)(GVT + unit * 8192 + (16 * slice + fr) * 64 + 32 * kk + 8 * fq) = bw;
                bv[kk] = __builtin_bit_cast(bf16x8, bw); }
#pragma unroll
            for (int i = 0; i < 8; ++i) S[i] = S[i] * dec;
#pragma unroll
            for (int kk = 0; kk < 2; ++kk)
#pragma unroll
                for (int i = 0; i < 8; ++i) S[i] = mfma16(ak[kk][i], bv[kk], S[i]);
        }
    }
#undef GS_ISSUE
    asm volatile("s_waitcnt vmcnt(0)" ::: "memory");
    __builtin_amdgcn_s_barrier();
}

constexpr int GO_SLOT = 49152;
__device__ __forceinline__ void gdn_out_units(int u0, int nu, const Args& a, LAS unsigned char* lds, bf16_t* acat, bf16_t* odst, const bf16_t* GQG, const bf16_t* GATT, const bf16_t* GST, const bf16_t* GVT, int tid, int lane, int wave) {
    const int fr = lane & 15, fq = lane >> 4, ct = wave & 3, dvh = wave >> 2;
    LAS float* SSQ = (LAS float*)(lds + DEC_OFF);
    unsigned goff[6]; unsigned dsto[6]; bool isv[6];
#pragma unroll
    for (int k = 0; k < 6; ++k) { const int p = wave * 6 + k;
        if (p < 32) { const int r = 4 * p + (lane >> 4), qd = lane & 15; goff[k] = (unsigned)(r * 256 + ((qd ^ (r & 15)) * 16)); dsto[k] = (unsigned)p * 1024u; isv[k] = false; }
        else { const int pp = p - 32, r = 8 * pp + (lane >> 3), qd = lane & 7; goff[k] = (unsigned)(r * 128 + ((qd ^ ((r >> 1) & 7)) * 16)); dsto[k] = 32768u + (unsigned)pp * 1024u; isv[k] = true; } }
#define GO_ISSUE(unit, slot) do { const char* _s = (const char*)(GST + (size_t)(unit) * 16384); const char* _v = (const char*)(GVT + (size_t)(unit) * 8192); \
        _Pragma("unroll") for (int _k = 0; _k < 6; ++_k) __builtin_amdgcn_global_load_lds((const unsigned*)((isv[_k] ? _v : _s) + goff[_k]), (LAS unsigned*)(lds + (slot) * GO_SLOT + dsto[_k]), 16, 0, 0); \
        asm volatile("" ::: "memory"); } while (0)
    f32x4 gv[4];
#pragma unroll
    for (int i4 = 0; i4 < 4; ++i4) gv[i4] = *(const f32x4*)(a.g_dn_out + 16 * (4 * dvh + i4) + 4 * fq);
    asm volatile("s_waitcnt vmcnt(0) lgkmcnt(0)" ::: "memory");
    __builtin_amdgcn_s_barrier();
    GO_ISSUE(u0, 0); GO_ISSUE(u0 + (nu > 1 ? 1 : 0), 1);
    for (int i = 0; i < nu; ++i) {
        const int unit = u0 + i;
        if (i == 0) asm volatile("s_waitcnt vmcnt(6)" ::: "memory"); else if (i == 1) asm volatile("s_waitcnt vmcnt(20)" ::: "memory"); else asm volatile("s_waitcnt vmcnt(24)" ::: "memory");
        __builtin_amdgcn_s_barrier();
        asm volatile("" ::: "memory");
        const int bh = unit >> 7, n = unit & 127, b = bh >> 4, h = bh & 15;
        const bf16_t* qg = GQG + (size_t)unit * 8192 + (16 * ct + fr) * 128 + 8 * fq;
        const bf16_t* at = GATT + (size_t)unit * 4096 + (16 * ct + fr) * 64 + 8 * fq;
        bf16x8 bq[4], bt[2];
#pragma unroll
        for (int kk = 0; kk < 4; ++kk) bq[kk] = *(const bf16x8*)(qg + 32 * kk);
#pragma unroll
        for (int kk = 0; kk < 2; ++kk) bt[kk] = *(const bf16x8*)(at + 32 * kk);
        const size_t zoff = tiled_off(b * SEQ + n * 64 + 16 * ct + fr, 2048 + h * 128 + 64 * dvh + 4 * fq, KCAT / 64);
        u32x2 zz[4];
#pragma unroll
        for (int i4 = 0; i4 < 4; ++i4) zz[i4] = *(const u32x2*)(acat + zoff + 16 * i4);
        asm volatile("" ::: "memory");
        { const int un = (i + 2 < nu) ? unit + 2 : unit; GO_ISSUE(un, (i + 2) % 3); }
        LAS const unsigned char* sb = lds + (i % 3) * GO_SLOT;
        bf16x8 fs[4][4], fv[4][2];
#pragma unroll
        for (int i4 = 0; i4 < 4; ++i4) { const int row = 16 * (4 * dvh + i4) + fr;
#pragma unroll
            for (int kk = 0; kk < 4; ++kk) fs[i4][kk] = *(const LAS bf16x8*)(sb + row * 256 + (((4 * kk + fq) ^ fr) * 16));
#pragma unroll
            for (int kk = 0; kk < 2; ++kk) fv[i4][kk] = *(const LAS bf16x8*)(sb + 32768 + row * 128 + (((4 * kk + fq) ^ ((fr >> 1) & 7)) * 16)); }
        f32x4 o[4]; float ss = 0.f;
#pragma unroll
        for (int i4 = 0; i4 < 4; ++i4) { f32x4 acc = (f32x4){0.f, 0.f, 0.f, 0.f};
#pragma unroll
            for (int kk = 0; kk < 4; ++kk) acc = mfma16(fs[i4][kk], bq[kk], acc);
#pragma unroll
            for (int kk = 0; kk < 2; ++kk) acc = mfma16(fv[i4][kk], bt[kk], acc);
            o[i4] = acc; ss += (acc[0] * acc[0] + acc[1] * acc[1]) + (acc[2] * acc[2] + acc[3] * acc[3]); }
        ss += __shfl_xor(ss, 16); ss += __shfl_xor(ss, 32);
        LAS float* sq = SSQ + (i & 1) * 128;
        if (fq == 0) sq[dvh * 64 + ct * 16 + fr] = ss;
        asm volatile("s_waitcnt lgkmcnt(0)" ::: "memory");
        __builtin_amdgcn_s_barrier();
        asm volatile("" ::: "memory");
        const float tot = sq[ct * 16 + fr] + sq[64 + ct * 16 + fr];
        const float rstd = __builtin_amdgcn_rsqf(tot * (1.0f / 128.0f) + EPS);
#pragma unroll
        for (int i4 = 0; i4 < 4; ++i4) { const u32x2 z = zz[i4]; const f32x4 g = gv[i4];
            u32x2 w; w.x = pk2(o[i4][0] * rstd * g[0] * siluf_(bflo(z.x)), o[i4][1] * rstd * g[1] * siluf_(bfhi(z.x)));
            w.y = pk2(o[i4][2] * rstd * g[2] * siluf_(bflo(z.y)), o[i4][3] * rstd * g[3] * siluf_(bfhi(z.y)));
            *(u32x2*)(odst + zoff + 16 * i4) = w; }
        asm volatile("" ::: "memory");
    }
#undef GO_ISSUE
    asm volatile("s_waitcnt vmcnt(0)" ::: "memory");
    __builtin_amdgcn_s_barrier();
}

typedef float f32x16 __attribute__((ext_vector_type(16)));
__device__ __forceinline__ f32x16 mfma32(bf16x8 a, bf16x8 b, f32x16 c) { return __builtin_amdgcn_mfma_f32_32x32x16_bf16(a, b, c, 0, 0, 0); }
__device__ __forceinline__ int perm16(int k) { const int k16 = k & 15; return (k & ~15) + 8 * ((k16 >> 2) & 1) + 4 * (k16 >> 3) + (k16 & 3); }
__device__ __forceinline__ bf16x8 pack8(const f32x16& p, int base) {
    u32x4 w; w.x = cvt_pk_bf16(p[base + 0], p[base + 1]); w.y = cvt_pk_bf16(p[base + 2], p[base + 3]); w.z = cvt_pk_bf16(p[base + 4], p[base + 5]); w.w = cvt_pk_bf16(p[base + 6], p[base + 7]);
    return __builtin_bit_cast(bf16x8, w); }

constexpr int SW_VT = 36864, SW_BT = 70656;
__device__ __forceinline__ void swa_unit(int unit, const Args& a, LAS unsigned char* lds, bf16_t* acat, bf16_t* odst, const bf16_t* kva, int tid, int lane, int wave) {
    const int kvh = unit & 3, nb = (unit >> 2) & 63, b = unit >> 8, hq = kvh * 8 + wave;
    const long tok0 = (long)b * SEQ + (long)nb * 128, tokw = tok0 - 128;
#pragma unroll
    for (int i = 0; i < 4; ++i) { const int idx = tid + 512 * i, row = idx >> 3, ch = idx & 7; u32x4 v = (u32x4){0u, 0u, 0u, 0u};
        if (nb > 0 || row >= 128) v = *(const u32x4*)(kva + (size_t)(tokw + row) * 512 + kvh * 64 + ch * 8);
        *(LAS u32x4*)(lds + row * 144 + ch * 16) = v; }
#pragma unroll
    for (int i = 0; i < 4; ++i) { const int idx = tid + 512 * i, key = idx & 255, ch = idx >> 8; u32x4 v = (u32x4){0u, 0u, 0u, 0u};
        if (nb > 0 || key >= 128) v = *(const u32x4*)(kva + (size_t)(tokw + key) * 512 + 256 + kvh * 64 + ch * 8);
        const int pos = perm16(key);
#pragma unroll
        for (int e = 0; e < 4; ++e) { *(LAS unsigned short*)(lds + SW_VT + (8 * ch + 2 * e) * 528 + pos * 2) = (unsigned short)(v[e] & 0xffffu);
            *(LAS unsigned short*)(lds + SW_VT + (8 * ch + 2 * e + 1) * 528 + pos * 2) = (unsigned short)(v[e] >> 16); } }
    LAS float* BT = (LAS float*)(lds + SW_BT) + wave * 128;
    BT[lane] = a.rel_bias[t5_bucket_dev(lane) * A_HEADS + hq]; BT[lane + 64] = a.rel_bias[t5_bucket_dev(lane + 64) * A_HEADS + hq];
    __syncthreads();
    const int r = lane & 31, hh = lane >> 5;
    const float sink = a.sinks[hq];
#pragma unroll 1
    for (int i = 0; i < 4; ++i) {
        bf16_t* qrow = acat + tiled_off((int)tok0 + 32 * i + r, hq * 64, KCAT / 64);
        bf16x8 qf[4];
#pragma unroll
        for (int s = 0; s < 4; ++s) qf[s] = *(const bf16x8*)(qrow + 16 * s + 8 * hh);
        f32x16 sc[5];
#pragma unroll
        for (int d = 0; d < 5; ++d) { f32x16 acc;
#pragma unroll
            for (int e = 0; e < 16; ++e) acc[e] = 0.f;
#pragma unroll
            for (int s = 0; s < 4; ++s) acc = mfma32(*(const LAS bf16x8*)(lds + (32 * (i + d) + r) * 144 + (16 * s + 8 * hh) * 2), qf[s], acc);
            sc[d] = acc;  asm volatile("" ::: "memory"); }
        float mx = sink;
#pragma unroll
        for (int d = 0; d < 5; ++d) { const bool tile_ok = (nb > 0) || (i + d >= 4);
#pragma unroll
            for (int e = 0; e < 16; ++e) { const int krow = (e & 3) + 8 * (e >> 2) + 4 * hh, dist = 128 - 32 * d + r - krow;
                const bool valid = tile_ok && (d == 0 ? (krow > r) : (d == 4 ? (krow <= r) : true));
                const float v = valid ? sc[d][e] * 0.125f + BT[dist & 127] : -1e30f;
                sc[d][e] = v; mx = fmaxf(mx, v); }  asm volatile("" ::: "memory"); }
        mx = fmaxf(mx, __shfl_xor(mx, 32));
        float ls = 0.f;
#pragma unroll
        for (int d = 0; d < 5; ++d)
#pragma unroll
            for (int e = 0; e < 16; ++e) { const float p = __expf(sc[d][e] - mx); sc[d][e] = p; ls += p; }
        ls += __shfl_xor(ls, 32); ls += __expf(sink - mx);
        f32x16 o[2];
#pragma unroll
        for (int dt = 0; dt < 2; ++dt)
#pragma unroll
            for (int e = 0; e < 16; ++e) o[dt][e] = 0.f;
#pragma unroll
        for (int d = 0; d < 5; ++d)
#pragma unroll
            for (int s2 = 0; s2 < 2; ++s2) { const bf16x8 pf = pack8(sc[d], 8 * s2);
#pragma unroll
                for (int dt = 0; dt < 2; ++dt) o[dt] = mfma32(*(const LAS bf16x8*)(lds + SW_VT + (32 * dt + r) * 528 + (32 * (i + d) + 16 * s2) * 2 + hh * 16), pf, o[dt]);
                asm volatile("" ::: "memory"); }
        const float inv = 1.0f / ls;
#pragma unroll
        for (int dt = 0; dt < 2; ++dt)
#pragma unroll
            for (int g4 = 0; g4 < 4; ++g4) { u32x2 w; w.x = cvt_pk_bf16(o[dt][4 * g4] * inv, o[dt][4 * g4 + 1] * inv); w.y = cvt_pk_bf16(o[dt][4 * g4 + 2] * inv, o[dt][4 * g4 + 3] * inv);
                *(u32x2*)(odst + (qrow - acat) + 32 * dt + 8 * g4 + 4 * hh) = w; }
    }
    __syncthreads();
}

constexpr int MA_VT = 69632;
__device__ __forceinline__ void mem_unit(int unit, LAS unsigned char* lds, bf16_t* acat, bf16_t* odst, const bf16_t* mkv, int tid, int lane, int wave) {
    const int h = unit & 3, qb = (unit >> 2) & 31, b = unit >> 7;
    const bf16_t* kbase = mkv + (size_t)b * MEMLEN * 1024 + h * 128;
#pragma unroll
    for (int i = 0; i < 8; ++i) { const int idx = tid + 512 * i, row = idx >> 4, ch = idx & 15;
        *(LAS u32x4*)(lds + row * 272 + ch * 16) = *(const u32x4*)(kbase + (size_t)row * 1024 + ch * 8); }
#pragma unroll
    for (int i = 0; i < 8; ++i) { const int idx = tid + 512 * i, key = idx & 255, ch = idx >> 8;
        const u32x4 v = *(const u32x4*)(kbase + (size_t)key * 1024 + 512 + ch * 8);
        const int pos = perm16(key);
#pragma unroll
        for (int e = 0; e < 4; ++e) { *(LAS unsigned short*)(lds + MA_VT + (8 * ch + 2 * e) * 528 + pos * 2) = (unsigned short)(v[e] & 0xffffu);
            *(LAS unsigned short*)(lds + MA_VT + (8 * ch + 2 * e + 1) * 528 + pos * 2) = (unsigned short)(v[e] >> 16); } }
    __syncthreads();
    const int r = lane & 31, hh = lane >> 5;
    bf16_t* qrow = acat + tiled_off(b * SEQ + qb * 256 + 32 * wave + r, 4096 + h * 128, KCAT / 64);
    bf16x8 qf[8];
#pragma unroll
    for (int s = 0; s < 8; ++s) qf[s] = *(const bf16x8*)(qrow + (s >> 2) * 8192 + 16 * (s & 3) + 8 * hh);
    f32x16 o[4];
#pragma unroll
    for (int dt = 0; dt < 4; ++dt)
#pragma unroll
        for (int e = 0; e < 16; ++e) o[dt][e] = 0.f;
    float mx = -1e30f, ls = 0.f;
#pragma unroll 1
    for (int grp = 0; grp < 4; ++grp) {
        f32x16 sc[2]; float gm = -1e30f;
#pragma unroll
        for (int d = 0; d < 2; ++d) { f32x16 acc;
#pragma unroll
            for (int e = 0; e < 16; ++e) acc[e] = 0.f;
#pragma unroll
            for (int s = 0; s < 8; ++s) acc = mfma32(*(const LAS bf16x8*)(lds + (32 * (2 * grp + d) + r) * 272 + (16 * s + 8 * hh) * 2), qf[s], acc);
#pragma unroll
            for (int e = 0; e < 16; ++e) { acc[e] *= 0.08838834764831845f; gm = fmaxf(gm, acc[e]); }
            sc[d] = acc; }
        gm = fmaxf(gm, __shfl_xor(gm, 32));
        const float mn = fmaxf(mx, gm), alpha = __expf(mx - mn);
        float ps = 0.f;
#pragma unroll
        for (int d = 0; d < 2; ++d)
#pragma unroll
            for (int e = 0; e < 16; ++e) { const float p = __expf(sc[d][e] - mn); sc[d][e] = p; ps += p; }
        ps += __shfl_xor(ps, 32);
        ls = ls * alpha + ps; mx = mn;
#pragma unroll
        for (int dt = 0; dt < 4; ++dt)
#pragma unroll
            for (int e = 0; e < 16; ++e) o[dt][e] *= alpha;
#pragma unroll
        for (int d = 0; d < 2; ++d)
#pragma unroll
            for (int s2 = 0; s2 < 2; ++s2) { const bf16x8 pf = pack8(sc[d], 8 * s2);
#pragma unroll
                for (int dt = 0; dt < 4; ++dt) o[dt] = mfma32(*(const LAS bf16x8*)(lds + MA_VT + (32 * dt + r) * 528 + (32 * (2 * grp + d) + 16 * s2) * 2 + hh * 16), pf, o[dt]); }
    }
    const float inv = 1.0f / ls;
#pragma unroll
    for (int dt = 0; dt < 4; ++dt)
#pragma unroll
        for (int g4 = 0; g4 < 4; ++g4) { u32x2 w; w.x = cvt_pk_bf16(o[dt][4 * g4] * inv, o[dt][4 * g4 + 1] * inv); w.y = cvt_pk_bf16(o[dt][4 * g4 + 2] * inv, o[dt][4 * g4 + 3] * inv);
            *(u32x2*)(odst + (qrow - acat) + (dt >> 1) * 8192 + 32 * (dt & 1) + 8 * g4 + 4 * hh) = w; }
    __syncthreads();
}


constexpr int BG_BRA = 128 * 32, BG_BRM = 128 * 8, BG_O = 128 * 64, BG_F1 = (2 * DFF / 32) * 64, BG_F2 = 128 * (DFF / 64);
constexpr int BG_ITEMS = 2 * BG_BRA + BG_BRM + BG_O + BG_F1 + BG_F2;
constexpr int BG_CH = 32;
constexpr int BG_E0 = (2 * BG_BRA + BG_BRM) / BG_CH, BG_E1 = BG_E0 + BG_O / BG_CH, BG_E2 = BG_E1 + BG_F1 / BG_CH, BG_E3 = BG_ITEMS / BG_CH;
static_assert(BG_ITEMS % BG_CH == 0 && (2 * BG_BRA + BG_BRM) % BG_CH == 0 && BG_O % BG_CH == 0 && BG_F1 % BG_CH == 0, "whole chunks per segment");
__device__ __forceinline__ void bg_item(int r, const Args& args, bf16_t* Wbr_t, bf16_t* Wo_t, bf16_t* Wf1_t, bf16_t* Wf2_t, LAS float* scr, int lane) {
    if (r < BG_BRA) { const int kb = r / 128, gd = r % 128; p0_transpose_item(args.w_br_a, DM, gd * 32, kb * 64, Wbr_t, (size_t)gd * 32, KCAT, 0, scr, lane); return; } r -= BG_BRA;
    if (r < BG_BRA) { const int kb = r / 128, gd = r % 128; p0_transpose_item(args.w_br_b, DM, gd * 32, kb * 64, Wbr_t, (size_t)gd * 32, KCAT, 2048, scr, lane); return; } r -= BG_BRA;
    if (r < BG_BRM) { const int kb = r / 128, gd = r % 128; p0_transpose_item(args.w_br_m, DM, gd * 32, kb * 64, Wbr_t, (size_t)gd * 32, KCAT, 4096, scr, lane); return; } r -= BG_BRM;
    if (r < BG_O) { const int kb = r / 128, gd = r % 128; p0_transpose_item(args.w_o, DM, gd * 32, kb * 64, Wo_t, (size_t)gd * 32, DM, 0, scr, lane); return; } r -= BG_O;
    if (r < BG_F1) { const int kb = r / (2 * DFF / 32), gd = r % (2 * DFF / 32), tj = gd / 8, wi = gd % 8;
        const int src = wi < 4 ? tj * 128 + wi * 32 : DFF + tj * 128 + (wi - 4) * 32;
        p0_transpose_item(args.w_ffn_in, 2 * DFF, src, kb * 64, Wf1_t, (size_t)gd * 32, DM, 0, scr, lane, args.g_ffn); return; } r -= BG_F1;
    { const int kb = r / 128, gd = r % 128; p0_transpose_item(args.w_ffn_out, DM, gd * 32, kb * 64, Wf2_t, (size_t)gd * 32, DFF, 0, scr, lane); }
}

__global__ void __launch_bounds__(512, 2) hybrid_fwd(Args args) {
    extern __shared__ __attribute__((aligned(16))) unsigned char lds_raw[];
    LAS unsigned char* lds = (LAS unsigned char*)lds_raw;
    volatile LAS unsigned* MISC = (volatile LAS unsigned*)(lds + MISC_OFF);
    const int tid = threadIdx.x, lane = tid & 63, wave = __builtin_amdgcn_readfirstlane(tid >> 6);
    const int G = gridDim.x, bx = blockIdx.x;
    const int vcu = (G % 8 == 0) ? (bx % 8) * (G / 8) + bx / 8 : bx;
    unsigned char* ws = args.ws;
    unsigned* ctl = (unsigned*)(ws + WS_CTL);
    bf16_t* Win_t = (bf16_t*)(ws + WS_WIN); bf16_t* Wkv_t = (bf16_t*)(ws + WS_WKV); bf16_t* Wbr_t = (bf16_t*)(ws + WS_WBR); bf16_t* Wo_t = (bf16_t*)(ws + WS_WO);
    bf16_t* Wf1_t = (bf16_t*)(ws + WS_WF1); bf16_t* Wf2_t = (bf16_t*)(ws + WS_WF2);
    bf16_t* HB = (bf16_t*)(ws + WS_H); bf16_t* ACAT = (bf16_t*)(ws + WS_ACAT); bf16_t* KVA = (bf16_t*)(ws + WS_KVA); bf16_t* BQKV = (bf16_t*)(ws + WS_BQKV);
    bf16_t* GATES = (bf16_t*)(ws + WS_GATES); float* BA = (float*)(ws + WS_BA); bf16_t* MEMN = (bf16_t*)(ws + WS_MEMN); bf16_t* MKV = (bf16_t*)(ws + WS_MKV);
    float* PART1 = (float*)(ws + WS_PART1); float* PART2 = (float*)(ws + WS_PART2); bf16_t* HID = (bf16_t*)(ws + WS_HID);
    bf16_t* YB = HB;
    bf16_t* X1B = (bf16_t*)(ws + WS_ACAT);
    bf16_t* GWp = (bf16_t*)(ws + WS_GW); bf16_t* GKDTp = (bf16_t*)(ws + WS_GKDT); bf16_t* GATTp = (bf16_t*)(ws + WS_GATT); float* GLp = (float*)(ws + WS_GL);
    bf16_t* GQGp = (bf16_t*)(ws + WS_GQG); bf16_t* GUTp = (bf16_t*)(ws + WS_GUT); bf16_t* GSTp = (bf16_t*)(ws + WS_GST); bf16_t* GVTp = (bf16_t*)(ws + WS_GVT);

    for (int u = tid; u < (LDS_BYTES - RS_OFF) / 4; u += 512) ((LAS unsigned*)(lds + RS_OFF))[u] = 0u;
    __syncthreads();
    XcdBarrier bar; bar.bar = ctl + CW_BAR; bar.x = 0; bar.st = nullptr;
    if (MK_ONE_LAUNCH) bar = xcd_barrier_post(ctl + CW_BAR, MISC + 8);
    const int lo = args.ph_lo, hi = args.ph_hi;
#ifndef DISABLE_MASK
#define DISABLE_MASK 0
#endif
#define IN(k) (lo <= (k) && (k) < hi && !((DISABLE_MASK >> (k)) & 1))
#ifndef REPEAT_MASK
#define REPEAT_MASK 0
#endif
#define REP(k) for (int _rep = 0; _rep < 1 + ((REPEAT_MASK >> (k)) & 1); ++_rep)
#define ODST_OF(k) ((_rep < ((REPEAT_MASK >> (k)) & 1)) ? (bf16_t*)args.out : ACAT)
#define SEAM(k) do { if (IN(k) && IN((k) + 1)) xcd_barrier(bar); } while (0)
#define AT_LD(p) __hip_atomic_load((p), __ATOMIC_RELAXED, __HIP_MEMORY_SCOPE_AGENT)
#define BG_WORK(need, steal_k) do { \
    LAS int* _qs = (LAS int*)(lds + DEC_OFF + 1024); \
    __syncthreads(); \
    if ((steal_k) >= 0 && tid == 0) (void)__hip_atomic_fetch_add(ctl + CW_DONE + 64 * ((steal_k) < 0 ? 0 : (steal_k)), 1u, __ATOMIC_RELAXED, __HIP_MEMORY_SCOPE_AGENT); \
    for (;;) { \
        if (tid == 0) { const unsigned _hd = AT_LD(ctl + CW_BGHEAD); bool _go = _hd < (unsigned)(need); \
            if (!_go && (steal_k) >= 0 && _hd < (unsigned)BG_E3) _go = AT_LD(ctl + CW_DONE + 64 * ((steal_k) < 0 ? 0 : (steal_k))) < (unsigned)G; \
            _qs[0] = _go ? (int)__hip_atomic_fetch_add(ctl + CW_BGHEAD, 1u, __ATOMIC_RELAXED, __HIP_MEMORY_SCOPE_AGENT) : -1; } \
        __syncthreads(); const int _c = _qs[0]; __syncthreads(); \
        if (_c < 0 || _c >= BG_E3) break; \
        for (int _q = 0; _q < BG_CH / 8; ++_q) bg_item(_c * BG_CH + _q * 8 + wave, args, Wbr_t, Wo_t, Wf1_t, Wf2_t, (LAS float*)(lds + wave * 16384), lane); \
    } } while (0)

    if (IN(0)) REP(0) {
        LAS float* scr = (LAS float*)(lds + wave * 16384);
        const int gw = vcu * 8 + wave, NGW = G * 8;
        constexpr int I_IN = (NP_IN / 32) * 64, I_KV = 32 * 64;
        constexpr int NITEMS = I_IN + I_KV;
        for (int it = gw; it < NITEMS; it += NGW) {
            int r = it;
            if (r < I_IN) { const int kb = r / (NP_IN / 32), gd = r % (NP_IN / 32), n0 = gd * 32;
                const int src = n0 < 10752 ? n0 : (n0 < 23552 ? n0 + 32 : (n0 < 23584 ? n0 - 23552 + 10752 : -1));
                p0_transpose_item(args.w_in, N_IN, src, kb * 64, Win_t, (size_t)n0, DM, 0, scr, lane); continue; } r -= I_IN;
            { const int kb = r / 32, gd = r % 32; p0_transpose_item(args.w_mem_kv, 1024, gd * 32, kb * 64, Wkv_t, (size_t)gd * 32, DM, 0, scr, lane); }
        }
        for (int m = gw; m < M; m += NGW) rms_row_to_bf16(args.x + (size_t)m * DM, args.g_mix, HB, m, lane);
        for (int m = gw; m < MEMROWS; m += NGW) rms_row_to_bf16(args.mem + (size_t)m * DM, args.g_mem, MEMN, m, lane);
    }
    SEAM(0);

    if (IN(1)) REP(1) {
        pg8::Gemm g{HB, Win_t, MEMN, Wkv_t, DM};
        pg8::StaticOrder S; S.init(M, NP_IN, G, bx, 8, 4);
        pg8::EpiInProj E{ACAT, KVA, BQKV, GATES, BA, MKV};
        pg8::gemm_phase<pg8::EpiInProj, pg8::StaticOrder, true, GEMM_MODE>(lds, g, S, E);
        BG_WORK(0, -1);
    }
    SEAM(1);

    if (IN(2)) REP(2) {
        const int per = GDN_UNITS / G, u0 = bx * per;
        { const int h = (u0 >> 7) & 15;
          if (tid < 384) { const int idx = tid * 4, xi = idx >> 9, j = (idx >> 7) & 3, c = idx & 127;
              *(LAS f32x4*)((LAS float*)(lds + L_CW) + idx) = *(const f32x4*)(args.conv_w + (size_t)j * 6144 + xi * 2048 + h * 128 + c); } }
        for (int i = 0; i < per; ++i) { int u = u0 + i; asm volatile("" : "+s"(u));
            gdn_local_unit(u, args, lds, BQKV, BA, GWp, GKDTp, GATTp, GLp, GQGp, GUTp, tid, wave); }
        BG_WORK(0, -1);
    }
    SEAM(2);

    if (IN(3)) REP(3) {
        bf16_t* ODST = ODST_OF(3);
        if (bx < 128) {
            const int j = bx >> 3; gdn_scan((bx & 7) * 4 + (j >> 2), j & 3, lds, GWp, GKDTp, GUTp, GLp, GSTp, GVTp, tid, lane, wave);
        }
        {   LAS int* qslot = (LAS int*)(lds + DEC_OFF + 1024);
            for (;;) {
                if (tid == 0) *qslot = (int)__hip_atomic_fetch_add(ctl + CW_QUEUE + 256 * _rep, 1u, __ATOMIC_RELAXED, __HIP_MEMORY_SCOPE_AGENT);
                __syncthreads();
                const int u = *qslot;
                __syncthreads();
                if (u >= 512) break;
                swa_unit(u, args, lds, ACAT, ODST, KVA, tid, lane, wave);
            }
            for (;;) {
                if (tid == 0) *qslot = (int)__hip_atomic_fetch_add(ctl + CW_QUEUE + 64 + 256 * _rep, 1u, __ATOMIC_RELAXED, __HIP_MEMORY_SCOPE_AGENT);
                __syncthreads();
                const int u = *qslot;
                __syncthreads();
                if (u >= 256) break;
                mem_unit(u, lds, ACAT, ODST, MKV, tid, lane, wave);
            }
        }
        BG_WORK(0, 3);
    }
    SEAM(3);

    if (IN(4)) REP(4) {
        bf16_t* ODST = ODST_OF(4);
        { const int per = GDN_UNITS / G; gdn_out_units(bx * per, per, args, lds, ACAT, ODST, GQGp, GATTp, GSTp, GVTp, tid, lane, wave); }
        BG_WORK(BG_E0, -1);
    }
    SEAM(4);

    if (IN(5)) REP(5) {
        pg8::Gemm g{ACAT, Wbr_t, ACAT, Wbr_t, KCAT};
        pg8::StaticOrder S; S.init(M, DM, G, bx);
        pg8::EpiMerge E{GATES, YB};
        pg8::gemm_phase<pg8::EpiMerge, pg8::StaticOrder, true, GEMM_MODE>(lds, g, S, E);
        BG_WORK(BG_E1, -1);
    }
    SEAM(5);

    if (IN(6)) REP(6) {
        pg8::Gemm g{YB, Wo_t, YB, Wo_t, DM};
        pg8::StaticOrder S; S.init(M, DM, G, bx);
        pg8::EpiWo E{args.x, X1B, PART1};
        pg8::gemm_phase<pg8::EpiWo, pg8::StaticOrder, true, GEMM_MODE>(lds, g, S, E);
        BG_WORK(BG_E2, -1);
    }
    SEAM(6);

    if (IN(7)) REP(7) {
        pg8::Gemm g{X1B, Wf1_t, X1B, Wf1_t, DM};
        pg8::RsOrder S; S.init(M, 2 * DFF, G, bx); S.part = PART1; S.rs = (LAS float*)(lds + RS_OFF); S.cur_pm = -1;
        pg8::EpiFfnIn E{HID, (const LAS float*)(lds + RS_OFF)};
        pg8::gemm_phase<pg8::EpiFfnIn, pg8::RsOrder, true, GEMM_MODE>(lds, g, S, E);
        BG_WORK(BG_E3, -1);
    }
    SEAM(7);

    if (IN(8)) REP(8) {
        pg8::Gemm g{HID, Wf2_t, HID, Wf2_t, DFF};
        pg8::StaticOrder S; S.init(M, DM, G, bx);
        pg8::EpiFfnOut E{X1B, PART2};
        pg8::gemm_phase<pg8::EpiFfnOut, pg8::StaticOrder, true, GEMM_MODE>(lds, g, S, E);
    }
    SEAM(8);

    if (IN(9)) REP(9) {
        const int gw = vcu * 8 + wave, NGW = G * 8;
        for (int m = gw; m < M; m += NGW) {
            const float ss = wave_sum(PART2[(size_t)lane * M + m]);
            const float rstd = __builtin_amdgcn_rsqf(ss * (1.0f / DM) + EPS);
            const u32x4* xr = (const u32x4*)(X1B + (size_t)(m >> 7) * (DM / 64) * 8192 + (size_t)(m & 127) * 64 + (size_t)(lane >> 3) * 8192) + (lane & 7);
            f32x4* orow = (f32x4*)(args.out + (size_t)m * DM) + 2 * lane; const f32x4* gr = (const f32x4*)args.g_final + 2 * lane;
            u32x4 v[8];
#pragma unroll
            for (int j = 0; j < 8; ++j) v[j] = xr[(size_t)j * 8 * 8192 / 8];
#pragma unroll
            for (int j = 0; j < 8; ++j) { const f32x4 a = {bflo(v[j].x), bfhi(v[j].x), bflo(v[j].y), bfhi(v[j].y)}, b = {bflo(v[j].z), bfhi(v[j].z), bflo(v[j].w), bfhi(v[j].w)};
                orow[128 * j] = a * rstd * gr[128 * j]; orow[128 * j + 1] = b * rstd * gr[128 * j + 1]; }
        }
    }
#undef IN
#undef SEAM
}

extern "C" void kernel_launch(void* const* d_in, const int* in_sizes, int n_in, void* d_out, int out_size, void* d_ws, size_t ws_size, hipStream_t stream) {
    static int grid = 0;
    if (grid == 0) {
        if (n_in != 20 || in_sizes[0] != M * DM || out_size != M * DM || ws_size < WS_END) {
            fprintf(stderr, "kernel_launch: unexpected shapes (n_in %d, in0 %d, out %d, ws %zu < %zu): nothing launched\n", n_in, n_in > 0 ? in_sizes[0] : -1, out_size, ws_size, (size_t)WS_END); grid = -1; return; }
        if (hipFuncSetAttribute((const void*)hybrid_fwd, hipFuncAttributeMaxDynamicSharedMemorySize, LDS_BYTES) != hipSuccess) { fprintf(stderr, "kernel_launch: hipFuncSetAttribute failed\n"); grid = -1; return; }
        int per_cu = 0;
        if (hipOccupancyMaxActiveBlocksPerMultiprocessor(&per_cu, (const void*)hybrid_fwd, 512, LDS_BYTES) != hipSuccess || per_cu < 1)
            fprintf(stderr, "kernel_launch: note: occupancy query reports %d workgroups per CU\n", per_cu);
        (void)hipGetLastError();
        grid = 256;
    }
    if (grid < 0) return;
    if (hipMemsetAsync((char*)d_ws + WS_CTL, 0, CTL_ZERO_BYTES, stream) != hipSuccess) { fprintf(stderr, "kernel_launch: memset failed\n"); return; }
    Args a{};
    a.x = (const float*)d_in[0]; a.mem = (const float*)d_in[1]; a.rel_bias = (const float*)d_in[2]; a.g_mix = (const float*)d_in[3]; a.w_in = (const float*)d_in[4];
    a.conv_w = (const float*)d_in[5]; a.a_log = (const float*)d_in[6]; a.dt_bias = (const float*)d_in[7]; a.g_dn_out = (const float*)d_in[8]; a.sinks = (const float*)d_in[9];
    a.g_mem = (const float*)d_in[10]; a.w_mem_kv = (const float*)d_in[11]; a.w_br_a = (const float*)d_in[12]; a.w_br_b = (const float*)d_in[13]; a.w_br_m = (const float*)d_in[14];
    a.w_o = (const float*)d_in[15]; a.g_ffn = (const float*)d_in[16]; a.w_ffn_in = (const float*)d_in[17]; a.w_ffn_out = (const float*)d_in[18]; a.g_final = (const float*)d_in[19];
    a.out = (float*)d_out; a.ws = (unsigned char*)d_ws;
#if MK_ONE_LAUNCH
    a.ph_lo = 0; a.ph_hi = NPHASE;
    hipLaunchKernelGGL(hybrid_fwd, dim3(grid), dim3(512), LDS_BYTES, stream, a);
#else
    for (int p = 0; p < NPHASE; ++p) { a.ph_lo = p; a.ph_hi = p + 1; hipLaunchKernelGGL(hybrid_fwd, dim3(grid), dim3(512), LDS_BYTES, stream, a); }
#endif
    const hipError_t le = hipPeekAtLastError();
    if (le != hipSuccess) fprintf(stderr, "kernel_launch: launch failed: %s\n", hipGetErrorName(le));
}
```

```cpp
#include <hip/hip_runtime.h>
#include <cstdio>

#ifndef GEMM_MODE
#define GEMM_MODE 1
#endif
#ifndef MK_ONE_LAUNCH
#define MK_ONE_LAUNCH 1
#endif

#define LAS __attribute__((address_space(3)))
#define GAS __attribute__((address_space(1)))
typedef unsigned short bf16_t;
typedef short bf16x8 __attribute__((ext_vector_type(8)));
typedef float f32x4 __attribute__((ext_vector_type(4)));
typedef float f32x2 __attribute__((ext_vector_type(2)));
typedef unsigned u32x4 __attribute__((ext_vector_type(4)));
typedef unsigned u32x2 __attribute__((ext_vector_type(2)));

constexpr int DM = 4096, BATCH = 2, SEQ = 8192, M = BATCH * SEQ, MEMLEN = 256, MEMROWS = BATCH * MEMLEN;
constexpr int N_IN = 23584, NP_IN = 23808;
constexpr int DFF = 11008, KCAT = 4608;
constexpr int A_HEADS = 32, A_KVH = 4, A_HD = 64, WINDOW = 128;
constexpr int B_HEADS = 16, B_DK = 128;
constexpr int M_HEADS = 4, M_HD = 128;
constexpr float EPS = 1e-6f;

constexpr size_t MiB = 1u << 20;
constexpr size_t WS_CTL = 0, CTL_ZERO_BYTES = 1 * MiB;
constexpr size_t WS_WIN = 2 * MiB;
constexpr size_t WS_WKV = 188 * MiB;
constexpr size_t WS_WBR = 196 * MiB;
constexpr size_t WS_WO = 232 * MiB;
constexpr size_t WS_WF1 = 264 * MiB;
constexpr size_t WS_WF2 = 436 * MiB;
constexpr size_t WS_H = 522 * MiB;
constexpr size_t WS_ACAT = 650 * MiB;
constexpr size_t WS_KVA = 794 * MiB;
constexpr size_t WS_BQKV = 810 * MiB;
constexpr size_t WS_GATES = 1002 * MiB;
constexpr size_t WS_BA = 1386 * MiB;
constexpr size_t WS_MEMN = 1388 * MiB;
constexpr size_t WS_MKV = 1392 * MiB;
constexpr size_t WS_PART1 = 1393 * MiB;
constexpr size_t WS_PART2 = 1397 * MiB;
constexpr size_t WS_END = 1401 * MiB;
constexpr size_t WS_H2 = WS_BQKV;
constexpr size_t WS_HID = WS_GATES;
constexpr size_t WS_GW = WS_WIN, WS_GKDT = 66 * MiB, WS_GATT = 130 * MiB, WS_GL = 162 * MiB, WS_GQG = WS_H, WS_GUT = 586 * MiB, WS_GST = WS_BQKV, WS_GVT = 938 * MiB;
constexpr int CW_TMO = 0, CW_CODE = 1, CW_QUEUE = 64, CW_DONE = 1024, CW_BGHEAD = 2048, CW_BAR = 4096;

constexpr int RING_BYTES = 147456;
constexpr int DEC_OFF = RING_BYTES;
constexpr int RS_OFF = 159744;
constexpr int MISC_OFF = 161792;
constexpr int LDS_BYTES = 163840;

__device__ __forceinline__ unsigned f2bf(float f) { unsigned u = __builtin_bit_cast(unsigned, f); return (u + 0x7fffu + ((u >> 16) & 1u)) >> 16; }
__device__ __forceinline__ float bf2f(unsigned short b) { return __builtin_bit_cast(float, (unsigned)b << 16); }
__device__ __forceinline__ float bflo(unsigned w) { return __builtin_bit_cast(float, w << 16); }
__device__ __forceinline__ float bfhi(unsigned w) { return __builtin_bit_cast(float, w & 0xffff0000u); }
typedef __bf16 bf16x2_t __attribute__((ext_vector_type(2)));
__device__ __forceinline__ unsigned cvt_pk_bf16(float lo, float hi) { const f32x2 v = {lo, hi}; const bf16x2_t b = __builtin_convertvector(v, bf16x2_t); return __builtin_bit_cast(unsigned, b); }
__device__ __forceinline__ unsigned pk2(float lo, float hi) { return cvt_pk_bf16(lo, hi); }
__device__ __forceinline__ float sigmoidf_(float x) { return __builtin_amdgcn_rcpf(1.0f + __expf(-x)); }
__device__ __forceinline__ float siluf_(float x) { return x * __builtin_amdgcn_rcpf(1.0f + __expf(-x)); }
__host__ __device__ __forceinline__ size_t tiled_off(int row, int col, int ktiles) { return ((size_t)(row >> 7) * ktiles + (size_t)(col >> 6)) * 8192 + (size_t)((row & 127) * 64 + (col & 63)); }
__device__ __forceinline__ float wave_sum(float v) {
#pragma unroll
    for (int o = 1; o < 64; o <<= 1) v += __shfl_xor(v, o);
    return v;
}

namespace pg8 {
constexpr int BM = 256, BK = 64, HALF = 128, HTB = HALF * BK * 2, STAGE_BYTES = 8 * HTB, NXCD = 8, WGM = 8;
__host__ __device__ __forceinline__ int lds_byte(int r, int c) { const int st = (r >> 4) * 2 + (c >> 5), rr = r & 15, cc = c & 31, ob = rr * 64 + cc * 2; return st * 1024 + (ob ^ (((ob >> 9) & 1) << 5)); }
__host__ __device__ __forceinline__ void stage_rc(int b, int& R, int& C) { const int st = b / 1024, sb = b % 1024, swz = sb ^ (((sb >> 9) & 1) << 5); R = (st >> 1) * 16 + swz / 64; C = (st & 1) * 32 + (swz % 64) / 2; }
__host__ __device__ __forceinline__ int perm32(int rho) { const int n = rho >> 4, i = rho & 15; return 8 * (i >> 2) + 4 * n + (i & 3); }

struct Unit { int pm, pn, sel; };
struct Gemm { const bf16_t* A; const bf16_t* Bt; const bf16_t* A2; const bf16_t* B2; int K; };

struct StaticOrder {
    int nM, nN, nwg, G, c, nextra, exN;
    __device__ void init(int M_, int N_, int G_, int c_, int nextra_ = 0, int exN_ = 1) { nM = M_ / BM; nN = N_ / BM; nwg = nM * nN; G = G_; c = c_; nextra = nextra_; exN = exN_; }
    __device__ bool next(int i, Unit& u) const {
        const long L = (long)i * G + c; if (L >= nwg + nextra) return false;
        if (L >= nwg) { const int e = (int)(L - nwg); u.pm = e / exN; u.pn = e % exN; u.sel = 1; return true; }
        int wgid = (int)L; { const int q = nwg / NXCD, r = nwg % NXCD, xcd = wgid % NXCD, off = wgid / NXCD; wgid = (xcd < r ? xcd * (q + 1) : r * (q + 1) + (xcd - r) * q) + off; }
        const int nig = WGM * nN, gid = wgid / nig, fm = gid * WGM, gsz = (nM - fm) < WGM ? (nM - fm) : WGM;
        u.pm = fm + ((wgid % nig) % gsz); u.pn = (wgid % nig) / gsz; u.sel = 0; return true;
    }
    __device__ __forceinline__ void a_ready(const Unit&) {}
    __device__ __forceinline__ void done(const Unit&) {}
};

template <class Epi, class Sched, bool ALIGN_EPI, int SP2>
__device__ __forceinline__ void gemm_phase(LAS unsigned char* lds, const Gemm g, Sched& S, Epi& E) {
    const int tid = threadIdx.x, wid = __builtin_amdgcn_readfirstlane(tid >> 6), lane = tid & 63, wr = wid >> 2, wc = wid & 3, fr = lane & 15, fq = lane >> 4;
    const int K = g.K, nt = K / BK;
    unsigned voffA[2], voffB[2];
#pragma unroll
    for (int i = 0; i < 2; ++i) { int R, C; stage_rc(tid * 16 + i * 8192, R, C); const int Rb = Epi::PERM ? ((R & ~31) + perm32(R & 31)) : R;
        voffA[i] = (unsigned)(R * 64 + C) * 2u; voffB[i] = (unsigned)(Rb * 64 + C) * 2u; }
    const size_t kstep = (size_t)HTB;
    const size_t hstepA = (size_t)nt * HTB, hstepB = hstepA;
    const unsigned ldsw = (unsigned)wid * 1024u;
    const int aoff = lds_byte(wr * 64 + fr, fq * 8), boff = lds_byte(wc * 32 + fr, fq * 8);
#define PG8_SA(b, h) (((b) * 2 + (h)) * HTB)
#define PG8_SB(b, h) ((4 + (b) * 2 + (h)) * HTB)
#define PG8_STAGE(bufoff, gbase, voff) do { _Pragma("unroll") for (int _i = 0; _i < 2; ++_i) \
        __builtin_amdgcn_global_load_lds((const unsigned*)((const char*)(gbase) + (voff)[_i]), (LAS unsigned*)(lds + (bufoff) + ldsw + _i * 8192), 16, 0, 0); } while (0)
#define PG8_LDA(dst, b, h) do { _Pragma("unroll") for (int m = 0; m < 4; ++m) _Pragma("unroll") for (int k = 0; k < 2; ++k) dst[m][k] = *(const LAS bf16x8*)(lds + PG8_SA(b, h) + aoff + m * 2048 + k * 1024); } while (0)
#define PG8_LDB(dst, b, h) do { _Pragma("unroll") for (int n = 0; n < 2; ++n) _Pragma("unroll") for (int k = 0; k < 2; ++k) dst[n][k] = *(const LAS bf16x8*)(lds + PG8_SB(b, h) + boff + n * 2048 + k * 1024); } while (0)
#define PG8_MMA(ai, bj, At, Bt) do { __builtin_amdgcn_s_setprio(1); _Pragma("unroll") for (int m = 0; m < 4; ++m) _Pragma("unroll") for (int n = 0; n < 2; ++n) _Pragma("unroll") for (int k = 0; k < 2; ++k) \
        acc[ai][bj][m][n] = __builtin_amdgcn_mfma_f32_16x16x32_bf16(Bt[n][k], At[m][k], acc[ai][bj][m][n], 0, 0, 0); __builtin_amdgcn_s_setprio(0); } while (0)
#define PG8_WAIT_V(n) asm volatile("s_waitcnt vmcnt(" #n ")" ::: "memory")
#define PG8_WAIT_L(n) asm volatile("s_waitcnt lgkmcnt(" #n ")" ::: "memory")
#define PG8_BAR __builtin_amdgcn_s_barrier()
#define PG8_SCHED __builtin_amdgcn_sched_barrier(0)
#define PG8_ATILE(u) ((const char*)((u).sel ? g.A2 : g.A) + (size_t)(u).pm * 2 * hstepA)
#define PG8_BTILE(u) ((const char*)((u).sel ? g.B2 : g.Bt) + (size_t)(u).pn * 2 * hstepB)
    Unit cur, nxt; int ui = 0;
    if (!S.next(0, cur)) return;
    f32x4 acc[2][2][4][2];
#pragma unroll
    for (int a = 0; a < 2; ++a)
#pragma unroll
        for (int b = 0; b < 2; ++b)
#pragma unroll
            for (int m = 0; m < 4; ++m)
#pragma unroll
                for (int n = 0; n < 2; ++n) acc[a][b][m][n] = (f32x4){0.f, 0.f, 0.f, 0.f};
    bf16x8 At[4][2], B0[2][2], B1[2][2];
    const char* cA = PG8_ATILE(cur); const char* cB = PG8_BTILE(cur);
    S.a_ready(cur);
    if constexpr (SP2 != 0) {
        PG8_STAGE(PG8_SB(0, 0), cB, voffB); PG8_STAGE(PG8_SB(0, 1), cB + hstepB, voffB); PG8_STAGE(PG8_SA(0, 0), cA, voffA); PG8_STAGE(PG8_SA(0, 1), cA + hstepA, voffA);
        if (wr == 1) PG8_BAR;
        PG8_WAIT_V(2); PG8_BAR;
        PG8_STAGE(PG8_SB(1, 0), cB + kstep, voffB); PG8_STAGE(PG8_SA(1, 0), cA + kstep, voffA); PG8_STAGE(PG8_SB(1, 1), cB + hstepB + kstep, voffB);
        PG8_WAIT_V(6); PG8_BAR;
    } else {
        PG8_STAGE(PG8_SB(0, 0), cB, voffB); PG8_STAGE(PG8_SA(0, 0), cA, voffA); PG8_STAGE(PG8_SB(0, 1), cB + hstepB, voffB); PG8_STAGE(PG8_SA(0, 1), cA + hstepA, voffA);
        if (wr == 1) PG8_BAR;
        PG8_WAIT_V(4); PG8_BAR;
        PG8_STAGE(PG8_SB(1, 0), cB + kstep, voffB); PG8_STAGE(PG8_SA(1, 0), cA + kstep, voffA); PG8_STAGE(PG8_SB(1, 1), cB + hstepB + kstep, voffB);
        PG8_WAIT_V(6); PG8_BAR;
    }
    for (;;) {
        const bool has_next = S.next(ui + 1, nxt);
        const char* nA = has_next ? PG8_ATILE(nxt) : cA; const char* nB = has_next ? PG8_BTILE(nxt) : cB;
        for (int t = 0; t < nt; t += 2) {
            const bool last = (t == nt - 2);
            const char* a1 = cA + (size_t)(t + 1) * kstep;
            const char* a2 = last ? nA : cA + (size_t)(t + 2) * kstep; const char* b2 = last ? nB : cB + (size_t)(t + 2) * kstep;
            const char* a3 = a2 + kstep; const char* b3 = b2 + kstep;
            if (last && has_next) S.a_ready(nxt);
            if constexpr (Epi::HOOK) { if (t == Epi::H1 || t == Epi::H2) E.hook(acc, cur, t, wr, wc, fr, fq); }
            if constexpr (SP2 == 2) {
            PG8_LDB(B0, 0, 0); PG8_LDB(B1, 0, 1); PG8_SCHED; PG8_LDA(At, 0, 0);
            PG8_WAIT_V(6); PG8_WAIT_L(0); PG8_BAR; PG8_MMA(0, 0, At, B0); PG8_STAGE(PG8_SA(1, 1), a1 + hstepA, voffA); PG8_MMA(0, 1, At, B1); PG8_BAR; PG8_SCHED;
            PG8_LDA(At, 0, 1);
            PG8_WAIT_V(2); PG8_WAIT_L(0); PG8_BAR; PG8_MMA(1, 0, At, B0); PG8_STAGE(PG8_SB(0, 0), b2, voffB); PG8_STAGE(PG8_SB(0, 1), b2 + hstepB, voffB); PG8_STAGE(PG8_SA(0, 0), a2, voffA); PG8_MMA(1, 1, At, B1); PG8_BAR; PG8_SCHED;
            PG8_LDB(B0, 1, 0); PG8_LDB(B1, 1, 1); PG8_SCHED; PG8_LDA(At, 1, 0);
            PG8_WAIT_V(6); PG8_WAIT_L(0); PG8_BAR; PG8_MMA(0, 0, At, B0); PG8_STAGE(PG8_SA(0, 1), a2 + hstepA, voffA); PG8_MMA(0, 1, At, B1); PG8_BAR; PG8_SCHED;
            PG8_LDA(At, 1, 1);
            PG8_WAIT_V(2); PG8_WAIT_L(0); PG8_BAR; PG8_MMA(1, 0, At, B0); PG8_STAGE(PG8_SB(1, 0), b3, voffB); PG8_STAGE(PG8_SB(1, 1), b3 + hstepB, voffB); PG8_STAGE(PG8_SA(1, 0), a3, voffA); PG8_MMA(1, 1, At, B1); PG8_BAR; PG8_SCHED;
            } else if constexpr (SP2 == 1) {
            PG8_LDB(B0, 0, 0); PG8_LDB(B1, 0, 1); PG8_SCHED; PG8_LDA(At, 0, 0); PG8_STAGE(PG8_SA(1, 1), a1 + hstepA, voffA);
            PG8_WAIT_V(8); PG8_WAIT_L(0); PG8_BAR; PG8_MMA(0, 0, At, B0); PG8_MMA(0, 1, At, B1); PG8_BAR; PG8_SCHED;
            PG8_LDA(At, 0, 1); PG8_STAGE(PG8_SB(0, 0), b2, voffB); PG8_STAGE(PG8_SB(0, 1), b2 + hstepB, voffB); PG8_STAGE(PG8_SA(0, 0), a2, voffA);
            PG8_WAIT_V(8); PG8_WAIT_L(0); PG8_BAR; PG8_MMA(1, 0, At, B0); PG8_MMA(1, 1, At, B1); PG8_BAR; PG8_SCHED;
            PG8_LDB(B0, 1, 0); PG8_LDB(B1, 1, 1); PG8_SCHED; PG8_LDA(At, 1, 0); PG8_STAGE(PG8_SA(0, 1), a2 + hstepA, voffA);
            PG8_WAIT_V(8); PG8_WAIT_L(0); PG8_BAR; PG8_MMA(0, 0, At, B0); PG8_MMA(0, 1, At, B1); PG8_BAR; PG8_SCHED;
            PG8_LDA(At, 1, 1); PG8_STAGE(PG8_SB(1, 0), b3, voffB); PG8_STAGE(PG8_SB(1, 1), b3 + hstepB, voffB); PG8_STAGE(PG8_SA(1, 0), a3, voffA);
            PG8_WAIT_V(8); PG8_WAIT_L(0); PG8_BAR; PG8_MMA(1, 0, At, B0); PG8_MMA(1, 1, At, B1); PG8_BAR; PG8_SCHED;
            } else {
            PG8_LDB(B0, 0, 0); PG8_SCHED; PG8_LDA(At, 0, 0); PG8_STAGE(PG8_SA(1, 1), a1 + hstepA, voffA);
            PG8_WAIT_L(8); PG8_BAR; PG8_WAIT_L(0); PG8_MMA(0, 0, At, B0); PG8_BAR; PG8_SCHED;
            PG8_LDB(B1, 0, 1); PG8_STAGE(PG8_SB(0, 0), b2, voffB);
            PG8_BAR; PG8_WAIT_L(0); PG8_MMA(0, 1, At, B1); PG8_BAR;
            PG8_LDA(At, 0, 1); PG8_STAGE(PG8_SA(0, 0), a2, voffA);
            PG8_BAR; PG8_WAIT_L(0); PG8_MMA(1, 0, At, B0); PG8_BAR; PG8_SCHED;
            PG8_STAGE(PG8_SB(0, 1), b2 + hstepB, voffB);
            PG8_WAIT_V(6); PG8_BAR; PG8_MMA(1, 1, At, B1); PG8_BAR;
            PG8_LDB(B0, 1, 0); PG8_SCHED; PG8_LDA(At, 1, 0); PG8_STAGE(PG8_SA(0, 1), a2 + hstepA, voffA);
            PG8_WAIT_L(8); PG8_BAR; PG8_WAIT_L(0); PG8_MMA(0, 0, At, B0); PG8_BAR; PG8_SCHED;
            PG8_LDB(B1, 1, 1); PG8_STAGE(PG8_SB(1, 0), b3, voffB);
            PG8_BAR; PG8_WAIT_L(0); PG8_MMA(0, 1, At, B1); PG8_BAR;
            PG8_LDA(At, 1, 1); PG8_STAGE(PG8_SA(1, 0), a3, voffA);
            PG8_BAR; PG8_WAIT_L(0); PG8_MMA(1, 0, At, B0); PG8_BAR; PG8_SCHED;
            PG8_STAGE(PG8_SB(1, 1), b3 + hstepB, voffB);
            PG8_WAIT_V(6); PG8_BAR; PG8_MMA(1, 1, At, B1); PG8_BAR;
            }
        }
        if constexpr (ALIGN_EPI) { if (wr == 0) PG8_BAR; }
        E(acc, cur, wr, wc, fr, fq); S.done(cur);
        if (!has_next) break;
#pragma unroll
        for (int a = 0; a < 2; ++a)
#pragma unroll
            for (int b = 0; b < 2; ++b)
#pragma unroll
                for (int m = 0; m < 4; ++m)
#pragma unroll
                    for (int n = 0; n < 2; ++n) acc[a][b][m][n] = (f32x4){0.f, 0.f, 0.f, 0.f};
        cur = nxt; cA = nA; cB = nB; ++ui;
        if constexpr (ALIGN_EPI) { if (wr == 1) PG8_BAR; }
    }
    PG8_WAIT_V(0);
    if constexpr (!ALIGN_EPI) { if (wr == 0) PG8_BAR; }
    PG8_BAR;
#undef PG8_SA
#undef PG8_SB
#undef PG8_STAGE
#undef PG8_LDA
#undef PG8_LDB
#undef PG8_MMA
#undef PG8_WAIT_V
#undef PG8_WAIT_L
#undef PG8_BAR
#undef PG8_SCHED
#undef PG8_ATILE
#undef PG8_BTILE
}

__device__ __forceinline__ size_t gate_frag_off(int g, int pm, int pn, int s, int tid) { return ((((size_t)(g * 64 + pm) * 16 + pn) * 16 + s) * 512 + tid) * 8; }
__device__ __forceinline__ unsigned gate_q4(const f32x4 v) {
    unsigned r = 0;
#pragma unroll
    for (int j = 0; j < 4; ++j) { const float s = __builtin_amdgcn_rcpf(1.0f + __expf(-v[j])); const float q = fminf(fmaxf(s * 255.0f + 0.5f, 1.0f), 255.0f); r |= (unsigned)q << (8 * j); }
    return r;
}
__device__ __forceinline__ float gate_b(unsigned w, int k) { return (float)((w >> (8 * k)) & 0xffu); }
struct EpiInProj {
    static constexpr bool PERM = true, HOOK = false; static constexpr int H1 = -1, H2 = -1;
    bf16_t* acat; bf16_t* kva; bf16_t* bqkv; bf16_t* gates; float* ba; bf16_t* mkv; const LAS float* rstd;
    __device__ __forceinline__ void hook(f32x4 (&)[2][2][4][2], const Unit&, int, int, int, int, int) {}
    __device__ __forceinline__ void operator()(const f32x4 (&acc)[2][2][4][2], const Unit& u, int wr, int wc, int fr, int fq) const {
        const int row0 = u.pm * BM + wr * 64 + fr;
        float rs[2][4];
#pragma unroll
        for (int ai = 0; ai < 2; ++ai)
#pragma unroll
            for (int m = 0; m < 4; ++m) rs[ai][m] = u.sel ? 1.0f : rstd[wr * 64 + fr + ai * HALF + m * 16];
        bf16_t* base; int ldc, colt; const int pn = u.pn;
        if (u.sel) { base = mkv; ldc = 1024; colt = pn * 256; }
        else if (pn < 8) { base = acat; ldc = KCAT; colt = pn * 256; }
        else if (pn < 10) { base = kva; ldc = 512; colt = (pn - 8) * 256; }
        else if (pn < 34) { base = bqkv; ldc = 6144; colt = (pn - 10) * 256; }
        else if (pn < 42) { base = acat; ldc = KCAT; colt = 2048 + (pn - 34) * 256; }
        else if (pn < 44) { base = acat; ldc = KCAT; colt = 4096 + (pn - 42) * 256; }
        else if (pn < 92) { base = gates; ldc = 12288; colt = (pn - 44) * 256; }
        else {
            if (wc == 0) {
#pragma unroll
                for (int ai = 0; ai < 2; ++ai)
#pragma unroll
                    for (int m = 0; m < 4; ++m) { float* rowp = ba + (size_t)(row0 + ai * HALF + m * 16) * 32 + 8 * fq;
                        *(f32x4*)(rowp) = acc[ai][0][m][0] * rs[ai][m]; *(f32x4*)(rowp + 4) = acc[ai][0][m][1] * rs[ai][m]; }
            }
            return;
        }
        const int col0 = colt + wc * 32 + 8 * fq; const bool tiled = (base == acat), isgate = (base == gates);
#pragma unroll
        for (int ai = 0; ai < 2; ++ai)
#pragma unroll
            for (int m = 0; m < 4; ++m) { const int r = row0 + ai * HALF + m * 16;
#pragma unroll
                for (int bj = 0; bj < 2; ++bj) { f32x4 v0 = acc[ai][bj][m][0] * rs[ai][m], v1 = acc[ai][bj][m][1] * rs[ai][m];
                    if (isgate) {
                        u32x2 wq; wq.x = gate_q4(v0); wq.y = gate_q4(v1);
                        *(u32x2*)((unsigned char*)base + gate_frag_off((pn - 44) >> 4, u.pm, (pn - 44) & 15, (ai * 4 + m) * 2 + bj, (wr * 4 + wc) * 64 + fq * 16 + fr)) = wq;
                        continue; }
                    u32x4 w; w.x = cvt_pk_bf16(v0[0], v0[1]); w.y = cvt_pk_bf16(v0[2], v0[3]); w.z = cvt_pk_bf16(v1[0], v1[1]); w.w = cvt_pk_bf16(v1[2], v1[3]);
                    bf16_t* p = tiled ? base + tiled_off(r, col0 + bj * HALF, KCAT / 64) : base + (size_t)r * ldc + col0 + bj * HALF;
                    *(u32x4*)p = w; } }
    }
};

struct EpiMerge {
    static constexpr bool PERM = true, HOOK = true; static constexpr int H1 = 32, H2 = 64;
    const bf16_t* gates; bf16_t* y;
    __device__ __forceinline__ void hook(f32x4 (&acc)[2][2][4][2], const Unit& u, int t, int wr, int wc, int fr, int fq) const {
        const int gsel = (t == H1) ? 0 : 1; const int tid_ = (wr * 4 + wc) * 64 + fq * 16 + fr;
        const unsigned char* gpb = (const unsigned char*)gates + gate_frag_off(gsel, u.pm, u.pn, 0, tid_); const unsigned char* gnb = (const unsigned char*)gates + gate_frag_off(gsel + 1, u.pm, u.pn, 0, tid_);
        u32x2 gp[16], gn[16];
#pragma unroll
        for (int sl = 0; sl < 16; ++sl) { gp[sl] = *(const u32x2*)(gpb + (size_t)sl * 4096); gn[sl] = *(const u32x2*)(gnb + (size_t)sl * 4096); }
        asm volatile("" ::: "memory");
#pragma unroll
        for (int sl = 0; sl < 16; ++sl) { const int ai = sl >> 3, m = (sl >> 1) & 3, bj = sl & 1;
#pragma unroll
            for (int n = 0; n < 2; ++n) { const unsigned wp = n ? gp[sl].y : gp[sl].x, wn = n ? gn[sl].y : gn[sl].x;
#pragma unroll
                for (int k = 0; k < 4; ++k) acc[ai][bj][m][n][k] *= gate_b(wp, k) * __builtin_amdgcn_rcpf(gate_b(wn, k)); } }
        asm volatile("" ::: "memory");
    }
    __device__ __forceinline__ void operator()(const f32x4 (&acc)[2][2][4][2], const Unit& u, int wr, int wc, int fr, int fq) const {
        const int row0 = u.pm * BM + wr * 64 + fr, col0 = u.pn * BM + wc * 32 + 8 * fq;
        const unsigned char* gmb = (const unsigned char*)gates + gate_frag_off(2, u.pm, u.pn, 0, (wr * 4 + wc) * 64 + fq * 16 + fr);
        u32x2 gm[16];
#pragma unroll
        for (int sl = 0; sl < 16; ++sl) gm[sl] = *(const u32x2*)(gmb + (size_t)sl * 4096);
        asm volatile("" ::: "memory");
#pragma unroll
        for (int sl = 0; sl < 16; ++sl) { const int ai = sl >> 3, m = (sl >> 1) & 3, bj = sl & 1; const size_t r = (size_t)(row0 + ai * HALF + m * 16); float o[8];
#pragma unroll
            for (int k = 0; k < 4; ++k) { o[k] = acc[ai][bj][m][0][k] * (gate_b(gm[sl].x, k) * (1.0f / 255.0f)); o[4 + k] = acc[ai][bj][m][1][k] * (gate_b(gm[sl].y, k) * (1.0f / 255.0f)); }
            u32x4 w; w.x = cvt_pk_bf16(o[0], o[1]); w.y = cvt_pk_bf16(o[2], o[3]); w.z = cvt_pk_bf16(o[4], o[5]); w.w = cvt_pk_bf16(o[6], o[7]);
            *(u32x4*)(y + tiled_off((int)r, col0 + bj * HALF, DM / 64)) = w; }
    }
};

struct RsOrder1 : StaticOrder {
    const float* rstd0; LAS float* rs; int cur_pm;
    __device__ __forceinline__ void a_ready(const Unit& u) {
        if (u.sel || u.pm == cur_pm) return;
        cur_pm = u.pm;
        const int tid = threadIdx.x;
        if (tid < 256) rs[tid] = rstd0[(size_t)u.pm * BM + tid];
        asm volatile("s_waitcnt vmcnt(0) lgkmcnt(0)" ::: "memory");
    }
};

struct EpiWo {
    static constexpr bool PERM = true, HOOK = false; static constexpr int H1 = -1, H2 = -1;
    const bf16_t* xb; bf16_t* x1b; float* part;
    __device__ __forceinline__ void hook(f32x4 (&)[2][2][4][2], const Unit&, int, int, int, int, int) {}
    __device__ __forceinline__ void operator()(const f32x4 (&acc)[2][2][4][2], const Unit& u, int wr, int wc, int fr, int fq) const {
        const int row0 = u.pm * BM + wr * 64 + fr, col0 = u.pn * BM + wc * 32 + 8 * fq;
#pragma unroll
        for (int ai = 0; ai < 2; ++ai) {
            {
            u32x4 xv[4][2];
#pragma unroll
            for (int m2 = 0; m2 < 4; ++m2)
#pragma unroll
                for (int bj = 0; bj < 2; ++bj) xv[m2][bj] = *(const u32x4*)(xb + tiled_off(row0 + ai * HALF + m2 * 16, col0 + bj * HALF, DM / 64));
            asm volatile("" ::: "memory");
#pragma unroll
            for (int m2 = 0; m2 < 4; ++m2) { const int m = m2; const int r = row0 + ai * HALF + m * 16; float s = 0.f;
#pragma unroll
                for (int bj = 0; bj < 2; ++bj) { u32x4 wx;
#pragma unroll
                    for (int n = 0; n < 2; ++n) { const unsigned w0 = xv[m2][bj][2 * n], w1 = xv[m2][bj][2 * n + 1];
                        const f32x4 xr = {bflo(w0), bfhi(w0), bflo(w1), bfhi(w1)}; const f32x4 x1 = xr + acc[ai][bj][m][n];
                        s += (x1[0] * x1[0] + x1[1] * x1[1]) + (x1[2] * x1[2] + x1[3] * x1[3]);
                        wx[2 * n] = cvt_pk_bf16(x1[0], x1[1]); wx[2 * n + 1] = cvt_pk_bf16(x1[2], x1[3]); }
                    *(u32x4*)(x1b + tiled_off(r, col0 + bj * HALF, DM / 64)) = wx; }
                s += __shfl_xor(s, 16); s += __shfl_xor(s, 32);
                if (fq == 0) part[(size_t)(u.pn * 4 + wc) * M + r] = s; }
            asm volatile("" ::: "memory");
            }
        }
    }
};

struct EpiFfnIn {
    static constexpr bool PERM = true, HOOK = false; static constexpr int H1 = -1, H2 = -1;
    bf16_t* hid; const LAS float* rs;
    __device__ __forceinline__ void hook(f32x4 (&)[2][2][4][2], const Unit&, int, int, int, int, int) {}
    __device__ __forceinline__ void operator()(const f32x4 (&acc)[2][2][4][2], const Unit& u, int wr, int wc, int fr, int fq) const {
        const int rl0 = wr * 64 + fr, col0 = u.pn * HALF + wc * 32 + 8 * fq;
#pragma unroll
        for (int ai = 0; ai < 2; ++ai)
#pragma unroll
            for (int m = 0; m < 4; ++m) { const int rl = rl0 + ai * HALF + m * 16; const float sc = rs[rl]; float o[8];
#pragma unroll
                for (int n = 0; n < 2; ++n)
#pragma unroll
                    for (int j = 0; j < 4; ++j) { const float gt = acc[ai][0][m][n][j] * sc, up = acc[ai][1][m][n][j] * sc; o[4 * n + j] = siluf_(gt) * up; }
                u32x4 w; w.x = cvt_pk_bf16(o[0], o[1]); w.y = cvt_pk_bf16(o[2], o[3]); w.z = cvt_pk_bf16(o[4], o[5]); w.w = cvt_pk_bf16(o[6], o[7]);
                *(u32x4*)(hid + tiled_off(u.pm * BM + rl, col0, DFF / 64)) = w;
                asm volatile("" ::: "memory"); }
    }
};
struct RsOrder : StaticOrder {
    const float* part; LAS float* rs; int cur_pm;
    __device__ __forceinline__ void a_ready(const Unit& u) {
        if (u.pm == cur_pm) return;
        cur_pm = u.pm;
        const int tid = threadIdx.x, row = tid >> 1, hf = tid & 1; float s = 0.f;
        const float* p = part + (size_t)(hf * 32) * M + (size_t)u.pm * BM + row;
#pragma unroll 8
        for (int j = 0; j < 32; ++j) s += p[(size_t)j * M];
        s += __shfl_xor(s, 1);
        if (hf == 0) rs[row] = 1.0f / sqrtf(s * (1.0f / DM) + EPS);
        asm volatile("s_waitcnt lgkmcnt(0)" ::: "memory");
    }
};

struct EpiFfnOut {
    static constexpr bool PERM = true, HOOK = false; static constexpr int H1 = -1, H2 = -1;
    bf16_t* x1b; float* part;
    __device__ __forceinline__ void hook(f32x4 (&)[2][2][4][2], const Unit&, int, int, int, int, int) {}
    __device__ __forceinline__ void operator()(const f32x4 (&acc)[2][2][4][2], const Unit& u, int wr, int wc, int fr, int fq) const {
        const int row0 = u.pm * BM + wr * 64 + fr, col0 = u.pn * BM + wc * 32 + 8 * fq;
#pragma unroll
        for (int ai = 0; ai < 2; ++ai) {
            u32x4 xv[4][2];
#pragma unroll
            for (int m = 0; m < 4; ++m)
#pragma unroll
                for (int bj = 0; bj < 2; ++bj) xv[m][bj] = *(const u32x4*)(x1b + tiled_off(row0 + ai * HALF + m * 16, col0 + bj * HALF, DM / 64));
            asm volatile("" ::: "memory");
#pragma unroll
            for (int m = 0; m < 4; ++m) { const int r = row0 + ai * HALF + m * 16; float s = 0.f;
#pragma unroll
                for (int bj = 0; bj < 2; ++bj) { u32x4 wx;
#pragma unroll
                    for (int n = 0; n < 2; ++n) { const unsigned w0 = xv[m][bj][2 * n], w1 = xv[m][bj][2 * n + 1];
                        const f32x4 x1 = {bflo(w0), bfhi(w0), bflo(w1), bfhi(w1)}; const f32x4 x2 = x1 + acc[ai][bj][m][n];
                        s += (x2[0] * x2[0] + x2[1] * x2[1]) + (x2[2] * x2[2] + x2[3] * x2[3]);
                        wx[2 * n] = cvt_pk_bf16(x2[0], x2[1]); wx[2 * n + 1] = cvt_pk_bf16(x2[2], x2[3]); }
                    *(u32x4*)(x1b + tiled_off(r, col0 + bj * HALF, DM / 64)) = wx; }
                s += __shfl_xor(s, 16); s += __shfl_xor(s, 32);
                if (fq == 0) part[(size_t)(u.pn * 4 + wc) * M + r] = s; }
            asm volatile("" ::: "memory");
        }
    }
};
}

#define XB_TMO      128
#define XB_XCNT(j)  (256  + 64 * (j))
#define XB_XSUB(j)  (1280 + 64 * (j))
#define XB_XGEN(j)  (2304 + 64 * (j))
#define XB_TOP      3328
#define XB_TOPGEN   3392
#define XCD_BAR_WORDS 3456
#define XB_SPIN_CAP (1u << 18)
__device__ __forceinline__ unsigned xb_ld(unsigned* p)              { return __hip_atomic_load(p, __ATOMIC_RELAXED, __HIP_MEMORY_SCOPE_AGENT); }
__device__ __forceinline__ unsigned xb_add(unsigned* p, unsigned v) { return __hip_atomic_fetch_add(p, v, __ATOMIC_RELAXED, __HIP_MEMORY_SCOPE_AGENT); }
__device__ __forceinline__ unsigned xb_xcc_id() { return (unsigned)__builtin_amdgcn_s_getreg((3 << 11) | 20) & 0xFu; }
#define XB_SPIN(cond, bar) do { unsigned _sp = 0; while (cond) { __builtin_amdgcn_s_sleep(1); \
    if ((++_sp & 255u) == 0u) { if (xb_ld(&(bar)[XB_TMO])) break; if (_sp > XB_SPIN_CAP) { atomicAdd(&(bar)[XB_TMO], 1u); break; } } } } while (0)
struct XcdBarrier { unsigned* bar; unsigned x; volatile LAS unsigned* st; };
__device__ __forceinline__ XcdBarrier xcd_barrier_post(unsigned* bar, volatile LAS unsigned* st) {
    XcdBarrier b; b.bar = bar; b.x = xb_xcc_id(); b.st = st;
    if (threadIdx.x == 0) (void)xb_add(&bar[XB_XCNT(b.x)], 1u);
    return b;
}
__device__ __forceinline__ void xcd_barrier_complete(unsigned* bar, unsigned x, unsigned& nloc, unsigned& nx) {
    const unsigned G = gridDim.x * gridDim.y * gridDim.z;
    unsigned sum, cnt, mine, sp = 0u;
    for (;;) {
        sum = 0u; cnt = 0u; mine = 0u;
#pragma unroll
        for (unsigned j = 0; j < 16; ++j) { const unsigned c = xb_ld(&bar[XB_XCNT(j)]); sum += c; cnt += (c > 0u) ? 1u : 0u; mine = (j == x) ? c : mine; }
        if (sum == G) break;
        __builtin_amdgcn_s_sleep(1);
        if ((++sp & 255u) == 0u) { if (xb_ld(&bar[XB_TMO])) break; if (sp > XB_SPIN_CAP) { atomicAdd(&bar[XB_TMO], 1u); break; } }
    }
    nloc = mine > 0u ? mine : 1u; nx = cnt > 0u ? cnt : 1u;
}
__device__ __forceinline__ void xcd_barrier(const XcdBarrier& b) {
    asm volatile("s_waitcnt vmcnt(0)" ::: "memory");
    __syncthreads();
    if (threadIdx.x == 0) {
        unsigned* bar = b.bar;
        __builtin_amdgcn_s_waitcnt(0);
        unsigned nloc = b.st[0], nx = b.st[1];
        if (nloc == 0u) { xcd_barrier_complete(bar, b.x, nloc, nx); b.st[0] = nloc; b.st[1] = nx; }
        const unsigned old = xb_add(&bar[XB_XSUB(b.x)], 1u);
        const unsigned gen = old / nloc;
        if (old + 1u == (gen + 1u) * nloc) {
            __builtin_amdgcn_fence(__ATOMIC_RELEASE, "agent");
            asm volatile("s_waitcnt vmcnt(0)" ::: "memory");
            const unsigned og = xb_add(&bar[XB_TOP], 1u);
            const unsigned tg = og / nx;
            if (og + 1u == (tg + 1u) * nx) xb_add(&bar[XB_TOPGEN], 1u);
            else XB_SPIN(xb_ld(&bar[XB_TOPGEN]) == tg, bar);
            __builtin_amdgcn_fence(__ATOMIC_ACQUIRE, "agent");
            xb_add(&bar[XB_XGEN(b.x)], 1u);
            asm volatile("s_waitcnt vmcnt(0)" ::: "memory");
        } else {
            XB_SPIN(xb_ld(&bar[XB_XGEN(b.x)]) == gen, bar);
            __builtin_amdgcn_fence(__ATOMIC_ACQUIRE, "agent");
            asm volatile("s_waitcnt vmcnt(0)" ::: "memory");
        }
    }
    __syncthreads();
}

struct Args {
    const float *x, *mem, *rel_bias, *g_mix, *w_in, *conv_w, *a_log, *dt_bias, *g_dn_out, *sinks, *g_mem, *w_mem_kv, *w_br_a, *w_br_b, *w_br_m, *w_o, *g_ffn, *w_ffn_in, *w_ffn_out, *g_final;
    float* out; unsigned char* ws; int ph_lo, ph_hi;
};
constexpr int NPHASE = 10;

__device__ __forceinline__ void p0_transpose_item(const float* W, int ldw, int src_col0, int k0, bf16_t* WT, size_t dst_row0, int ldt  , int dst_k0, LAS float* scr, int lane, const float* rowgain = nullptr) {
    if (src_col0 >= 0 && rowgain != nullptr) {
#pragma unroll 8
        for (int i = 0; i < 32; ++i) { const int kk = 2 * i + (lane >> 5); scr[kk * 33 + (lane & 31)] = W[(size_t)(k0 + kk) * ldw + src_col0 + (lane & 31)] * rowgain[k0 + kk]; }
    } else if (src_col0 >= 0) {
#pragma unroll 8
        for (int i = 0; i < 32; ++i) { const int kk = 2 * i + (lane >> 5); scr[kk * 33 + (lane & 31)] = W[(size_t)(k0 + kk) * ldw + src_col0 + (lane & 31)]; }
    } else {
#pragma unroll 8
        for (int i = 0; i < 32; ++i) { const int kk = 2 * i + (lane >> 5); scr[kk * 33 + (lane & 31)] = 0.f; }
    }
    asm volatile("s_waitcnt lgkmcnt(0)" ::: "memory");
    const int c = lane & 7;
#pragma unroll
    for (int j = 0; j < 4; ++j) { const int n = (lane >> 3) + 8 * j; const LAS float* s = scr + (8 * c) * 33 + n;
        u32x4 o; o.x = pk2(s[0 * 33], s[1 * 33]); o.y = pk2(s[2 * 33], s[3 * 33]); o.z = pk2(s[4 * 33], s[5 * 33]); o.w = pk2(s[6 * 33], s[7 * 33]);
        *(u32x4*)(WT + tiled_off((int)dst_row0 + n, dst_k0 + k0 + 8 * c, ldt / 64)) = o; }
    asm volatile("s_waitcnt lgkmcnt(0)" ::: "memory");
}
__device__ __forceinline__ void raw_row_to_bf16(const float* xrow, bf16_t* obase, float* rstd_out, int row, int lane) {
    const f32x4* xr = (const f32x4*)xrow + lane;
    f32x4 v[16]; float s = 0.f;
#pragma unroll
    for (int j = 0; j < 16; ++j) { v[j] = xr[64 * j]; s += (v[j][0] * v[j][0] + v[j][1] * v[j][1]) + (v[j][2] * v[j][2] + v[j][3] * v[j][3]); }
    const float rstd = 1.0f / sqrtf(wave_sum(s) * (1.0f / DM) + EPS);
    if (lane == 0) rstd_out[row] = rstd;
#pragma unroll
    for (int j = 0; j < 16; ++j) { u32x2 w; w.x = pk2(v[j][0], v[j][1]); w.y = pk2(v[j][2], v[j][3]);
        *(u32x2*)(obase + tiled_off(row, 4 * lane + 256 * j, DM / 64)) = w; }
}
__device__ __forceinline__ void rms_row_to_bf16(const float* xrow, const float* gain, bf16_t* obase, int row, int lane) {
    const f32x4* xr = (const f32x4*)xrow + lane; const f32x4* gr = (const f32x4*)gain + lane;
    f32x4 v[16]; float s = 0.f;
#pragma unroll
    for (int j = 0; j < 16; ++j) { v[j] = xr[64 * j]; s += (v[j][0] * v[j][0] + v[j][1] * v[j][1]) + (v[j][2] * v[j][2] + v[j][3] * v[j][3]); }
    const float rstd = 1.0f / sqrtf(wave_sum(s) * (1.0f / DM) + EPS);
#pragma unroll
    for (int j = 0; j < 16; ++j) { const f32x4 gv = gr[64 * j]; u32x2 w; w.x = pk2(v[j][0] * rstd * gv[0], v[j][1] * rstd * gv[1]); w.y = pk2(v[j][2] * rstd * gv[2], v[j][3] * rstd * gv[3]);
        *(u32x2*)(obase + tiled_off(row, 4 * lane + 256 * j, DM / 64)) = w; }
}

__device__ __forceinline__ int t5_bucket_dev(int n) {
    if (n < 16) return n;
    const float nf = (float)n;
    int large = 16 + (int)(logf(nf / 16.0f) / 2.0794415416798357f * 16.0f);
    return large < 31 ? large : 31;
}
constexpr int GDN_UNITS = BATCH * B_HEADS * (SEQ / 64);
constexpr int L_QS = 0, L_KS = 17408, L_RT = 34816, L_KDT = 71680, L_AM = 90112, L_TB = 107520, L_G = 116736, L_CW = 117504;
__device__ __forceinline__ f32x4 mfma16(bf16x8 a, bf16x8 b, f32x4 c) { return __builtin_amdgcn_mfma_f32_16x16x32_bf16(a, b, c, 0, 0, 0); }
__device__ __forceinline__ int perm_pos(int t) { const int t32 = t & 31; return (t & 32) + 8 * ((t32 >> 2) & 3) + 4 * (t32 >> 4) + (t32 & 3); }

constexpr int L_DINV = 123648;
struct GdnRaw { u32x4 w[3][4][2]; };
__device__ __forceinline__ void gdn_load_raw(GdnRaw& R, int unit, const bf16_t* bqkv, int tid) {
    const int bh = unit >> 7, n = unit & 127, b = bh >> 4, h = bh & 15, t = tid >> 3, c0 = (tid & 7) * 16;
    const long tok0 = (long)b * SEQ + (long)n * 64;
#pragma unroll
    for (int xi = 0; xi < 3; ++xi)
#pragma unroll
        for (int j = 0; j < 4; ++j) { const int row = t + j - 3;
            if (n * 64 + row >= 0) { const bf16_t* src = bqkv + (size_t)(tok0 + row) * 6144 + xi * 2048 + h * 128 + c0;
                R.w[xi][j][0] = *(const u32x4*)src; R.w[xi][j][1] = *(const u32x4*)(src + 8); }
            else { R.w[xi][j][0] = (u32x4){0u, 0u, 0u, 0u}; R.w[xi][j][1] = (u32x4){0u, 0u, 0u, 0u}; } }
}
__device__ __forceinline__ f32x4 mfma4f(float a, float b, f32x4 c) { return __builtin_amdgcn_mfma_f32_16x16x4f32(a, b, c, 0, 0, 0); }

__device__ __forceinline__ void gdn_local_unit(int unit, const Args& a, LAS unsigned char* lds0, const bf16_t* bqkv, const float* ba,
        bf16_t* GW, bf16_t* GKDT, bf16_t* GATT, float* GL, bf16_t* GQG, bf16_t* GUT, int tid0, int wave) {
    LAS unsigned char* lds = lds0; asm volatile("" : "+v"(lds));
    int tid = tid0; asm volatile("" : "+v"(tid));
    const int lane = tid & 63;
    const int bh = unit >> 7, n = unit & 127, b = bh >> 4, h = bh & 15, fr = lane & 15, fq = lane >> 4;
    const long tok0 = (long)b * SEQ + (long)n * 64;
    LAS float* CW = (LAS float*)(lds + L_CW);
    LAS float* Gs = (LAS float*)(lds + L_G); LAS float* GCs = Gs + 64; LAS float* BTs = Gs + 128;
    const int t = tid >> 3, cg = tid & 7, c0 = cg * 16;
#ifndef GP_A
#define GP_A 1
#define GP_B 1
#define GP_C 1
#define GP_D 1
#endif
    for (int rrA = 0; rrA < GP_A; ++rrA) {
    float beta;
    { const float bb = ba[(tok0 + t) * 32 + h], bav = ba[(tok0 + t) * 32 + 16 + h];
      beta = sigmoidf_(bb); const float z = bav + a.dt_bias[h]; const float sp = z > 20.f ? z : log1pf(__expf(z));
      const float g = -__expf(a.a_log[h]) * sp;
      if (cg == 0) { Gs[t] = g; BTs[t] = beta; } }
    __syncthreads();
    if (wave == 0) { float v = Gs[lane];
#pragma unroll
        for (int o = 1; o < 64; o <<= 1) { const float u = __shfl_up(v, o); if (lane >= o) v += u; }
        GCs[lane] = v; }
    float y[3][16];
#pragma unroll
    for (int xi = 0; xi < 3; ++xi) {
#pragma unroll
        for (int i = 0; i < 16; ++i) y[xi][i] = 0.f;
#pragma unroll
        for (int j = 0; j < 4; ++j) {
            const int row = t + j - 3;
            if (j == 2) asm volatile("" ::: "memory");
            const bool rok = (n * 64 + row >= 0);
            const bf16_t* src = bqkv + (size_t)(tok0 + (rok ? row : 0)) * 6144 + xi * 2048 + h * 128 + c0;
            u32x4 w0 = *(const u32x4*)src, w1 = *(const u32x4*)(src + 8);
            const unsigned msk = rok ? 0xffffffffu : 0u; w0 = w0 & msk; w1 = w1 & msk;
            const LAS float* cw = CW + xi * 512 + j * 128 + c0;
            const f32x4 k0 = *(const LAS f32x4*)cw, k1 = *(const LAS f32x4*)(cw + 4), k2 = *(const LAS f32x4*)(cw + 8), k3 = *(const LAS f32x4*)(cw + 12);
            y[xi][0] += k0[0] * bflo(w0[0]); y[xi][1] += k0[1] * bfhi(w0[0]); y[xi][2] += k0[2] * bflo(w0[1]); y[xi][3] += k0[3] * bfhi(w0[1]);
            y[xi][4] += k1[0] * bflo(w0[2]); y[xi][5] += k1[1] * bfhi(w0[2]); y[xi][6] += k1[2] * bflo(w0[3]); y[xi][7] += k1[3] * bfhi(w0[3]);
            y[xi][8] += k2[0] * bflo(w1[0]); y[xi][9] += k2[1] * bfhi(w1[0]); y[xi][10] += k2[2] * bflo(w1[1]); y[xi][11] += k2[3] * bfhi(w1[1]);
            y[xi][12] += k3[0] * bflo(w1[2]); y[xi][13] += k3[1] * bfhi(w1[2]); y[xi][14] += k3[2] * bflo(w1[3]); y[xi][15] += k3[3] * bfhi(w1[3]);
        }
#pragma unroll
        for (int i = 0; i < 16; ++i) y[xi][i] = siluf_(y[xi][i]);
        asm volatile("" ::: "memory");
    }
    float sq = 0.f, sk = 0.f;
#pragma unroll
    for (int i = 0; i < 16; ++i) { sq += y[0][i] * y[0][i]; sk += y[1][i] * y[1][i]; }
    sq += __shfl_xor(sq, 1); sq += __shfl_xor(sq, 2); sq += __shfl_xor(sq, 4);
    sk += __shfl_xor(sk, 1); sk += __shfl_xor(sk, 2); sk += __shfl_xor(sk, 4);
    const float rq = __builtin_amdgcn_rsqf(sq + EPS) * 0.08838834764831845f, rk = __builtin_amdgcn_rsqf(sk + EPS);
    __syncthreads();
    const float gct = GCs[t], glast = GCs[63];
    const float e1 = __expf(gct), e2 = __expf(glast - gct);
    if (tid == 0) GL[unit] = __expf(glast);
    {
        u32x4 kq[2], qq[2], qg[2];
#pragma unroll
        for (int i = 0; i < 8; ++i) { const float k0 = y[1][2 * i] * rk, k1 = y[1][2 * i + 1] * rk, q0 = y[0][2 * i] * rq, q1 = y[0][2 * i + 1] * rq;
            kq[i >> 2][i & 3] = cvt_pk_bf16(k0, k1); qq[i >> 2][i & 3] = cvt_pk_bf16(q0, q1); qg[i >> 2][i & 3] = cvt_pk_bf16(q0 * e1, q1 * e1); }
        *(LAS u32x4*)(lds + L_KS + t * 272 + c0 * 2) = kq[0]; *(LAS u32x4*)(lds + L_KS + t * 272 + c0 * 2 + 16) = kq[1];
        *(LAS u32x4*)(lds + L_QS + t * 272 + c0 * 2) = qq[0]; *(LAS u32x4*)(lds + L_QS + t * 272 + c0 * 2 + 16) = qq[1];
        bf16_t* qgp = GQG + (size_t)unit * 8192 + t * 128 + (c0 & ~31) + 4 * (cg & 1);
        *(u32x2*)(qgp) = (u32x2){qg[0].x, qg[0].y}; *(u32x2*)(qgp + 8) = (u32x2){qg[0].z, qg[0].w}; *(u32x2*)(qgp + 16) = (u32x2){qg[1].x, qg[1].y}; *(u32x2*)(qgp + 24) = (u32x2){qg[1].z, qg[1].w};
    }
    {
        const int tp = (t + 8 * cg) & 63, pt = (perm_pos(t) + 8 * cg) & 63;
#pragma unroll
        for (int i = 0; i < 16; i += 2) { const float kn0 = y[1][i] * rk, kn1 = y[1][i + 1] * rk;
            const unsigned pv = cvt_pk_bf16(beta * y[2][i], beta * y[2][i + 1]), pk = cvt_pk_bf16(beta * kn0 * e1, beta * kn1 * e1), pd = cvt_pk_bf16(kn0 * e2, kn1 * e2);
            *(LAS unsigned short*)(lds + L_RT + (c0 + i) * 144 + tp * 2) = (unsigned short)(pv & 0xffffu); *(LAS unsigned short*)(lds + L_RT + (c0 + i + 1) * 144 + tp * 2) = (unsigned short)(pv >> 16);
            *(LAS unsigned short*)(lds + L_RT + (128 + c0 + i) * 144 + tp * 2) = (unsigned short)(pk & 0xffffu); *(LAS unsigned short*)(lds + L_RT + (128 + c0 + i + 1) * 144 + tp * 2) = (unsigned short)(pk >> 16);
            *(LAS unsigned short*)(lds + L_KDT + (c0 + i) * 144 + pt * 2) = (unsigned short)(pd & 0xffffu); *(LAS unsigned short*)(lds + L_KDT + (c0 + i + 1) * 144 + pt * 2) = (unsigned short)(pd >> 16); }
    }
    __syncthreads();
    }
    for (int rrB = 0; rrB < GP_B; ++rrB) {
#pragma unroll
    for (int q = 0; q < 2; ++q) {
        const int idx = 2 * wave + q, ct = idx >> 2, st = idx & 3;
        f32x4 acc = (f32x4){0.f, 0.f, 0.f, 0.f}, acc2 = (f32x4){0.f, 0.f, 0.f, 0.f};
        if (st <= ct) {
#pragma unroll
            for (int kk = 0; kk < 4; ++kk) {
                const bf16x8 kc = *(const LAS bf16x8*)(lds + L_KS + (ct * 16 + fr) * 272 + (32 * kk + 8 * fq) * 2);
                const bf16x8 ks = *(const LAS bf16x8*)(lds + L_KS + (st * 16 + fr) * 272 + (32 * kk + 8 * fq) * 2);
                const bf16x8 qc = *(const LAS bf16x8*)(lds + L_QS + (ct * 16 + fr) * 272 + (32 * kk + 8 * fq) * 2);
                acc = mfma16(kc, ks, acc);
                acc2 = mfma16(ks, qc, acc2);
            }
        }
        {   const int sc = st * 16 + fr; const float gcs = GCs[sc];
#pragma unroll
            for (int r = 0; r < 4; ++r) { const int c = ct * 16 + 4 * fq + r; const float dl = fminf(GCs[c] - gcs, 0.f);
                const float v = (sc < c) ? BTs[c] * acc[r] * __expf(dl) : 0.f;
                *(LAS float*)(lds + L_AM + c * 272 + sc * 4) = v; } }
        {   const int c = ct * 16 + fr; const float gcc = GCs[c]; float o[4];
#pragma unroll
            for (int r = 0; r < 4; ++r) { const int sr = st * 16 + 4 * fq + r; const float dl = fminf(gcc - GCs[sr], 0.f); o[r] = (sr <= c) ? acc2[r] * __expf(dl) : 0.f; }
            u32x2 w; w.x = cvt_pk_bf16(o[0], o[1]); w.y = cvt_pk_bf16(o[2], o[3]);
            *(u32x2*)(GATT + (size_t)unit * 4096 + c * 64 + 32 * (st >> 1) + 8 * fq + 4 * (st & 1)) = w; }
    }
    __syncthreads();
    }
    for (int rrC = 0; rrC < GP_C; ++rrC) {
    if (wave < 4) {
        const int bi = wave; float x[16];
#pragma unroll
        for (int i = 0; i < 16; ++i) x[i] = 0.f;
#pragma unroll
        for (int i = 0; i < 16; ++i) {
            float s0 = (fr == i) ? 1.f : 0.f, s1 = 0.f, s2 = 0.f, s3 = 0.f;
#pragma unroll
            for (int m4 = 0; m4 < (i + 3) / 4; ++m4) { const f32x4 a4 = *(const LAS f32x4*)(lds + L_AM + (16 * bi + i) * 272 + (16 * bi) * 4 + m4 * 16);
                s0 -= a4[0] * x[4 * m4]; s1 -= a4[1] * x[4 * m4 + 1]; s2 -= a4[2] * x[4 * m4 + 2]; s3 -= a4[3] * x[4 * m4 + 3]; }
            x[i] = (s0 + s1) + (s2 + s3);
        }
        if (fq == 0) {
#pragma unroll
            for (int i = 0; i < 16; ++i) { *(LAS float*)(lds + L_DINV + bi * 1280 + i * 80 + fr * 4) = x[i];
                *(LAS unsigned short*)(lds + L_TB + (16 * bi + i) * 144 + (16 * bi + fr) * 2) = (unsigned short)(cvt_pk_bf16(x[i], 0.f) & 0xffffu); }
        } else {
            const int bj = bi + fq;
            if (bj < 4) {
#pragma unroll
                for (int i = 0; i < 16; ++i) *(LAS unsigned short*)(lds + L_TB + (16 * bi + i) * 144 + (16 * bj + fr) * 2) = (unsigned short)0; }
        }
    } else {
        for (int idx = tid - 256; idx < 1024; idx += 256) { const int row = idx >> 3, ch = idx & 7;
            *(u32x4*)(GKDT + (size_t)unit * 8192 + row * 64 + ch * 8) = *(const LAS u32x4*)(lds + L_KDT + row * 144 + (((8 * ch + 8 * (row >> 4)) & 63) * 2)); }
    }
    __syncthreads();
    if (wave < 3) {
        const int j = wave;
        f32x4 Tc[4];
#pragma unroll
        for (int k = 0; k < 4; ++k) Tc[k] = (f32x4){0.f, 0.f, 0.f, 0.f};
#pragma unroll
        for (int k = 0; k < 3; ++k) if (k == j) {
#pragma unroll
            for (int kk = 0; kk < 4; ++kk) Tc[k][kk] = *(const LAS float*)(lds + L_DINV + k * 1280 + (4 * fq + kk) * 80 + fr * 4); }
#pragma unroll
        for (int i = 1; i < 4; ++i) if (i > j) {
            f32x4 Mx = (f32x4){0.f, 0.f, 0.f, 0.f};
#pragma unroll
            for (int k = 0; k < 3; ++k) if (k >= j && k < i) {
                const f32x4 a4 = *(const LAS f32x4*)(lds + L_AM + (16 * i + fr) * 272 + (16 * k + 4 * fq) * 4);
#pragma unroll
                for (int kk = 0; kk < 4; ++kk) Mx = mfma4f(a4[kk], Tc[k][kk], Mx); }
            f32x4 Tx = (f32x4){0.f, 0.f, 0.f, 0.f};
            const f32x4 d4 = *(const LAS f32x4*)(lds + L_DINV + i * 1280 + fr * 80 + (4 * fq) * 4);
#pragma unroll
            for (int kk = 0; kk < 4; ++kk) Tx = mfma4f(d4[kk], Mx[kk], Tx);
            Tc[i] = -Tx;
#pragma unroll
            for (int kk = 0; kk < 4; ++kk) *(LAS unsigned short*)(lds + L_TB + (16 * i + 4 * fq + kk) * 144 + (16 * j + fr) * 2) = (unsigned short)(cvt_pk_bf16(Tc[i][kk], 0.f) & 0xffffu);
        }
    }
    __syncthreads();
    }
    for (int rrD = 0; rrD < GP_D; ++rrD) {
#pragma unroll
    for (int q = 0; q < 4; ++q) {
        const int idx = 4 * wave + q;
        {   const int ct = idx >> 3, nt = idx & 7; f32x4 acc = (f32x4){0.f, 0.f, 0.f, 0.f};
#pragma unroll
            for (int kk = 0; kk < 2; ++kk) {
                const bf16x8 ta = *(const LAS bf16x8*)(lds + L_TB + (ct * 16 + fr) * 144 + (32 * kk + 8 * fq) * 2);
                const bf16x8 rb = *(const LAS bf16x8*)(lds + L_RT + (nt * 16 + fr) * 144 + (((32 * kk + 8 * fq + 8 * nt) & 63) * 2));
                acc = mfma16(ta, rb, acc); }
            u32x2 w; w.x = cvt_pk_bf16(acc[0], acc[1]); w.y = cvt_pk_bf16(acc[2], acc[3]);
            *(u32x2*)(GUT + (size_t)unit * 8192 + (nt * 16 + fr) * 64 + ct * 16 + 4 * fq) = w; }
        {   const int it = idx >> 2, ct = idx & 3; f32x4 acc = (f32x4){0.f, 0.f, 0.f, 0.f};
#pragma unroll
            for (int kk = 0; kk < 2; ++kk) {
                const bf16x8 ra = *(const LAS bf16x8*)(lds + L_RT + (128 + it * 16 + fr) * 144 + (((32 * kk + 8 * fq + 8 * it) & 63) * 2));
                const bf16x8 tb = *(const LAS bf16x8*)(lds + L_TB + (ct * 16 + fr) * 144 + (32 * kk + 8 * fq) * 2);
                acc = mfma16(ra, tb, acc); }
            u32x2 w; w.x = cvt_pk_bf16(acc[0], acc[1]); w.y = cvt_pk_bf16(acc[2], acc[3]);
            *(u32x2*)(GW + (size_t)unit * 8192 + (ct * 16 + fr) * 128 + 32 * (it >> 1) + 8 * fq + 4 * (it & 1)) = w; }
    }
    __syncthreads();
    }
}

constexpr int GS_SPW = 2, GS_SLOT = 36864, GS_D = 4;
__device__ __forceinline__ void gdn_scan(int bh, int sg, LAS unsigned char* lds, const bf16_t* GW, const bf16_t* GKDT, const bf16_t* GUT, const float* GL, bf16_t* GST, bf16_t* GVT, int tid, int lane, int wave) {
    const int fr = lane & 15, fq = lane >> 4;
    LAS float* DEC = (LAS float*)(lds + DEC_OFF);
    if (tid < 128) DEC[tid] = GL[bh * 128 + tid];
    const bool comp = wave < GS_SPW;
    const int slice = sg * GS_SPW + wave;
    const size_t ubase = (size_t)bh * 128;
    unsigned goff[6], dsto[6]; int kind[6];
#pragma unroll
    for (int k = 0; k < 6; ++k) { const int p = (wave - GS_SPW) * 6 + k;
        if (p < 16) { const int r = 4 * p + (lane >> 4), qd = lane & 15; goff[k] = (unsigned)(r * 256 + ((qd ^ (r & 15)) * 16)); dsto[k] = (unsigned)p * 1024u; kind[k] = 0; }
        else if (p < 32) { const int pp = p - 16, r = 8 * pp + (lane >> 3), qd = lane & 7; goff[k] = (unsigned)(r * 128 + ((qd ^ ((r >> 1) & 7)) * 16)); dsto[k] = 16384u + (unsigned)pp * 1024u; kind[k] = 1; }
        else { const int u = p - 32, cw = u >> 1, k2 = u & 1; goff[k] = (unsigned)((sg * GS_SPW + cw) * 2048 + k2 * 1024 + lane * 16); dsto[k] = 32768u + (unsigned)(cw * 2048 + k2 * 1024); kind[k] = 2; } }
#define GS_ISSUE(step, slot) do { if (!comp) { const size_t _u = ubase + (size_t)(step); \
        _Pragma("unroll") for (int _k = 0; _k < 6; ++_k) { const char* _g = (const char*)((kind[_k] == 0 ? GW : (kind[_k] == 1 ? GKDT : GUT)) + _u * 8192); \
            __builtin_amdgcn_global_load_lds((const unsigned*)(_g + goff[_k]), (LAS unsigned*)(lds + (slot) * GS_SLOT + dsto[_k]), 16, 0, 0); } } \
        asm volatile("" ::: "memory"); } while (0)
    f32x4 S[8];
#pragma unroll
    for (int i = 0; i < 8; ++i) S[i] = (f32x4){0.f, 0.f, 0.f, 0.f};
    asm volatile("s_waitcnt vmcnt(0) lgkmcnt(0)" ::: "memory");
    __builtin_amdgcn_s_barrier();
    GS_ISSUE(0, 0); GS_ISSUE(1, 1); GS_ISSUE(2, 2);
    for (int n = 0; n < 128; ++n) {
        if (!comp) asm volatile("s_waitcnt vmcnt(12)" ::: "memory");
        __builtin_amdgcn_s_barrier();
        asm volatile("" ::: "memory");
        { const int nn = n + 3 < 128 ? n + 3 : 127; const int sl = (n + 3) & 3; GS_ISSUE(nn, sl); }
        if (comp) {
            LAS const unsigned char* sb = lds + (n & 3) * GS_SLOT;
            const size_t unit = ubase + n;
            bf16x8 aw[4][4], ak[2][8];
#pragma unroll
            for (int kk = 0; kk < 4; ++kk)
#pragma unroll
                for (int ct = 0; ct < 4; ++ct) aw[kk][ct] = *(const LAS bf16x8*)(sb + (16 * ct + fr) * 256 + (((4 * kk + fq) ^ fr) * 16));
#pragma unroll
            for (int kk = 0; kk < 2; ++kk)
#pragma unroll
                for (int i = 0; i < 8; ++i) ak[kk][i] = *(const LAS bf16x8*)(sb + 16384 + (16 * i + fr) * 128 + (((4 * kk + fq) ^ ((fr >> 1) & 7)) * 16));
            u32x2 uu[4];
#pragma unroll
            for (int ct = 0; ct < 4; ++ct) uu[ct] = *(const LAS u32x2*)(sb + 32768 + wave * 2048 + fr * 128 + (16 * ct + 4 * fq) * 2);
            const float dec = DEC[n];
            asm volatile("" ::: "memory");
            bf16x8 bs[4];
#pragma unroll
            for (int kk = 0; kk < 4; ++kk) { u32x4 bw; bw.x = cvt_pk_bf16(S[2 * kk][0], S[2 * kk][1]); bw.y = cvt_pk_bf16(S[2 * kk][2], S[2 * kk][3]);
                bw.z = cvt_pk_bf16(S[2 * kk + 1][0], S[2 * kk + 1][1]); bw.w = cvt_pk_bf16(S[2 * kk + 1][2], S[2 * kk + 1][3]);
                *(u32x4*)(GST + unit * 16384 + (16 * slice + fr) * 128 + 32 * kk + 8 * fq) = bw;
                bs[kk] = __builtin_bit_cast(bf16x8, bw); }
            f32x4 av[4];
#pragma unroll
            for (int ct = 0; ct < 4; ++ct) av[ct] = (f32x4){0.f, 0.f, 0.f, 0.f};
#pragma unroll
            for (int kk = 0; kk < 4; ++kk)
#pragma unroll
                for (int ct = 0; ct < 4; ++ct) av[ct] = mfma16(aw[kk][ct], bs[kk], av[ct]);
            bf16x8 bv[2];
#pragma unroll
            for (int kk = 0; kk < 2; ++kk) { u32x4 bw;
                { const int ct = 2 * kk; bw.x = cvt_pk_bf16(bflo(uu[ct].x) - av[ct][0], bfhi(uu[ct].x) - av[ct][1]); bw.y = cvt_pk_bf16(bflo(uu[ct].y) - av[ct][2], bfhi(uu[ct].y) - av[ct][3]); }
                { const int ct = 2 * kk + 1; bw.z = cvt_pk_bf16(bflo(uu[ct].x) - av[ct][0], bfhi(uu[ct].x) - av[ct][1]); bw.w = cvt_pk_bf16(bflo(uu[ct].y) - av[ct][2], bfhi(uu[ct].y) - av[ct][3]); }
                *(u32x4*)(GVT + unit * 8192 + (16 * slice + fr) * 64 + 32 * kk + 8 * fq) = bw;
                bv[kk] = __builtin_bit_cast(bf16x8, bw); }
#pragma unroll
            for (int i = 0; i < 8; ++i) S[i] = S[i] * dec;
#pragma unroll
            for (int kk = 0; kk < 2; ++kk)
#pragma unroll
                for (int i = 0; i < 8; ++i) S[i] = mfma16(ak[kk][i], bv[kk], S[i]);
        }
    }
#undef GS_ISSUE
    asm volatile("s_waitcnt vmcnt(0)" ::: "memory");
    __builtin_amdgcn_s_barrier();
}

constexpr int GO_SLOT = 49152;
__device__ __forceinline__ void gdn_out_units(int u0, int nu, const Args& a, LAS unsigned char* lds, bf16_t* acat, bf16_t* odst, const bf16_t* GQG, const bf16_t* GATT, const bf16_t* GST, const bf16_t* GVT, int tid, int lane, int wave) {
    const int fr = lane & 15, fq = lane >> 4, ct = wave & 3, dvh = wave >> 2;
    LAS float* SSQ = (LAS float*)(lds + DEC_OFF);
    unsigned goff[6]; unsigned dsto[6]; bool isv[6];
#pragma unroll
    for (int k = 0; k < 6; ++k) { const int p = wave * 6 + k;
        if (p < 32) { const int r = 4 * p + (lane >> 4), qd = lane & 15; goff[k] = (unsigned)(r * 256 + ((qd ^ (r & 15)) * 16)); dsto[k] = (unsigned)p * 1024u; isv[k] = false; }
        else { const int pp = p - 32, r = 8 * pp + (lane >> 3), qd = lane & 7; goff[k] = (unsigned)(r * 128 + ((qd ^ ((r >> 1) & 7)) * 16)); dsto[k] = 32768u + (unsigned)pp * 1024u; isv[k] = true; } }
#define GO_ISSUE(unit, slot) do { const char* _s = (const char*)(GST + (size_t)(unit) * 16384); const char* _v = (const char*)(GVT + (size_t)(unit) * 8192); \
        _Pragma("unroll") for (int _k = 0; _k < 6; ++_k) __builtin_amdgcn_global_load_lds((const unsigned*)((isv[_k] ? _v : _s) + goff[_k]), (LAS unsigned*)(lds + (slot) * GO_SLOT + dsto[_k]), 16, 0, 0); \
        asm volatile("" ::: "memory"); } while (0)
    f32x4 gv[4];
#pragma unroll
    for (int i4 = 0; i4 < 4; ++i4) gv[i4] = *(const f32x4*)(a.g_dn_out + 16 * (4 * dvh + i4) + 4 * fq);
    asm volatile("s_waitcnt vmcnt(0) lgkmcnt(0)" ::: "memory");
    __builtin_amdgcn_s_barrier();
    GO_ISSUE(u0, 0); GO_ISSUE(u0 + (nu > 1 ? 1 : 0), 1);
    for (int i = 0; i < nu; ++i) {
        const int unit = u0 + i;
        if (i == 0) asm volatile("s_waitcnt vmcnt(6)" ::: "memory"); else if (i == 1) asm volatile("s_waitcnt vmcnt(20)" ::: "memory"); else asm volatile("s_waitcnt vmcnt(24)" ::: "memory");
        __builtin_amdgcn_s_barrier();
        asm volatile("" ::: "memory");
        const int bh = unit >> 7, n = unit & 127, b = bh >> 4, h = bh & 15;
        const bf16_t* qg = GQG + (size_t)unit * 8192 + (16 * ct + fr) * 128 + 8 * fq;
        const bf16_t* at = GATT + (size_t)unit * 4096 + (16 * ct + fr) * 64 + 8 * fq;
        bf16x8 bq[4], bt[2];
#pragma unroll
        for (int kk = 0; kk < 4; ++kk) bq[kk] = *(const bf16x8*)(qg + 32 * kk);
#pragma unroll
        for (int kk = 0; kk < 2; ++kk) bt[kk] = *(const bf16x8*)(at + 32 * kk);
        const size_t zoff = tiled_off(b * SEQ + n * 64 + 16 * ct + fr, 2048 + h * 128 + 64 * dvh + 4 * fq, KCAT / 64);
        u32x2 zz[4];
#pragma unroll
        for (int i4 = 0; i4 < 4; ++i4) zz[i4] = *(const u32x2*)(acat + zoff + 16 * i4);
        asm volatile("" ::: "memory");
        { const int un = (i + 2 < nu) ? unit + 2 : unit; GO_ISSUE(un, (i + 2) % 3); }
        LAS const unsigned char* sb = lds + (i % 3) * GO_SLOT;
        bf16x8 fs[4][4], fv[4][2];
#pragma unroll
        for (int i4 = 0; i4 < 4; ++i4) { const int row = 16 * (4 * dvh + i4) + fr;
#pragma unroll
            for (int kk = 0; kk < 4; ++kk) fs[i4][kk] = *(const LAS bf16x8*)(sb + row * 256 + (((4 * kk + fq) ^ fr) * 16));
#pragma unroll
            for (int kk = 0; kk < 2; ++kk) fv[i4][kk] = *(const LAS bf16x8*)(sb + 32768 + row * 128 + (((4 * kk + fq) ^ ((fr >> 1) & 7)) * 16)); }
        f32x4 o[4]; float ss = 0.f;
#pragma unroll
        for (int i4 = 0; i4 < 4; ++i4) { f32x4 acc = (f32x4){0.f, 0.f, 0.f, 0.f};
#pragma unroll
            for (int kk = 0; kk < 4; ++kk) acc = mfma16(fs[i4][kk], bq[kk], acc);
#pragma unroll
            for (int kk = 0; kk < 2; ++kk) acc = mfma16(fv[i4][kk], bt[kk], acc);
            o[i4] = acc; ss += (acc[0] * acc[0] + acc[1] * acc[1]) + (acc[2] * acc[2] + acc[3] * acc[3]); }
        ss += __shfl_xor(ss, 16); ss += __shfl_xor(ss, 32);
        LAS float* sq = SSQ + (i & 1) * 128;
        if (fq == 0) sq[dvh * 64 + ct * 16 + fr] = ss;
        asm volatile("s_waitcnt lgkmcnt(0)" ::: "memory");
        __builtin_amdgcn_s_barrier();
        asm volatile("" ::: "memory");
        const float tot = sq[ct * 16 + fr] + sq[64 + ct * 16 + fr];
        const float rstd = __builtin_amdgcn_rsqf(tot * (1.0f / 128.0f) + EPS);
#pragma unroll
        for (int i4 = 0; i4 < 4; ++i4) { const u32x2 z = zz[i4]; const f32x4 g = gv[i4];
            u32x2 w; w.x = pk2(o[i4][0] * rstd * g[0] * siluf_(bflo(z.x)), o[i4][1] * rstd * g[1] * siluf_(bfhi(z.x)));
            w.y = pk2(o[i4][2] * rstd * g[2] * siluf_(bflo(z.y)), o[i4][3] * rstd * g[3] * siluf_(bfhi(z.y)));
            *(u32x2*)(odst + zoff + 16 * i4) = w; }
        asm volatile("" ::: "memory");
    }
#undef GO_ISSUE
    asm volatile("s_waitcnt vmcnt(0)" ::: "memory");
    __builtin_amdgcn_s_barrier();
}

typedef float f32x16 __attribute__((ext_vector_type(16)));
__device__ __forceinline__ f32x16 mfma32(bf16x8 a, bf16x8 b, f32x16 c) { return __builtin_amdgcn_mfma_f32_32x32x16_bf16(a, b, c, 0, 0, 0); }
__device__ __forceinline__ int perm16(int k) { const int k16 = k & 15; return (k & ~15) + 8 * ((k16 >> 2) & 1) + 4 * (k16 >> 3) + (k16 & 3); }
__device__ __forceinline__ bf16x8 pack8(const f32x16& p, int base) {
    u32x4 w; w.x = cvt_pk_bf16(p[base + 0], p[base + 1]); w.y = cvt_pk_bf16(p[base + 2], p[base + 3]); w.z = cvt_pk_bf16(p[base + 4], p[base + 5]); w.w = cvt_pk_bf16(p[base + 6], p[base + 7]);
    return __builtin_bit_cast(bf16x8, w); }

constexpr int SW_VT = 36864, SW_BT = 70656;
__device__ __forceinline__ void swa_unit(int unit, const Args& a, LAS unsigned char* lds, bf16_t* acat, bf16_t* odst, const bf16_t* kva, int tid, int lane, int wave) {
    const int kvh = unit & 3, nb = (unit >> 2) & 63, b = unit >> 8, hq = kvh * 8 + wave;
    const long tok0 = (long)b * SEQ + (long)nb * 128, tokw = tok0 - 128;
#pragma unroll
    for (int i = 0; i < 4; ++i) { const int idx = tid + 512 * i, row = idx >> 3, ch = idx & 7; u32x4 v = (u32x4){0u, 0u, 0u, 0u};
        if (nb > 0 || row >= 128) v = *(const u32x4*)(kva + (size_t)(tokw + row) * 512 + kvh * 64 + ch * 8);
        *(LAS u32x4*)(lds + row * 144 + ch * 16) = v; }
#pragma unroll
    for (int i = 0; i < 4; ++i) { const int idx = tid + 512 * i, key = idx & 255, ch = idx >> 8; u32x4 v = (u32x4){0u, 0u, 0u, 0u};
        if (nb > 0 || key >= 128) v = *(const u32x4*)(kva + (size_t)(tokw + key) * 512 + 256 + kvh * 64 + ch * 8);
        const int pos = perm16(key);
#pragma unroll
        for (int e = 0; e < 4; ++e) { *(LAS unsigned short*)(lds + SW_VT + (8 * ch + 2 * e) * 528 + pos * 2) = (unsigned short)(v[e] & 0xffffu);
            *(LAS unsigned short*)(lds + SW_VT + (8 * ch + 2 * e + 1) * 528 + pos * 2) = (unsigned short)(v[e] >> 16); } }
    LAS float* BT = (LAS float*)(lds + SW_BT) + wave * 128;
    BT[lane] = a.rel_bias[t5_bucket_dev(lane) * A_HEADS + hq]; BT[lane + 64] = a.rel_bias[t5_bucket_dev(lane + 64) * A_HEADS + hq];
    __syncthreads();
    const int r = lane & 31, hh = lane >> 5;
    const float sink = a.sinks[hq];
#pragma unroll 1
    for (int i = 0; i < 4; ++i) {
        bf16_t* qrow = acat + tiled_off((int)tok0 + 32 * i + r, hq * 64, KCAT / 64);
        bf16x8 qf[4];
#pragma unroll
        for (int s = 0; s < 4; ++s) qf[s] = *(const bf16x8*)(qrow + 16 * s + 8 * hh);
        f32x16 sc[5];
#pragma unroll
        for (int d = 0; d < 5; ++d) { f32x16 acc;
#pragma unroll
            for (int e = 0; e < 16; ++e) acc[e] = 0.f;
#pragma unroll
            for (int s = 0; s < 4; ++s) acc = mfma32(*(const LAS bf16x8*)(lds + (32 * (i + d) + r) * 144 + (16 * s + 8 * hh) * 2), qf[s], acc);
            sc[d] = acc;  asm volatile("" ::: "memory"); }
        float mx = sink;
#pragma unroll
        for (int d = 0; d < 5; ++d) { const bool tile_ok = (nb > 0) || (i + d >= 4);
#pragma unroll
            for (int e = 0; e < 16; ++e) { const int krow = (e & 3) + 8 * (e >> 2) + 4 * hh, dist = 128 - 32 * d + r - krow;
                const bool valid = tile_ok && (d == 0 ? (krow > r) : (d == 4 ? (krow <= r) : true));
                const float v = valid ? sc[d][e] * 0.125f + BT[dist & 127] : -1e30f;
                sc[d][e] = v; mx = fmaxf(mx, v); }  asm volatile("" ::: "memory"); }
        mx = fmaxf(mx, __shfl_xor(mx, 32));
        float ls = 0.f;
#pragma unroll
        for (int d = 0; d < 5; ++d)
#pragma unroll
            for (int e = 0; e < 16; ++e) { const float p = __expf(sc[d][e] - mx); sc[d][e] = p; ls += p; }
        ls += __shfl_xor(ls, 32); ls += __expf(sink - mx);
        f32x16 o[2];
#pragma unroll
        for (int dt = 0; dt < 2; ++dt)
#pragma unroll
            for (int e = 0; e < 16; ++e) o[dt][e] = 0.f;
#pragma unroll
        for (int d = 0; d < 5; ++d)
#pragma unroll
            for (int s2 = 0; s2 < 2; ++s2) { const bf16x8 pf = pack8(sc[d], 8 * s2);
#pragma unroll
                for (int dt = 0; dt < 2; ++dt) o[dt] = mfma32(*(const LAS bf16x8*)(lds + SW_VT + (32 * dt + r) * 528 + (32 * (i + d) + 16 * s2) * 2 + hh * 16), pf, o[dt]);
                asm volatile("" ::: "memory"); }
        const float inv = 1.0f / ls;
#pragma unroll
        for (int dt = 0; dt < 2; ++dt)
#pragma unroll
            for (int g4 = 0; g4 < 4; ++g4) { u32x2 w; w.x = cvt_pk_bf16(o[dt][4 * g4] * inv, o[dt][4 * g4 + 1] * inv); w.y = cvt_pk_bf16(o[dt][4 * g4 + 2] * inv, o[dt][4 * g4 + 3] * inv);
                *(u32x2*)(odst + (qrow - acat) + 32 * dt + 8 * g4 + 4 * hh) = w; }
    }
    __syncthreads();
}

constexpr int MA_VT = 69632;
__device__ __forceinline__ void mem_unit(int unit, LAS unsigned char* lds, bf16_t* acat, bf16_t* odst, const bf16_t* mkv, int tid, int lane, int wave) {
    const int h = unit & 3, qb = (unit >> 2) & 31, b = unit >> 7;
    const bf16_t* kbase = mkv + (size_t)b * MEMLEN * 1024 + h * 128;
#pragma unroll
    for (int i = 0; i < 8; ++i) { const int idx = tid + 512 * i, row = idx >> 4, ch = idx & 15;
        *(LAS u32x4*)(lds + row * 272 + ch * 16) = *(const u32x4*)(kbase + (size_t)row * 1024 + ch * 8); }
#pragma unroll
    for (int i = 0; i < 8; ++i) { const int idx = tid + 512 * i, key = idx & 255, ch = idx >> 8;
        const u32x4 v = *(const u32x4*)(kbase + (size_t)key * 1024 + 512 + ch * 8);
        const int pos = perm16(key);
#pragma unroll
        for (int e = 0; e < 4; ++e) { *(LAS unsigned short*)(lds + MA_VT + (8 * ch + 2 * e) * 528 + pos * 2) = (unsigned short)(v[e] & 0xffffu);
            *(LAS unsigned short*)(lds + MA_VT + (8 * ch + 2 * e + 1) * 528 + pos * 2) = (unsigned short)(v[e] >> 16); } }
    __syncthreads();
    const int r = lane & 31, hh = lane >> 5;
    bf16_t* qrow = acat + tiled_off(b * SEQ + qb * 256 + 32 * wave + r, 4096 + h * 128, KCAT / 64);
    bf16x8 qf[8];
#pragma unroll
    for (int s = 0; s < 8; ++s) qf[s] = *(const bf16x8*)(qrow + (s >> 2) * 8192 + 16 * (s & 3) + 8 * hh);
    f32x16 o[4];
#pragma unroll
    for (int dt = 0; dt < 4; ++dt)
#pragma unroll
        for (int e = 0; e < 16; ++e) o[dt][e] = 0.f;
    float mx = -1e30f, ls = 0.f;
#pragma unroll 1
    for (int grp = 0; grp < 4; ++grp) {
        f32x16 sc[2]; float gm = -1e30f;
#pragma unroll
        for (int d = 0; d < 2; ++d) { f32x16 acc;
#pragma unroll
            for (int e = 0; e < 16; ++e) acc[e] = 0.f;
#pragma unroll
            for (int s = 0; s < 8; ++s) acc = mfma32(*(const LAS bf16x8*)(lds + (32 * (2 * grp + d) + r) * 272 + (16 * s + 8 * hh) * 2), qf[s], acc);
#pragma unroll
            for (int e = 0; e < 16; ++e) { acc[e] *= 0.08838834764831845f; gm = fmaxf(gm, acc[e]); }
            sc[d] = acc; }
        gm = fmaxf(gm, __shfl_xor(gm, 32));
        const float mn = fmaxf(mx, gm), alpha = __expf(mx - mn);
        float ps = 0.f;
#pragma unroll
        for (int d = 0; d < 2; ++d)
#pragma unroll
            for (int e = 0; e < 16; ++e) { const float p = __expf(sc[d][e] - mn); sc[d][e] = p; ps += p; }
        ps += __shfl_xor(ps, 32);
        ls = ls * alpha + ps; mx = mn;
#pragma unroll
        for (int dt = 0; dt < 4; ++dt)
#pragma unroll
            for (int e = 0; e < 16; ++e) o[dt][e] *= alpha;
#pragma unroll
        for (int d = 0; d < 2; ++d)
#pragma unroll
            for (int s2 = 0; s2 < 2; ++s2) { const bf16x8 pf = pack8(sc[d], 8 * s2);
#pragma unroll
                for (int dt = 0; dt < 4; ++dt) o[dt] = mfma32(*(const LAS bf16x8*)(lds + MA_VT + (32 * dt + r) * 528 + (32 * (2 * grp + d) + 16 * s2) * 2 + hh * 16), pf, o[dt]); }
    }
    const float inv = 1.0f / ls;
#pragma unroll
    for (int dt = 0; dt < 4; ++dt)
#pragma unroll
        for (int g4 = 0; g4 < 4; ++g4) { u32x2 w; w.x = cvt_pk_bf16(o[dt][4 * g4] * inv, o[dt][4 * g4 + 1] * inv); w.y = cvt_pk_bf16(o[dt][4 * g4 + 2] * inv, o[dt][4 * g4 + 3] * inv);
            *(u32x2*)(odst + (qrow - acat) + (dt >> 1) * 8192 + 32 * (dt & 1) + 8 * g4 + 4 * hh) = w; }
    __syncthreads();
}


constexpr int BG_BRA = 128 * 32, BG_BRM = 128 * 8, BG_O = 128 * 64, BG_F1 = (2 * DFF / 32) * 64, BG_F2 = 128 * (DFF / 64);
constexpr int BG_ITEMS = 2 * BG_BRA + BG_BRM + BG_O + BG_F1 + BG_F2;
constexpr int BG_CH = 32;
constexpr int BG_E0 = (2 * BG_BRA + BG_BRM) / BG_CH, BG_E1 = BG_E0 + BG_O / BG_CH, BG_E2 = BG_E1 + BG_F1 / BG_CH, BG_E3 = BG_ITEMS / BG_CH;
static_assert(BG_ITEMS % BG_CH == 0 && (2 * BG_BRA + BG_BRM) % BG_CH == 0 && BG_O % BG_CH == 0 && BG_F1 % BG_CH == 0, "whole chunks per segment");
__device__ __forceinline__ void bg_item(int r, const Args& args, bf16_t* Wbr_t, bf16_t* Wo_t, bf16_t* Wf1_t, bf16_t* Wf2_t, LAS float* scr, int lane) {
    if (r < BG_BRA) { const int kb = r / 128, gd = r % 128; p0_transpose_item(args.w_br_a, DM, gd * 32, kb * 64, Wbr_t, (size_t)gd * 32, KCAT, 0, scr, lane); return; } r -= BG_BRA;
    if (r < BG_BRA) { const int kb = r / 128, gd = r % 128; p0_transpose_item(args.w_br_b, DM, gd * 32, kb * 64, Wbr_t, (size_t)gd * 32, KCAT, 2048, scr, lane); return; } r -= BG_BRA;
    if (r < BG_BRM) { const int kb = r / 128, gd = r % 128; p0_transpose_item(args.w_br_m, DM, gd * 32, kb * 64, Wbr_t, (size_t)gd * 32, KCAT, 4096, scr, lane); return; } r -= BG_BRM;
    if (r < BG_O) { const int kb = r / 128, gd = r % 128; p0_transpose_item(args.w_o, DM, gd * 32, kb * 64, Wo_t, (size_t)gd * 32, DM, 0, scr, lane); return; } r -= BG_O;
    if (r < BG_F1) { const int kb = r / (2 * DFF / 32), gd = r % (2 * DFF / 32), tj = gd / 8, wi = gd % 8;
        const int src = wi < 4 ? tj * 128 + wi * 32 : DFF + tj * 128 + (wi - 4) * 32;
        p0_transpose_item(args.w_ffn_in, 2 * DFF, src, kb * 64, Wf1_t, (size_t)gd * 32, DM, 0, scr, lane, args.g_ffn); return; } r -= BG_F1;
    { const int kb = r / 128, gd = r % 128; p0_transpose_item(args.w_ffn_out, DM, gd * 32, kb * 64, Wf2_t, (size_t)gd * 32, DFF, 0, scr, lane); }
}

__global__ void __launch_bounds__(512, 2) hybrid_fwd(Args args) {
    extern __shared__ __attribute__((aligned(16))) unsigned char lds_raw[];
    LAS unsigned char* lds = (LAS unsigned char*)lds_raw;
    volatile LAS unsigned* MISC = (volatile LAS unsigned*)(lds + MISC_OFF);
    const int tid = threadIdx.x, lane = tid & 63, wave = __builtin_amdgcn_readfirstlane(tid >> 6);
    const int G = gridDim.x, bx = blockIdx.x;
    const int vcu = (G % 8 == 0) ? (bx % 8) * (G / 8) + bx / 8 : bx;
    unsigned char* ws = args.ws;
    unsigned* ctl = (unsigned*)(ws + WS_CTL);
    bf16_t* Win_t = (bf16_t*)(ws + WS_WIN); bf16_t* Wkv_t = (bf16_t*)(ws + WS_WKV); bf16_t* Wbr_t = (bf16_t*)(ws + WS_WBR); bf16_t* Wo_t = (bf16_t*)(ws + WS_WO);
    bf16_t* Wf1_t = (bf16_t*)(ws + WS_WF1); bf16_t* Wf2_t = (bf16_t*)(ws + WS_WF2);
    bf16_t* HB = (bf16_t*)(ws + WS_H); bf16_t* ACAT = (bf16_t*)(ws + WS_ACAT); bf16_t* KVA = (bf16_t*)(ws + WS_KVA); bf16_t* BQKV = (bf16_t*)(ws + WS_BQKV);
    bf16_t* GATES = (bf16_t*)(ws + WS_GATES); float* BA = (float*)(ws + WS_BA); bf16_t* MEMN = (bf16_t*)(ws + WS_MEMN); bf16_t* MKV = (bf16_t*)(ws + WS_MKV);
    float* PART1 = (float*)(ws + WS_PART1); float* PART2 = (float*)(ws + WS_PART2); bf16_t* HID = (bf16_t*)(ws + WS_HID);
    bf16_t* YB = HB;
    bf16_t* XB = (bf16_t*)(ws + WS_GATES + 192 * MiB);
    float* RSTD0 = (float*)(ws + WS_PART2);
    bf16_t* X1B = (bf16_t*)(ws + WS_ACAT);
    bf16_t* GWp = (bf16_t*)(ws + WS_GW); bf16_t* GKDTp = (bf16_t*)(ws + WS_GKDT); bf16_t* GATTp = (bf16_t*)(ws + WS_GATT); float* GLp = (float*)(ws + WS_GL);
    bf16_t* GQGp = (bf16_t*)(ws + WS_GQG); bf16_t* GUTp = (bf16_t*)(ws + WS_GUT); bf16_t* GSTp = (bf16_t*)(ws + WS_GST); bf16_t* GVTp = (bf16_t*)(ws + WS_GVT);

    for (int u = tid; u < (LDS_BYTES - RS_OFF) / 4; u += 512) ((LAS unsigned*)(lds + RS_OFF))[u] = 0u;
    __syncthreads();
    XcdBarrier bar; bar.bar = ctl + CW_BAR; bar.x = 0; bar.st = nullptr;
    if (MK_ONE_LAUNCH) bar = xcd_barrier_post(ctl + CW_BAR, MISC + 8);
    const int lo = args.ph_lo, hi = args.ph_hi;
#ifndef DISABLE_MASK
#define DISABLE_MASK 0
#endif
#define IN(k) (lo <= (k) && (k) < hi && !((DISABLE_MASK >> (k)) & 1))
#ifndef REPEAT_MASK
#define REPEAT_MASK 0
#endif
#define REP(k) for (int _rep = 0; _rep < 1 + ((REPEAT_MASK >> (k)) & 1); ++_rep)
#define ODST_OF(k) ((_rep < ((REPEAT_MASK >> (k)) & 1)) ? (bf16_t*)args.out : ACAT)
#define SEAM(k) do { if (IN(k) && IN((k) + 1)) xcd_barrier(bar); } while (0)
#define AT_LD(p) __hip_atomic_load((p), __ATOMIC_RELAXED, __HIP_MEMORY_SCOPE_AGENT)
#define BG_WORK(need, steal_k) do { \
    LAS int* _qs = (LAS int*)(lds + DEC_OFF + 1024); \
    __syncthreads(); \
    if ((steal_k) >= 0 && tid == 0) (void)__hip_atomic_fetch_add(ctl + CW_DONE + 64 * ((steal_k) < 0 ? 0 : (steal_k)), 1u, __ATOMIC_RELAXED, __HIP_MEMORY_SCOPE_AGENT); \
    for (;;) { \
        if (tid == 0) { const unsigned _hd = AT_LD(ctl + CW_BGHEAD); bool _go = _hd < (unsigned)(need); \
            if (!_go && (steal_k) >= 0 && _hd < (unsigned)BG_E3) _go = AT_LD(ctl + CW_DONE + 64 * ((steal_k) < 0 ? 0 : (steal_k))) < (unsigned)G; \
            _qs[0] = _go ? (int)__hip_atomic_fetch_add(ctl + CW_BGHEAD, 1u, __ATOMIC_RELAXED, __HIP_MEMORY_SCOPE_AGENT) : -1; } \
        __syncthreads(); const int _c = _qs[0]; __syncthreads(); \
        if (_c < 0 || _c >= BG_E3) break; \
        for (int _q = 0; _q < BG_CH / 8; ++_q) bg_item(_c * BG_CH + _q * 8 + wave, args, Wbr_t, Wo_t, Wf1_t, Wf2_t, (LAS float*)(lds + wave * 16384), lane); \
    } } while (0)

    if (IN(0)) REP(0) {
        LAS float* scr = (LAS float*)(lds + wave * 16384);
        const int gw = vcu * 8 + wave, NGW = G * 8;
        constexpr int I_IN = (NP_IN / 32) * 64, I_KV = 32 * 64;
        constexpr int NITEMS = I_IN + I_KV;
        for (int it = gw; it < NITEMS; it += NGW) {
            int r = it;
            if (r < I_IN) { const int kb = r / (NP_IN / 32), gd = r % (NP_IN / 32), n0 = gd * 32;
                const int src = n0 < 10752 ? n0 : (n0 < 23552 ? n0 + 32 : (n0 < 23584 ? n0 - 23552 + 10752 : -1));
                p0_transpose_item(args.w_in, N_IN, src, kb * 64, Win_t, (size_t)n0, DM, 0, scr, lane, args.g_mix); continue; } r -= I_IN;
            { const int kb = r / 32, gd = r % 32; p0_transpose_item(args.w_mem_kv, 1024, gd * 32, kb * 64, Wkv_t, (size_t)gd * 32, DM, 0, scr, lane); }
        }
        for (int m = gw; m < M; m += NGW) raw_row_to_bf16(args.x + (size_t)m * DM, XB, RSTD0, m, lane);
        for (int m = gw; m < MEMROWS; m += NGW) rms_row_to_bf16(args.mem + (size_t)m * DM, args.g_mem, MEMN, m, lane);
    }
    SEAM(0);

    if (IN(1)) REP(1) {
        pg8::Gemm g{XB, Win_t, MEMN, Wkv_t, DM};
        pg8::RsOrder1 S; S.init(M, NP_IN, G, bx, 8, 4); S.rstd0 = RSTD0; S.rs = (LAS float*)(lds + RS_OFF); S.cur_pm = -1;
        pg8::EpiInProj E{ACAT, KVA, BQKV, GATES, BA, MKV, (const LAS float*)(lds + RS_OFF)};
        pg8::gemm_phase<pg8::EpiInProj, pg8::RsOrder1, true, GEMM_MODE>(lds, g, S, E);
        BG_WORK(0, -1);
    }
    SEAM(1);

    if (IN(2)) REP(2) {
        const int per = GDN_UNITS / G, u0 = bx * per;
        { const int h = (u0 >> 7) & 15;
          if (tid < 384) { const int idx = tid * 4, xi = idx >> 9, j = (idx >> 7) & 3, c = idx & 127;
              *(LAS f32x4*)((LAS float*)(lds + L_CW) + idx) = *(const f32x4*)(args.conv_w + (size_t)j * 6144 + xi * 2048 + h * 128 + c); } }
        for (int i = 0; i < per; ++i) { int u = u0 + i; asm volatile("" : "+s"(u));
            gdn_local_unit(u, args, lds, BQKV, BA, GWp, GKDTp, GATTp, GLp, GQGp, GUTp, tid, wave); }
        BG_WORK(0, -1);
    }
    SEAM(2);

    if (IN(3)) REP(3) {
        bf16_t* ODST = ODST_OF(3);
        if (bx < 128) {
            const int j = bx >> 3; gdn_scan((bx & 7) * 4 + (j >> 2), j & 3, lds, GWp, GKDTp, GUTp, GLp, GSTp, GVTp, tid, lane, wave);
        }
        {   LAS int* qslot = (LAS int*)(lds + DEC_OFF + 1024);
            for (;;) {
                if (tid == 0) *qslot = (int)__hip_atomic_fetch_add(ctl + CW_QUEUE + 256 * _rep, 1u, __ATOMIC_RELAXED, __HIP_MEMORY_SCOPE_AGENT);
                __syncthreads();
                const int u = *qslot;
                __syncthreads();
                if (u >= 512) break;
                swa_unit(u, args, lds, ACAT, ODST, KVA, tid, lane, wave);
            }
            for (;;) {
                if (tid == 0) *qslot = (int)__hip_atomic_fetch_add(ctl + CW_QUEUE + 64 + 256 * _rep, 1u, __ATOMIC_RELAXED, __HIP_MEMORY_SCOPE_AGENT);
                __syncthreads();
                const int u = *qslot;
                __syncthreads();
                if (u >= 256) break;
                mem_unit(u, lds, ACAT, ODST, MKV, tid, lane, wave);
            }
        }
        BG_WORK(0, 3);
    }
    SEAM(3);

    if (IN(4)) REP(4) {
        bf16_t* ODST = ODST_OF(4);
        { const int per = GDN_UNITS / G; gdn_out_units(bx * per, per, args, lds, ACAT, ODST, GQGp, GATTp, GSTp, GVTp, tid, lane, wave); }
        BG_WORK(BG_E0, -1);
    }
    SEAM(4);

    if (IN(5)) REP(5) {
        pg8::Gemm g{ACAT, Wbr_t, ACAT, Wbr_t, KCAT};
        pg8::StaticOrder S; S.init(M, DM, G, bx);
        pg8::EpiMerge E{GATES, YB};
        pg8::gemm_phase<pg8::EpiMerge, pg8::StaticOrder, true, GEMM_MODE>(lds, g, S, E);
        BG_WORK(BG_E1, -1);
    }
    SEAM(5);

    if (IN(6)) REP(6) {
        pg8::Gemm g{YB, Wo_t, YB, Wo_t, DM};
        pg8::StaticOrder S; S.init(M, DM, G, bx);
        pg8::EpiWo E{XB, X1B, PART1};
        pg8::gemm_phase<pg8::EpiWo, pg8::StaticOrder, true, GEMM_MODE>(lds, g, S, E);
        BG_WORK(BG_E2, -1);
    }
    SEAM(6);

    if (IN(7)) REP(7) {
        pg8::Gemm g{X1B, Wf1_t, X1B, Wf1_t, DM};
        pg8::RsOrder S; S.init(M, 2 * DFF, G, bx); S.part = PART1; S.rs = (LAS float*)(lds + RS_OFF); S.cur_pm = -1;
        pg8::EpiFfnIn E{HID, (const LAS float*)(lds + RS_OFF)};
        pg8::gemm_phase<pg8::EpiFfnIn, pg8::RsOrder, true, GEMM_MODE>(lds, g, S, E);
        BG_WORK(BG_E3, -1);
    }
    SEAM(7);

    if (IN(8)) REP(8) {
        pg8::Gemm g{HID, Wf2_t, HID, Wf2_t, DFF};
        pg8::StaticOrder S; S.init(M, DM, G, bx);
        pg8::EpiFfnOut E{X1B, PART2};
        pg8::gemm_phase<pg8::EpiFfnOut, pg8::StaticOrder, true, GEMM_MODE>(lds, g, S, E);
    }
    SEAM(8);

    if (IN(9)) REP(9) {
        const int gw = vcu * 8 + wave, NGW = G * 8;
        for (int m = gw; m < M; m += NGW) {
            const float ss = wave_sum(PART2[(size_t)lane * M + m]);
            const float rstd = __builtin_amdgcn_rsqf(ss * (1.0f / DM) + EPS);
            const u32x4* xr = (const u32x4*)(X1B + (size_t)(m >> 7) * (DM / 64) * 8192 + (size_t)(m & 127) * 64 + (size_t)(lane >> 3) * 8192) + (lane & 7);
            f32x4* orow = (f32x4*)(args.out + (size_t)m * DM) + 2 * lane; const f32x4* gr = (const f32x4*)args.g_final + 2 * lane;
            u32x4 v[8];
#pragma unroll
            for (int j = 0; j < 8; ++j) v[j] = xr[(size_t)j * 8 * 8192 / 8];
#pragma unroll
            for (int j = 0; j < 8; ++j) { const f32x4 a = {bflo(v[j].x), bfhi(v[j].x), bflo(v[j].y), bfhi(v[j].y)}, b = {bflo(v[j].z), bfhi(v[j].z), bflo(v[j].w), bfhi(v[j].w)};
                orow[128 * j] = a * rstd * gr[128 * j]; orow[128 * j + 1] = b * rstd * gr[128 * j + 1]; }
        }
    }
#undef IN
#undef SEAM
}

extern "C" void kernel_launch(void* const* d_in, const int* in_sizes, int n_in, void* d_out, int out_size, void* d_ws, size_t ws_size, hipStream_t stream) {
    static int grid = 0;
    if (grid == 0) {
        if (n_in != 20 || in_sizes[0] != M * DM || out_size != M * DM || ws_size < WS_END) {
            fprintf(stderr, "kernel_launch: unexpected shapes (n_in %d, in0 %d, out %d, ws %zu < %zu): nothing launched\n", n_in, n_in > 0 ? in_sizes[0] : -1, out_size, ws_size, (size_t)WS_END); grid = -1; return; }
        if (hipFuncSetAttribute((const void*)hybrid_fwd, hipFuncAttributeMaxDynamicSharedMemorySize, LDS_BYTES) != hipSuccess) { fprintf(stderr, "kernel_launch: hipFuncSetAttribute failed\n"); grid = -1; return; }
        int per_cu = 0;
        if (hipOccupancyMaxActiveBlocksPerMultiprocessor(&per_cu, (const void*)hybrid_fwd, 512, LDS_BYTES) != hipSuccess || per_cu < 1)
            fprintf(stderr, "kernel_launch: note: occupancy query reports %d workgroups per CU\n", per_cu);
        (void)hipGetLastError();
        grid = 256;
    }
    if (grid < 0) return;
    if (hipMemsetAsync((char*)d_ws + WS_CTL, 0, CTL_ZERO_BYTES, stream) != hipSuccess) { fprintf(stderr, "kernel_launch: memset failed\n"); return; }
    Args a{};
    a.x = (const float*)d_in[0]; a.mem = (const float*)d_in[1]; a.rel_bias = (const float*)d_in[2]; a.g_mix = (const float*)d_in[3]; a.w_in = (const float*)d_in[4];
    a.conv_w = (const float*)d_in[5]; a.a_log = (const float*)d_in[6]; a.dt_bias = (const float*)d_in[7]; a.g_dn_out = (const float*)d_in[8]; a.sinks = (const float*)d_in[9];
    a.g_mem = (const float*)d_in[10]; a.w_mem_kv = (const float*)d_in[11]; a.w_br_a = (const float*)d_in[12]; a.w_br_b = (const float*)d_in[13]; a.w_br_m = (const float*)d_in[14];
    a.w_o = (const float*)d_in[15]; a.g_ffn = (const float*)d_in[16]; a.w_ffn_in = (const float*)d_in[17]; a.w_ffn_out = (const float*)d_in[18]; a.g_final = (const float*)d_in[19];
    a.out = (float*)d_out; a.ws = (unsigned char*)d_ws;
#if MK_ONE_LAUNCH
    a.ph_lo = 0; a.ph_hi = NPHASE;
    hipLaunchKernelGGL(hybrid_fwd, dim3(grid), dim3(512), LDS_BYTES, stream, a);
#else
    for (int p = 0; p < NPHASE; ++p) { a.ph_lo = p; a.ph_hi = p + 1; hipLaunchKernelGGL(hybrid_fwd, dim3(grid), dim3(512), LDS_BYTES, stream, a); }
#endif
    const hipError_t le = hipPeekAtLastError();
    if (le != hipSuccess) fprintf(stderr, "kernel_launch: launch failed: %s\n", hipGetErrorName(le));
}
```
